# Optimizing an MI355X kernel written in HIP

```python
import jax, jax.numpy as jnp
from jax import lax
import numpy as np

D_MODEL = 2048
BATCH = 4
SEQ = 2048
DEPTH = 1

HEAD_DIM = 128
N_HEADS_FOX = 8
N_HEADS_DIL = 8
DIL_PATTERNS = ((128, 1), (512, 4), (2048, 16))
Q_BLOCK = 128
D_FF = 5632
CONV_WIDTH = 3
EPS = 1e-6
NEG_INF = -1e30
W_FOX = N_HEADS_FOX * HEAD_DIM
W_DIL = N_HEADS_DIL * HEAD_DIM
IN_SPLITS = (W_FOX, W_FOX, W_FOX, N_HEADS_FOX, W_DIL, W_DIL, W_DIL, D_MODEL, D_MODEL)
IN_COLS = sum(IN_SPLITS)

kernel_name = "hybrid_fox_dilated_convffn"


def rms_norm(x, g):
    xf = x.astype(jnp.float32)
    y = xf * lax.rsqrt(jnp.mean(xf * xf, axis=-1, keepdims=True) + EPS)
    return (y * g.astype(jnp.float32)).astype(x.dtype)


def alibi_slopes(n_heads):
    return jnp.asarray(2.0 ** (-8.0 * np.arange(1, n_heads + 1) / n_heads), dtype=jnp.float32)


def split_heads(a, n_heads):
    b, s, _ = a.shape
    return a.reshape(b, s, n_heads, HEAD_DIM).transpose(0, 2, 1, 3)


def merge_heads(a):
    b, h, s, d = a.shape
    return a.transpose(0, 2, 1, 3).reshape(b, s, h * d)


def fox_attention(q, k, v, log_f):
    b, h, s, d = q.shape
    nb = s // Q_BLOCK
    scale = 1.0 / np.sqrt(d)
    c = jnp.cumsum(log_f, axis=-1)
    qb = q.reshape(b, h, nb, Q_BLOCK, d).transpose(2, 0, 1, 3, 4)
    cb = c.reshape(b, h, nb, Q_BLOCK).transpose(2, 0, 1, 3)
    kpos = jnp.arange(s)

    def block(args):
        n, qn, cn = args
        sc = jnp.einsum('bhqd,bhkd->bhqk', qn, k) * scale
        sc = sc + cn[..., :, None] - c[:, :, None, :]
        qpos = n * Q_BLOCK + jnp.arange(Q_BLOCK)
        sc = jnp.where(kpos[None, :] <= qpos[:, None], sc, NEG_INF)
        p = jax.nn.softmax(sc, axis=-1)
        return jnp.einsum('bhqk,bhkd->bhqd', p, v)

    o = lax.map(block, (jnp.arange(nb), qb, cb))
    return o.transpose(1, 2, 0, 3, 4).reshape(b, h, s, d)


def dilated_pattern(q, k, v, slopes, window, dil):
    b, h, s, d = q.shape
    steps = window // dil
    L = s // dil
    nb = -(-L // steps)
    Lp = nb * steps
    scale = 1.0 / np.sqrt(d)

    def to_sub(a):
        return a.reshape(b, h, L, dil, d).transpose(0, 1, 3, 2, 4)

    qs = jnp.pad(to_sub(q), ((0, 0), (0, 0), (0, 0), (0, Lp - L), (0, 0)))
    qb = qs.reshape(b, h, dil, nb, steps, d)

    def band(a):
        ap = jnp.pad(to_sub(a), ((0, 0), (0, 0), (0, 0), (steps, Lp - L), (0, 0)))
        prev = ap[:, :, :, :Lp].reshape(b, h, dil, nb, steps, d)
        cur = ap[:, :, :, steps:].reshape(b, h, dil, nb, steps, d)
        return jnp.concatenate([prev, cur], axis=4)

    kb, vb = band(k), band(v)
    sc = jnp.einsum('bhrnqd,bhrnkd->bhrnqk', qb, kb) * scale
    i = jnp.arange(steps)[:, None]
    j = jnp.arange(2 * steps)[None, :]
    dist = i + steps - j
    ksub = jnp.arange(nb)[:, None, None] * steps + j[None] - steps
    valid = (dist >= 0) & (dist <= steps) & (ksub >= 0)
    penalty = slopes[None, :, None, None, None, None] * (dil * dist).astype(jnp.float32)
    sc = jnp.where(valid, sc - penalty, NEG_INF)
    m = jnp.max(sc, axis=-1, keepdims=True)
    e = jnp.exp(sc - m)
    den = jnp.sum(e, axis=-1)
    o = jnp.einsum('bhrnqk,bhrnkd->bhrnqd', e, vb) / den[..., None]
    lse = m[..., 0] + jnp.log(den)

    def from_sub(a, tail):
        a = a.reshape((b, h, dil, Lp) + tail)[:, :, :, :L]
        perm = (0, 1, 3, 2) + tuple(range(4, 4 + len(tail)))
        return a.transpose(perm).reshape((b, h, s) + tail)

    return from_sub(o, (d,)), from_sub(lse, ())


def dilated_attention(q, k, v, slopes):
    outs, lses = [], []
    for window, dil in DIL_PATTERNS:
        o, l = dilated_pattern(q, k, v, slopes, window, dil)
        outs.append(o)
        lses.append(l)
    o = jnp.stack(outs, axis=0)
    w = jax.nn.softmax(jnp.stack(lses, axis=0), axis=0)
    return jnp.sum(w[..., None] * o, axis=0)


def qk_norm(a, g):
    af = a.astype(jnp.float32)
    af = af * lax.rsqrt(jnp.mean(af * af, axis=-1, keepdims=True) + EPS)
    return af * g.astype(jnp.float32)[None, :, None, :]


def setup_inputs(seed: int = 0) -> dict:
    key = jax.random.key(seed)
    ks = jax.random.split(key, 20)
    f32 = jnp.float32

    def nrm(k, shape, scale):
        return jax.random.normal(k, shape, f32) * scale

    return {
        "x": jax.random.normal(ks[0], (BATCH, SEQ, D_MODEL), f32),
        "g_attn": 1.0 + nrm(ks[1], (DEPTH, D_MODEL), 0.02),
        "w_in": nrm(ks[2], (DEPTH, D_MODEL, IN_COLS), D_MODEL ** -0.5),
        "b_forget": 3.0 + nrm(ks[3], (DEPTH, N_HEADS_FOX), 0.5),
        "g_q_fox": 1.0 + nrm(ks[4], (DEPTH, N_HEADS_FOX, HEAD_DIM), 0.02),
        "g_k_fox": 1.0 + nrm(ks[5], (DEPTH, N_HEADS_FOX, HEAD_DIM), 0.02),
        "g_q_dil": 1.0 + nrm(ks[6], (DEPTH, N_HEADS_DIL, HEAD_DIM), 0.02),
        "g_k_dil": 1.0 + nrm(ks[7], (DEPTH, N_HEADS_DIL, HEAD_DIM), 0.02),
        "w_br_fox": nrm(ks[8], (DEPTH, W_FOX, D_MODEL), W_FOX ** -0.5),
        "w_br_dil": nrm(ks[9], (DEPTH, W_DIL, D_MODEL), W_DIL ** -0.5),
        "w_out": nrm(ks[10], (DEPTH, D_MODEL, D_MODEL), D_MODEL ** -0.5),
        "g_ffn": 1.0 + nrm(ks[11], (DEPTH, D_MODEL), 0.02),
        "w_up": nrm(ks[12], (DEPTH, D_MODEL, 2 * D_FF), D_MODEL ** -0.5),
        "w_conv": nrm(ks[13], (DEPTH, CONV_WIDTH, 2 * D_FF), CONV_WIDTH ** -0.5),
        "b_conv": nrm(ks[14], (DEPTH, 2 * D_FF), 0.02),
        "w_down": nrm(ks[15], (DEPTH, D_FF, D_MODEL), D_FF ** -0.5),
    }


def reference(x, g_attn, w_in, b_forget, g_q_fox, g_k_fox, g_q_dil, g_k_dil,
              w_br_fox, w_br_dil, w_out, g_ffn, w_up, w_conv, b_conv, w_down):
    b, s, _ = x.shape
    offs = np.cumsum(IN_SPLITS)[:-1].tolist()
    slopes = alibi_slopes(N_HEADS_DIL)
    for l in range(DEPTH):
        h = rms_norm(x, g_attn[l])
        proj = h @ w_in[l]
        qa, ka, va, fa, qb, kb, vb, ga, gb = jnp.split(proj, offs, axis=-1)
        q_a = qk_norm(split_heads(qa, N_HEADS_FOX), g_q_fox[l])
        k_a = qk_norm(split_heads(ka, N_HEADS_FOX), g_k_fox[l])
        v_a = split_heads(va, N_HEADS_FOX).astype(jnp.float32)
        log_f = jax.nn.log_sigmoid((fa + b_forget[l]).astype(jnp.float32)).transpose(0, 2, 1)
        o_a = merge_heads(fox_attention(q_a, k_a, v_a, log_f)).astype(x.dtype)
        q_b = qk_norm(split_heads(qb, N_HEADS_DIL), g_q_dil[l])
        k_b = qk_norm(split_heads(kb, N_HEADS_DIL), g_k_dil[l])
        v_b = split_heads(vb, N_HEADS_DIL).astype(jnp.float32)
        o_b = merge_heads(dilated_attention(q_b, k_b, v_b, slopes)).astype(x.dtype)
        merged = jax.nn.sigmoid(ga) * (o_a @ w_br_fox[l]) + jax.nn.sigmoid(gb) * (o_b @ w_br_dil[l])
        x = x + merged @ w_out[l]
        h = rms_norm(x, g_ffn[l])
        u = h @ w_up[l]
        up = jnp.pad(u, ((0, 0), (CONV_WIDTH - 1, 0), (0, 0)))
        wc = w_conv[l]
        conv = sum(wc[t] * up[:, t:t + s] for t in range(CONV_WIDTH)) + b_conv[l]
        gate, val = jnp.split(conv, 2, axis=-1)
        x = x + (jax.nn.silu(gate) * val) @ w_down[l]
    return x
```

```cpp
#include <hip/hip_runtime.h>
#include <hip/hip_cooperative_groups.h>
#include <cstdio>
#include <cstdint>
namespace cg = cooperative_groups;
namespace pg8 {
#define PG8_LAS __attribute__((address_space(3)))
typedef unsigned short bf16_t;
typedef short bf16x8 __attribute__((ext_vector_type(8)));
typedef float f32x4 __attribute__((ext_vector_type(4)));
typedef unsigned u32x4 __attribute__((ext_vector_type(4)));
constexpr int BM = 256, BK = 64, HALF = 128, HTB = HALF * BK * 2  , STAGE_BYTES = 8 * HTB, NXCD = 8, WGM = 8;

__host__ __device__ __forceinline__ int lds_byte(int r, int c) { const int st = (r >> 4) * 2 + (c >> 5), rr = r & 15, cc = c & 31, ob = rr * 64 + cc * 2; return st * 1024 + (ob ^ (((ob >> 9) & 1) << 5)); }
__host__ __device__ __forceinline__ void stage_rc(int b, int& R, int& C) { const int st = b / 1024, sb = b % 1024, swz = sb ^ (((sb >> 9) & 1) << 5); R = (st >> 1) * 16 + swz / 64; C = (st & 1) * 32 + (swz % 64) / 2; }
__host__ __device__ __forceinline__ int perm32(int rho) { const int n = rho >> 4, i = rho & 15; return 8 * (i >> 2) + 4 * n + (i & 3); }

struct Unit { int pm, pn; };
struct Gemm { const bf16_t* A; const bf16_t* Bt; int M, N, K; };

struct StaticOrder {
    int nM, nN, nwg, G, c;
    __host__ __device__ void init(int M, int N, int G_, int c_) { nM = M / BM; nN = N / BM; nwg = nM * nN; G = G_; c = c_; }
    __host__ __device__ bool next(int i, Unit& u) const {
        const long L = (long)i * G + c; if (L >= nwg) return false;
        int wgid = (int)L; { const int q = nwg / NXCD, r = nwg % NXCD, xcd = wgid % NXCD, off = wgid / NXCD; wgid = (xcd < r ? xcd * (q + 1) : r * (q + 1) + (xcd - r) * q) + off; }
        const int nig = WGM * nN, gid = wgid / nig, fm = gid * WGM, gsz = (nM - fm) < WGM ? (nM - fm) : WGM;
        u.pm = fm + ((wgid % nig) % gsz); u.pn = (wgid % nig) / gsz; return true;
    }
    __device__ __forceinline__ void a_ready(const Unit&) const {}
    __device__ __forceinline__ void done(const Unit&) const {}
};

__device__ __forceinline__ unsigned cvt_pk_bf16(float lo, float hi) { unsigned r; asm volatile("v_cvt_pk_bf16_f32 %0, %1, %2" : "=v"(r) : "v"(lo), "v"(hi)); return r; }
typedef unsigned u32x4e __attribute__((ext_vector_type(4)));
constexpr float LOG2E = 1.4426950408889634f;
constexpr float EPSN = 1e-6f;
constexpr float QSCALE = 0.08838834764831845f * 1.4426950408889634f;
__device__ __forceinline__ float sigm(float x) { return __builtin_amdgcn_rcpf(1.f + __builtin_amdgcn_exp2f(-x * LOG2E)); }
__device__ __forceinline__ float bflo(unsigned w) { return __uint_as_float(w << 16); }
__device__ __forceinline__ float bfhi(unsigned w) { return __uint_as_float(w & 0xffff0000u); }
__device__ __forceinline__ u32x4e pack8f(const f32x4 a, const f32x4 b) { u32x4e w; w.x = cvt_pk_bf16(a[0], a[1]); w.y = cvt_pk_bf16(a[2], a[3]); w.z = cvt_pk_bf16(b[0], b[1]); w.w = cvt_pk_bf16(b[2], b[3]); return w; }
#define EPI_LDSBAR() do { asm volatile("s_waitcnt lgkmcnt(0)" ::: "memory"); __builtin_amdgcn_s_barrier(); asm volatile("" ::: "memory"); } while (0)

struct EpiProj {
    static constexpr bool PERM = true, AFTER_DRAIN = false, HAS_MID = false;
    bf16_t* QKV; bf16_t* GATES; const float* gains; PG8_LAS float* xl;
    __device__ __forceinline__ void operator()(f32x4 (&acc)[2][2][4][2], const Unit& u, int wr, int wc, int fr, int fq) const {
        const int colt = u.pn * BM, row0 = u.pm * BM + wr * 64 + fr, seg = colt >> 10;
        const bool norm = (seg == 0) | (seg == 1) | (seg == 3) | (seg == 4);
        if (!norm) {
            bf16_t* base; int ldc, col0;
            if (colt >= 6144) { base = GATES; ldc = 4096; col0 = colt - 6144; } else { base = QKV; ldc = 6144; col0 = colt; }
            col0 += wc * 32 + 8 * fq;
#pragma unroll
            for (int ai = 0; ai < 2; ++ai)
#pragma unroll
                for (int m = 0; m < 4; ++m) { bf16_t* rowp = base + (size_t)(row0 + ai * HALF + m * 16) * ldc + col0;
#pragma unroll
                    for (int bj = 0; bj < 2; ++bj) *(u32x4e*)(rowp + bj * HALF) = pack8f(acc[ai][bj][m][0], acc[ai][bj][m][1]); }
        } else {
#pragma unroll
            for (int ai = 0; ai < 2; ++ai)
#pragma unroll
                for (int m = 0; m < 4; ++m)
#pragma unroll
                    for (int bj = 0; bj < 2; ++bj) { const f32x4 a = acc[ai][bj][m][0], b = acc[ai][bj][m][1];
                        float s = (a[0] * a[0] + a[1] * a[1]) + (a[2] * a[2] + a[3] * a[3]) + (b[0] * b[0] + b[1] * b[1]) + (b[2] * b[2] + b[3] * b[3]);
                        s += __shfl_xor(s, 16); s += __shfl_xor(s, 32);
                        if (fq == 0) xl[((ai * HALF + wr * 64 + m * 16 + fr) * 2 + bj) * 4 + wc] = s; }
            EPI_LDSBAR();
            const float* gp = gains + (seg - (seg >= 3 ? 1 : 0)) * 1024 + (colt & 1023) + wc * 32 + 8 * fq;
            const float qs = (seg == 0 || seg == 3) ? QSCALE : 1.f;
            f32x4 g[2][2];
#pragma unroll
            for (int bj = 0; bj < 2; ++bj)
#pragma unroll
                for (int n = 0; n < 2; ++n) g[bj][n] = *(const f32x4*)(gp + bj * HALF + 4 * n) * qs;
            bf16_t* base = QKV + colt + wc * 32 + 8 * fq;
#pragma unroll
            for (int ai = 0; ai < 2; ++ai)
#pragma unroll
                for (int m = 0; m < 4; ++m) { bf16_t* rowp = base + (size_t)(row0 + ai * HALF + m * 16) * 6144;
#pragma unroll
                    for (int bj = 0; bj < 2; ++bj) { const f32x4 p = *(const PG8_LAS f32x4*)(xl + ((ai * HALF + wr * 64 + m * 16 + fr) * 2 + bj) * 4);
                        const float rs = __builtin_amdgcn_rsqf(((p[0] + p[1]) + (p[2] + p[3])) * (1.f / 128.f) + EPSN);
                        *(u32x4e*)(rowp + bj * HALF) = pack8f(acc[ai][bj][m][0] * rs * g[bj][0], acc[ai][bj][m][1] * rs * g[bj][1]); } }
        }
    }
};

__device__ __forceinline__ void gate8(const bf16_t* p, f32x4& s0, f32x4& s1) {
    const u32x4e w = *(const u32x4e*)p;
    s0[0] = sigm(bflo(w.x)); s0[1] = sigm(bfhi(w.x)); s0[2] = sigm(bflo(w.y)); s0[3] = sigm(bfhi(w.y));
    s1[0] = sigm(bflo(w.z)); s1[1] = sigm(bfhi(w.z)); s1[2] = sigm(bflo(w.w)); s1[3] = sigm(bfhi(w.w));
}
struct EpiBr {
    static constexpr bool PERM = true, AFTER_DRAIN = false, HAS_MID = true;
    const bf16_t* G; bf16_t* MG;
    __device__ __forceinline__ void mid(f32x4 (&acc)[2][2][4][2], const Unit& u, int wr, int wc, int fr_in, int fq_in) const {
        (void)fr_in; (void)fq_in; int ln_ = (int)(threadIdx.x & 63u); asm volatile("" : "+v"(ln_)); const int fr = ln_ & 15, fq = ln_ >> 4;
        const int row0 = u.pm * BM + wr * 64 + fr, col0 = u.pn * BM + wc * 32 + 8 * fq;
#define RAT(x, y) ((1.f + __builtin_amdgcn_exp2f(-(y) * LOG2E)) * __builtin_amdgcn_rcpf(1.f + __builtin_amdgcn_exp2f(-(x) * LOG2E)))
#pragma unroll
        for (int ai = 0; ai < 2; ++ai) {
            u32x4e ga[4][2], gb[4][2];
#pragma unroll
            for (int m = 0; m < 4; ++m)
#pragma unroll
                for (int bj = 0; bj < 2; ++bj) { const bf16_t* gp = G + (size_t)(row0 + ai * HALF + m * 16) * 4096 + col0 + bj * HALF; ga[m][bj] = *(const u32x4e*)gp; gb[m][bj] = *(const u32x4e*)(gp + 2048); }
#pragma unroll
            for (int m = 0; m < 4; ++m)
#pragma unroll
                for (int bj = 0; bj < 2; ++bj) { const u32x4e a = ga[m][bj], b = gb[m][bj]; f32x4 r0, r1;
                    r0[0] = RAT(bflo(a.x), bflo(b.x)); r0[1] = RAT(bfhi(a.x), bfhi(b.x)); r0[2] = RAT(bflo(a.y), bflo(b.y)); r0[3] = RAT(bfhi(a.y), bfhi(b.y));
                    r1[0] = RAT(bflo(a.z), bflo(b.z)); r1[1] = RAT(bfhi(a.z), bfhi(b.z)); r1[2] = RAT(bflo(a.w), bflo(b.w)); r1[3] = RAT(bfhi(a.w), bfhi(b.w));
                    acc[ai][bj][m][0] = acc[ai][bj][m][0] * r0; acc[ai][bj][m][1] = acc[ai][bj][m][1] * r1; }
            asm volatile("" ::: "memory"); __builtin_amdgcn_sched_barrier(0); }
#undef RAT
    }
    __device__ __forceinline__ void operator()(f32x4 (&acc)[2][2][4][2], const Unit& u, int wr, int wc, int fr, int fq) const {
        const int row0 = u.pm * BM + wr * 64 + fr, col0 = u.pn * BM + wc * 32 + 8 * fq;
#pragma unroll
        for (int ai = 0; ai < 2; ++ai)
#pragma unroll
            for (int m = 0; m < 4; ++m) { const size_t row = (size_t)(row0 + ai * HALF + m * 16);
#pragma unroll
                for (int bj = 0; bj < 2; ++bj) { const int col = col0 + bj * HALF; f32x4 s0, s1; gate8(G + row * 4096 + 2048 + col, s0, s1);
                    *(u32x4e*)(MG + row * 2048 + col) = pack8f(acc[ai][bj][m][0] * s0, acc[ai][bj][m][1] * s1); } }
    }
};
struct EpiOut {
    static constexpr bool PERM = true, AFTER_DRAIN = true, HAS_MID = false;
    const float* X; bf16_t* XB; float* SSQ;
    __device__ __forceinline__ void fused(f32x4 (&acc)[2][2][4][2], const Unit& u, int wr, int wc, int fr, int fq, PG8_LAS unsigned char* lds, int wid, int lane) const {
        PG8_LAS float* P = (PG8_LAS float*)lds;
        const int row0 = u.pm * BM + wr * 64 + fr, col0 = u.pn * BM + wc * 32 + 8 * fq;
#pragma unroll
        for (int ai = 0; ai < 2; ++ai) { f32x4 xa[4][2][2];
#pragma unroll
            for (int m = 0; m < 4; ++m)
#pragma unroll
                for (int bj = 0; bj < 2; ++bj) { const size_t off = (size_t)(row0 + ai * HALF + m * 16) * 2048 + col0 + bj * HALF;
                    xa[m][bj][0] = __builtin_nontemporal_load((const f32x4*)(X + off)); xa[m][bj][1] = __builtin_nontemporal_load((const f32x4*)(X + off + 4)); }
#pragma unroll
            for (int m = 0; m < 4; ++m) { const size_t row = (size_t)(row0 + ai * HALF + m * 16); float ss = 0.f;
#pragma unroll
                for (int bj = 0; bj < 2; ++bj) { const size_t off = row * 2048 + col0 + bj * HALF;
                    const f32x4 v0 = acc[ai][bj][m][0] + xa[m][bj][0], v1 = acc[ai][bj][m][1] + xa[m][bj][1];
                    *(u32x4e*)(XB + off) = pack8f(v0, v1);
                    ss += (v0[0] * v0[0] + v0[1] * v0[1]) + (v0[2] * v0[2] + v0[3] * v0[3]) + (v1[0] * v1[0] + v1[1] * v1[1]) + (v1[2] * v1[2] + v1[3] * v1[3]); }
                ss += __shfl_xor(ss, 16); ss += __shfl_xor(ss, 32);
                if (fq == 0) P[(ai * HALF + wr * 64 + m * 16 + fr) * 4 + wc] = ss; } }
        EPI_LDSBAR();
        const int tid = wid * 64 + lane;
        if (tid < 256) { const f32x4 p = *(const PG8_LAS f32x4*)(P + tid * 4); SSQ[(size_t)(u.pm * BM + tid) * 8 + u.pn] = (p[0] + p[1]) + (p[2] + p[3]); }
    }
};
#ifndef CONV_LDSW
#define CONV_LDSW 0
#endif
__device__ __forceinline__ float ror1f(float v) { return __builtin_bit_cast(float, __builtin_amdgcn_update_dpp(0, __builtin_bit_cast(int, v), 0x121, 0xf, 0xf, false)); }
__device__ __forceinline__ float ror2f(float v) { return __builtin_bit_cast(float, __builtin_amdgcn_update_dpp(0, __builtin_bit_cast(int, v), 0x122, 0xf, 0xf, false)); }
struct EpiUpConv {
    static constexpr bool PERM = true, AFTER_DRAIN = false, HAS_MID = false;
    const float* RSTD; const float* wconv; const float* bconv; bf16_t* ACT; float* US; PG8_LAS float* xl;
    __device__ __forceinline__ void operator()(f32x4 (&acc)[2][2][4][2], const Unit& u, int wr, int wc, int fr_in, int fq_in) const {
        typedef unsigned u32x2e __attribute__((ext_vector_type(2)));
        PG8_LAS float* wl = xl + (unsigned)(wr * 4 + wc) * 256u;
        { const unsigned L_ = threadIdx.x & 63u, ucol_ = (L_ >> 5) * 5632u + (unsigned)u.pn * 128u + (unsigned)wc * 32u + (L_ & 31u);
          const float t0_ = wconv[ucol_], t1_ = wconv[11264u + ucol_], t2_ = wconv[22528u + ucol_], t3_ = bconv[ucol_];
          wl[L_] = t0_; wl[64u + L_] = t1_; wl[128u + L_] = t2_; wl[192u + L_] = t3_;
          asm volatile("s_waitcnt lgkmcnt(0)" ::: "memory"); }
        (void)fr_in; (void)fq_in; int ln_ = (int)(threadIdx.x & 63u); asm volatile("" : "+v"(ln_)); const int fr = ln_ & 15, fq = ln_ >> 4;
        const unsigned cw = (unsigned)(u.pn * 128 + wc * 32 + 8 * fq), row0 = (unsigned)(u.pm * BM + wr * 64 + fr);
        const bool lo = fr < 2, hi14 = fr >= 14, f1 = fr >= 1, f2 = fr >= 2;
#pragma unroll
        for (int ai = 0; ai < 2; ++ai) { const unsigned G = (unsigned)(4 * u.pm + 2 * ai + wr);
            float rs[4];
#pragma unroll
            for (int m = 0; m < 4; ++m) rs[m] = RSTD[row0 + ai * HALF + m * 16];
            const unsigned aoff = (row0 + ai * HALF) * 5632u + cw;
            const unsigned us_lo = (G * 4 + 2 + (fr & 1)) * 11264u; const bool sthi = hi14 && (G + 1 < 128);
#pragma unroll
            for (int n = 0; n < 2; ++n) {
#pragma unroll
                for (int j = 0; j < 4; ++j) { unsigned col = cw + 4 * n + j; asm volatile("" : "+v"(col));
#pragma unroll
                    for (int bj = 0; bj < 2; ++bj) { const unsigned ucol = bj * 5632 + col;
                        const unsigned lc = (unsigned)bj * 32u + (col - (unsigned)u.pn * 128u - (unsigned)wc * 32u);
                        const float w0 = wl[lc], w1 = wl[64u + lc], w2 = wl[128u + lc], bb = wl[192u + lc];
                        float pa1 = 0.f, pa2 = 0.f;
#pragma unroll
                        for (int m = 0; m < 4; ++m) { const float uu = acc[ai][bj][m][n][j] * rs[m];
                            if (m == 0) { if (lo) US[us_lo + ucol] = uu; }
                            if (m == 3) { if (sthi) US[us_lo + 22528u + ucol] = uu; }
                            const float a1 = ror1f(uu), a2 = ror2f(uu);
                            const float p1 = f1 ? a1 : pa1, p2 = f2 ? a2 : pa2;
                            acc[ai][bj][m][n][j] = fmaf(w0, p2, fmaf(w1, p1, fmaf(w2, uu, bb)));
                            pa1 = a1; pa2 = a2; }
                        }
#pragma unroll
                    for (int m = 0; m < 4; ++m) { const float g0 = acc[ai][0][m][n][j]; acc[ai][0][m][n][j] = g0 * sigm(g0) * acc[ai][1][m][n][j]; }
                    asm volatile("" ::: "memory"); }
#pragma unroll
                for (int m = 0; m < 4; ++m) { u32x2e w; w.x = cvt_pk_bf16(acc[ai][0][m][n][0], acc[ai][0][m][n][1]); w.y = cvt_pk_bf16(acc[ai][0][m][n][2], acc[ai][0][m][n][3]);
                    if (!(m == 0 && lo)) *(u32x2e*)(ACT + (aoff + (unsigned)(m * 16 * 5632 + 4 * n))) = w; }
                asm volatile("" ::: "memory"); __builtin_amdgcn_sched_barrier(0); } }
    }
};
struct EpiUp {
    static constexpr bool PERM = true, AFTER_DRAIN = false, HAS_MID = false;
    const float* RSTD; bf16_t* U;
    __device__ __forceinline__ void operator()(f32x4 (&acc)[2][2][4][2], const Unit& u, int wr, int wc, int fr, int fq) const {
        const int row0 = u.pm * BM + wr * 64 + fr, col0 = u.pn * BM + wc * 32 + 8 * fq;
#pragma unroll
        for (int ai = 0; ai < 2; ++ai)
#pragma unroll
            for (int m = 0; m < 4; ++m) { const int row = row0 + ai * HALF + m * 16; const float rs = RSTD[row]; bf16_t* rowp = U + (size_t)row * 11264 + col0;
#pragma unroll
                for (int bj = 0; bj < 2; ++bj) *(u32x4e*)(rowp + bj * HALF) = pack8f(acc[ai][bj][m][0] * rs, acc[ai][bj][m][1] * rs); }
    }
};
struct EpiFinal {
    static constexpr bool PERM = true, AFTER_DRAIN = false, HAS_MID = false;
    const bf16_t* XB; float* OUT;
    __device__ __forceinline__ void operator()(f32x4 (&acc)[2][2][4][2], const Unit& u, int wr, int wc, int fr, int fq) const {
        const int row0 = u.pm * BM + wr * 64 + fr, col0 = u.pn * BM + wc * 32 + 8 * fq;
#pragma unroll
        for (int ai = 0; ai < 2; ++ai)
#pragma unroll
            for (int m = 0; m < 4; ++m)
#pragma unroll
                for (int bj = 0; bj < 2; ++bj) { const size_t off = (size_t)(row0 + ai * HALF + m * 16) * 2048 + col0 + bj * HALF;
                    const u32x4e w = __builtin_nontemporal_load((const u32x4e*)(XB + off));
                    const f32x4 a = {bflo(w.x), bfhi(w.x), bflo(w.y), bfhi(w.y)}, b = {bflo(w.z), bfhi(w.z), bflo(w.w), bfhi(w.w)};
                    __builtin_nontemporal_store(a + acc[ai][bj][m][0], (f32x4*)(OUT + off)); __builtin_nontemporal_store(b + acc[ai][bj][m][1], (f32x4*)(OUT + off + 4)); }
    }
};

template <class Epi, class Sched, bool ALIGN_EPI = false, bool SP2 = false>
__device__ __forceinline__ void gemm_phase(PG8_LAS unsigned char* lds, const Gemm g, const Sched& S, const Epi& E) {
    int tid_o = threadIdx.x; asm volatile("" : "+v"(tid_o));
    const int tid = tid_o, wid = __builtin_amdgcn_readfirstlane(tid >> 6), lane = tid & 63, wr = wid >> 2, wc = wid & 3, fr = lane & 15, fq = lane >> 4;
    const int K = g.K, nt = K / BK;
    unsigned voffA[1], voffB[1];
#pragma unroll
    for (int i = 0; i < 1; ++i) { int R, C; stage_rc(tid * 16 + i * 8192, R, C); const int Rb = Epi::PERM ? ((R & ~31) + perm32(R & 31)) : R;
        voffA[i] = (unsigned)(R * K + C) * 2u; voffB[i] = (unsigned)(Rb * K + C) * 2u; }
    const size_t vstep = (size_t)K * 128;
    const size_t kstep = (size_t)(BK * 2);
    const size_t hstep = (size_t)HALF * K * 2;
    const size_t tstep = 2 * hstep;
    const unsigned ldsw = (unsigned)wid * 1024u;
    const int aoff = lds_byte(wr * 64 + fr, fq * 8), boff = lds_byte(wc * 32 + fr, fq * 8);
#define PG8_SA(b, h) (((b) * 2 + (h)) * HTB)
#define PG8_SB(b, h) ((4 + (b) * 2 + (h)) * HTB)
#define PG8_STAGE(bufoff, gbase, voff) do { _Pragma("unroll") for (int _i = 0; _i < 2; ++_i) \
        __builtin_amdgcn_global_load_lds((const unsigned*)((const char*)(gbase) + (size_t)_i * vstep + (voff)[0]), (PG8_LAS unsigned*)(lds + (bufoff) + ldsw + _i * 8192), 16, 0, 0); } while (0)
#define PG8_LDA(dst, b, h) do { _Pragma("unroll") for (int m = 0; m < 4; ++m) _Pragma("unroll") for (int k = 0; k < 2; ++k) dst[m][k] = *(const PG8_LAS bf16x8*)(lds + PG8_SA(b, h) + aoff + m * 2048 + k * 1024); } while (0)
#define PG8_LDB(dst, b, h) do { _Pragma("unroll") for (int n = 0; n < 2; ++n) _Pragma("unroll") for (int k = 0; k < 2; ++k) dst[n][k] = *(const PG8_LAS bf16x8*)(lds + PG8_SB(b, h) + boff + n * 2048 + k * 1024); } while (0)
#define PG8_MMA(ai, bj, At, Bt) do { __builtin_amdgcn_s_setprio(1); _Pragma("unroll") for (int m = 0; m < 4; ++m) _Pragma("unroll") for (int n = 0; n < 2; ++n) _Pragma("unroll") for (int k = 0; k < 2; ++k) \
        acc[ai][bj][m][n] = __builtin_amdgcn_mfma_f32_16x16x32_bf16(Bt[n][k], At[m][k], acc[ai][bj][m][n], 0, 0, 0); __builtin_amdgcn_s_setprio(0); } while (0)
#define PG8_WAIT_V(n) asm volatile("s_waitcnt vmcnt(" #n ")" ::: "memory")
#define PG8_WAIT_L(n) asm volatile("s_waitcnt lgkmcnt(" #n ")" ::: "memory")
#define PG8_BAR __builtin_amdgcn_s_barrier()
#define PG8_SCHED __builtin_amdgcn_sched_barrier(0)
    Unit cur, nxt; int ui = 0;
    if (!S.next(0, cur)) return;
    f32x4 acc[2][2][4][2];
#pragma unroll
    for (int a = 0; a < 2; ++a)
#pragma unroll
        for (int b = 0; b < 2; ++b)
#pragma unroll
            for (int m = 0; m < 4; ++m)
#pragma unroll
                for (int n = 0; n < 2; ++n) acc[a][b][m][n] = (f32x4){0.f, 0.f, 0.f, 0.f};
    bf16x8 At[4][2], B0[2][2], B1[2][2];
    const char* cA = (const char*)g.A + (size_t)cur.pm * tstep; const char* cB = (const char*)g.Bt + (size_t)cur.pn * tstep;
    S.a_ready(cur);
    if constexpr (SP2) {
        PG8_STAGE(PG8_SB(0, 0), cB, voffB); PG8_STAGE(PG8_SB(0, 1), cB + hstep, voffB); PG8_STAGE(PG8_SA(0, 0), cA, voffA); PG8_STAGE(PG8_SA(0, 1), cA + hstep, voffA);
        if (wr == 1) PG8_BAR;
        PG8_WAIT_V(2); PG8_BAR;
        PG8_STAGE(PG8_SB(1, 0), cB + kstep, voffB); PG8_STAGE(PG8_SA(1, 0), cA + kstep, voffA); PG8_STAGE(PG8_SB(1, 1), cB + hstep + kstep, voffB);
        PG8_WAIT_V(6); PG8_BAR;
    } else {
        PG8_STAGE(PG8_SB(0, 0), cB, voffB); PG8_STAGE(PG8_SA(0, 0), cA, voffA); PG8_STAGE(PG8_SB(0, 1), cB + hstep, voffB); PG8_STAGE(PG8_SA(0, 1), cA + hstep, voffA);
        if (wr == 1) PG8_BAR;
        PG8_WAIT_V(4); PG8_BAR;
        PG8_STAGE(PG8_SB(1, 0), cB + kstep, voffB); PG8_STAGE(PG8_SA(1, 0), cA + kstep, voffA); PG8_STAGE(PG8_SB(1, 1), cB + hstep + kstep, voffB);
        PG8_WAIT_V(6); PG8_BAR;
    }
    for (;;) {
        const bool has_next = S.next(ui + 1, nxt);
        const char* nA = has_next ? (const char*)g.A + (size_t)nxt.pm * tstep : cA; const char* nB = has_next ? (const char*)g.Bt + (size_t)nxt.pn * tstep : cB;
        for (int t = 0; t < nt; t += 2) {
            if constexpr (Epi::HAS_MID) { if (t == (nt >> 1)) E.mid(acc, cur, wr, wc, fr, fq); }
            const bool last = (t == nt - 2);
            const char* a1 = cA + (size_t)(t + 1) * kstep;
            const char* a2 = last ? nA : cA + (size_t)(t + 2) * kstep; const char* b2 = last ? nB : cB + (size_t)(t + 2) * kstep;
            const char* a3 = a2 + kstep; const char* b3 = b2 + kstep;
            if (last && has_next) S.a_ready(nxt);
            if constexpr (SP2) {
            PG8_LDB(B0, 0, 0); PG8_LDB(B1, 0, 1); PG8_SCHED; PG8_LDA(At, 0, 0); PG8_STAGE(PG8_SA(1, 1), a1 + hstep, voffA);
            PG8_WAIT_V(8); PG8_WAIT_L(0); PG8_BAR; PG8_MMA(0, 0, At, B0); PG8_MMA(0, 1, At, B1); PG8_BAR; PG8_SCHED;
            PG8_LDA(At, 0, 1); PG8_STAGE(PG8_SB(0, 0), b2, voffB); PG8_STAGE(PG8_SB(0, 1), b2 + hstep, voffB); PG8_STAGE(PG8_SA(0, 0), a2, voffA);
            PG8_WAIT_V(8); PG8_WAIT_L(0); PG8_BAR; PG8_MMA(1, 0, At, B0); PG8_MMA(1, 1, At, B1); PG8_BAR; PG8_SCHED;
            PG8_LDB(B0, 1, 0); PG8_LDB(B1, 1, 1); PG8_SCHED; PG8_LDA(At, 1, 0); PG8_STAGE(PG8_SA(0, 1), a2 + hstep, voffA);
            PG8_WAIT_V(8); PG8_WAIT_L(0); PG8_BAR; PG8_MMA(0, 0, At, B0); PG8_MMA(0, 1, At, B1); PG8_BAR; PG8_SCHED;
            PG8_LDA(At, 1, 1); PG8_STAGE(PG8_SB(1, 0), b3, voffB); PG8_STAGE(PG8_SB(1, 1), b3 + hstep, voffB); PG8_STAGE(PG8_SA(1, 0), a3, voffA);
            PG8_WAIT_V(8); PG8_WAIT_L(0); PG8_BAR; PG8_MMA(1, 0, At, B0); PG8_MMA(1, 1, At, B1); PG8_BAR; PG8_SCHED;
            } else {
            PG8_LDB(B0, 0, 0); PG8_SCHED; PG8_LDA(At, 0, 0); PG8_STAGE(PG8_SA(1, 1), a1 + hstep, voffA);
            PG8_WAIT_L(8); PG8_BAR; PG8_WAIT_L(0); PG8_MMA(0, 0, At, B0); PG8_BAR; PG8_SCHED;
            PG8_LDB(B1, 0, 1); PG8_STAGE(PG8_SB(0, 0), b2, voffB);
            PG8_BAR; PG8_WAIT_L(0); PG8_MMA(0, 1, At, B1); PG8_BAR;
            PG8_LDA(At, 0, 1); PG8_STAGE(PG8_SA(0, 0), a2, voffA);
            PG8_BAR; PG8_WAIT_L(0); PG8_MMA(1, 0, At, B0); PG8_BAR; PG8_SCHED;
            PG8_STAGE(PG8_SB(0, 1), b2 + hstep, voffB);
            PG8_WAIT_V(6); PG8_BAR; PG8_MMA(1, 1, At, B1); PG8_BAR;
            PG8_LDB(B0, 1, 0); PG8_SCHED; PG8_LDA(At, 1, 0); PG8_STAGE(PG8_SA(0, 1), a2 + hstep, voffA);
            PG8_WAIT_L(8); PG8_BAR; PG8_WAIT_L(0); PG8_MMA(0, 0, At, B0); PG8_BAR; PG8_SCHED;
            PG8_LDB(B1, 1, 1); PG8_STAGE(PG8_SB(1, 0), b3, voffB);
            PG8_BAR; PG8_WAIT_L(0); PG8_MMA(0, 1, At, B1); PG8_BAR;
            PG8_LDA(At, 1, 1); PG8_STAGE(PG8_SA(1, 0), a3, voffA);
            PG8_BAR; PG8_WAIT_L(0); PG8_MMA(1, 0, At, B0); PG8_BAR; PG8_SCHED;
            PG8_STAGE(PG8_SB(1, 1), b3 + hstep, voffB);
            PG8_WAIT_V(6); PG8_BAR; PG8_MMA(1, 1, At, B1); PG8_BAR;
            }
        }
        if constexpr (ALIGN_EPI) { if (wr == 0) PG8_BAR; }
        if constexpr (!Epi::AFTER_DRAIN) { E(acc, cur, wr, wc, fr, fq); S.done(cur); }
        if (!has_next) break;
#pragma unroll
        for (int a = 0; a < 2; ++a)
#pragma unroll
            for (int b = 0; b < 2; ++b)
#pragma unroll
                for (int m = 0; m < 4; ++m)
#pragma unroll
                    for (int n = 0; n < 2; ++n) acc[a][b][m][n] = (f32x4){0.f, 0.f, 0.f, 0.f};
        cur = nxt; cA = nA; cB = nB; ++ui;
        if constexpr (ALIGN_EPI) { if (wr == 1) PG8_BAR; }
    }
    PG8_WAIT_V(0);
    if constexpr (!ALIGN_EPI) { if (wr == 0) PG8_BAR; }
    PG8_BAR;
    if constexpr (Epi::AFTER_DRAIN) { E.fused(acc, cur, wr, wc, fr, fq, lds, wid, lane); S.done(cur); }
#undef PG8_SA
#undef PG8_SB
#undef PG8_STAGE
#undef PG8_LDA
#undef PG8_LDB
#undef PG8_MMA
#undef PG8_WAIT_V
#undef PG8_WAIT_L
#undef PG8_BAR
#undef PG8_SCHED
}
}

namespace att {
typedef unsigned short bf16;
constexpr int D = 128, NW = 8, QBLK = 32, KVBLK = 64, QB = NW * QBLK;
constexpr int SHM_V = KVBLK * D * 2, SHM_K = KVBLK * D * 2;
constexpr int LDS_WS = 2 * SHM_V + 2 * SHM_K, LDS_KB = LDS_WS + NW * 64 * 4, LDS_SLOT = LDS_KB + 2 * 64 * 4, LDS_Q = LDS_SLOT + 256, LDS_END = LDS_Q + NW * 8192;
constexpr float SCALE = 1.f, THR = 8.f;
typedef short bf16x8 __attribute__((ext_vector_type(8)));
typedef short s16x4 __attribute__((ext_vector_type(4)));
typedef float f32x16 __attribute__((ext_vector_type(16)));
typedef float f32x4 __attribute__((ext_vector_type(4)));
typedef unsigned u32x4 __attribute__((ext_vector_type(4)));
template <class A, class Bt> struct same_t { static constexpr bool v = false; };
template <class A> struct same_t<A, A> { static constexpr bool v = true; };

#define KSWZ(row, colB) ((row) * 256 + ((colB) ^ (((row) & 7) << 4)))
#define SBAR() __builtin_amdgcn_sched_barrier(0)
__device__ __forceinline__ int v_st(int k, int c) { const int kk = (k & ~0xC) | ((k & 4) << 1) | ((k & 8) >> 1); return ((kk >> 3) * 4 + (c >> 5)) * 512 + ((kk & 7) * 32 + (c & 31)) * 2; }
__device__ __forceinline__ int v_rd_base(int lane) { return ((lane & 3) << 3) | (((lane >> 2) & 3) << 6) | (((lane >> 4) & 1) << 5) | (((lane >> 5) & 1) << 8); }
constexpr int v_rd_off(int d0, int ks, int half) { return d0 * 512 + ks * 4096 + half * 2048; }
__device__ __forceinline__ int crow(int r, int hi) { return (r & 3) + 8 * (r >> 2) + 4 * hi; }
__device__ __forceinline__ unsigned cvtpk(float lo, float hi) {
    unsigned r; asm volatile("v_cvt_pk_bf16_f32 %0, %1, %2" : "=v"(r) : "v"(lo), "v"(hi)); return r;
}
__device__ __forceinline__ bf16x8 pack8(f32x4 a, f32x4 b) {
    u32x4 w = {cvtpk(a[0], a[1]), cvtpk(a[2], a[3]), cvtpk(b[0], b[1]), cvtpk(b[2], b[3])};
    return *reinterpret_cast<bf16x8*>(&w);
}
template <class T> __device__ __forceinline__ bf16x8 load8(const T* p) {
    if constexpr (same_t<T, float>::v) { return pack8(*(const f32x4*)p, *(const f32x4*)(p + 4)); }
    else { return *reinterpret_cast<const bf16x8*>(p); }
}
__device__ __forceinline__ void mask_tile(f32x16& p0, f32x16& p1, int dq, unsigned W) {
    const float NEG = -__builtin_inff();
#pragma unroll
    for (int r = 0; r < 16; ++r) {
        const int c = (r & 3) + 8 * (r >> 2);
        if ((unsigned)(dq - c) >= W) p0[r] = NEG;
        if ((unsigned)(dq - c - 32) >= W) p1[r] = NEG;
    }
}
__device__ __forceinline__ void partialSM(f32x16& p0, f32x16& p1, float& m_reg, float& mn, float& alpha) {
    float pmax = p0[0]; for (int r = 1; r < 16; ++r) pmax = fmaxf(pmax, p0[r]); for (int r = 0; r < 16; ++r) pmax = fmaxf(pmax, p1[r]);
    { auto rr = __builtin_amdgcn_permlane32_swap(__float_as_uint(pmax), __float_as_uint(pmax), false, false);
      pmax = fmaxf(__uint_as_float(rr[0]), __uint_as_float(rr[1])); }
    constexpr float C2 = 1.f;
    if (__builtin_expect(__all((pmax - m_reg) * SCALE <= THR), 1)) { mn = m_reg; alpha = 1.f; }
    else { mn = fmaxf(m_reg, pmax); alpha = __builtin_amdgcn_exp2f((m_reg - mn) * C2); m_reg = mn; }
    const float mnL = -mn * C2;
    for (int r = 0; r < 16; ++r) p0[r] = fmaf(p0[r], C2, mnL); for (int r = 0; r < 16; ++r) p1[r] = fmaf(p1[r], C2, mnL);
    for (int r = 0; r < 16; ++r) p0[r] = __builtin_amdgcn_exp2f(p0[r]);
}
__device__ __forceinline__ void finishSM(f32x16& p0, f32x16& p1, float alpha, float& l_reg, bf16x8& pa0, bf16x8& pa1, bf16x8& pa2, bf16x8& pa3) {
    for (int r = 0; r < 16; ++r) p1[r] = __builtin_amdgcn_exp2f(p1[r]);
    float ps = 0; for (int r = 0; r < 16; ++r) ps += p0[r]; for (int r = 0; r < 16; ++r) ps += p1[r];
    { auto rr = __builtin_amdgcn_permlane32_swap(__float_as_uint(ps), __float_as_uint(ps), false, false);
      ps = __uint_as_float(rr[0]) + __uint_as_float(rr[1]); }
    l_reg = l_reg * alpha + ps;
#define PK4(P, B_, OUT) do { unsigned a0 = cvtpk(P[B_+0], P[B_+1]), a1 = cvtpk(P[B_+2], P[B_+3]);                          \
        unsigned b0 = cvtpk(P[B_+4], P[B_+5]), b1 = cvtpk(P[B_+6], P[B_+7]);                                             \
        auto r0 = __builtin_amdgcn_permlane32_swap(a0, b0, false, false); auto r1 = __builtin_amdgcn_permlane32_swap(a1, b1, false, false); \
        u32x4 w = {r0[0], r1[0], r0[1], r1[1]}; OUT = *reinterpret_cast<bf16x8*>(&w); } while (0)
    PK4(p0, 0, pa0); PK4(p0, 8, pa1); PK4(p1, 0, pa2); PK4(p1, 8, pa3);
#undef PK4
}
template <int KB, bool SK>
__device__ __forceinline__ void qkt(f32x16& p0, f32x16& p1, const char* K_lds, const float* kbl, int r32, int hi, const __attribute__((address_space(3))) char* q_lds, bool act) {
    if (SK && !act) { const float NEG = -__builtin_inff();
#pragma unroll
        for (int r = 0; r < 16; ++r) { p0[r] = NEG; p1[r] = NEG; } return; }
    { const float* kb_ = kbl + KB * 64 + 4 * hi;
#pragma unroll
      for (int j = 0; j < 4; ++j) { const f32x4 a = *(const f32x4*)(kb_ + 8 * j), b = *(const f32x4*)(kb_ + 32 + 8 * j);
          p0[4 * j] = a[0]; p0[4 * j + 1] = a[1]; p0[4 * j + 2] = a[2]; p0[4 * j + 3] = a[3];
          p1[4 * j] = b[0]; p1[4 * j + 1] = b[1]; p1[4 * j + 2] = b[2]; p1[4 * j + 3] = b[3]; } }
    const char* kb[4];
#pragma unroll
    for (int dd = 0; dd < 4; ++dd) kb[dd] = K_lds + KB * SHM_K + KSWZ(r32, (dd * 16 + hi * 8) * 2);
#pragma unroll
    for (int d0 = 0; d0 < 8; ++d0) { const char* a = kb[d0 & 3] + (d0 >> 2) * 128;
        bf16x8 b0 = *reinterpret_cast<const bf16x8*>(a);
        bf16x8 b1 = *reinterpret_cast<const bf16x8*>(a + 32 * 256);
        const bf16x8 q_ = *(const __attribute__((address_space(3))) bf16x8*)(q_lds + d0 * 1024);
        p0 = __builtin_amdgcn_mfma_f32_32x32x16_bf16(b0, q_, p0, 0, 0, 0);
        p1 = __builtin_amdgcn_mfma_f32_32x32x16_bf16(b1, q_, p1, 0, 0, 0); }
}
template <int VB, bool SK>
__device__ __forceinline__ void pv_tile(f32x16* o, int vb0, bf16x8 pa0, bf16x8 pa1, bf16x8 pa2, bf16x8 pa3, bool act) {
    if (SK && !act) return;
#define TRRD(dst, off) asm volatile("ds_read_b64_tr_b16 %0, %1 offset:%2" : "=&v"(dst) : "v"(vb0), "i"(off) : "memory")
#define PV_D0(d0) do { s16x4 l0, l1, l2, l3, h0, h1, h2, h3; constexpr int b_ = VB * SHM_V + v_rd_off(d0, 0, 0);     \
        TRRD(l0, b_); TRRD(h0, b_ + 2048); TRRD(l1, b_ + 4096); TRRD(h1, b_ + 6144); TRRD(l2, b_ + 8192); TRRD(h2, b_ + 10240); TRRD(l3, b_ + 12288); TRRD(h3, b_ + 14336); \
        asm volatile("s_waitcnt lgkmcnt(0)" ::: "memory"); SBAR();                 \
        o[d0] = __builtin_amdgcn_mfma_f32_32x32x16_bf16(pa0, (bf16x8){l0[0], l0[1], l0[2], l0[3], h0[0], h0[1], h0[2], h0[3]}, o[d0], 0, 0, 0);   \
        o[d0] = __builtin_amdgcn_mfma_f32_32x32x16_bf16(pa1, (bf16x8){l1[0], l1[1], l1[2], l1[3], h1[0], h1[1], h1[2], h1[3]}, o[d0], 0, 0, 0);   \
        o[d0] = __builtin_amdgcn_mfma_f32_32x32x16_bf16(pa2, (bf16x8){l2[0], l2[1], l2[2], l2[3], h2[0], h2[1], h2[2], h2[3]}, o[d0], 0, 0, 0);   \
        o[d0] = __builtin_amdgcn_mfma_f32_32x32x16_bf16(pa3, (bf16x8){l3[0], l3[1], l3[2], l3[3], h3[0], h3[1], h3[2], h3[3]}, o[d0], 0, 0, 0); } while (0)
    PV_D0(0); PV_D0(1); PV_D0(2); PV_D0(3);
#undef PV_D0
#undef TRRD
}

constexpr float LOG2E = 1.4426950408889634f;
struct Blk {
    const bf16* Q; const bf16* K; const bf16* V; bf16* O; float* LSE; const float* CUM;
    long rs, os; int ls;
    int P0, L, W, nvalid; float sd2, cref;
};
struct Seam { bf16x8 st_v0, st_v1, st_k0, st_k1; float st_b0, st_b1; };
__device__ __forceinline__ float kbias_raw(const Blk& B, int key) { return B.CUM ? B.CUM[key] : B.sd2 * (float)(key - B.P0); }
__device__ __forceinline__ float kbias_fin(const Blk& B, float raw) { return B.CUM ? -raw * LOG2E : raw; }
__device__ __forceinline__ int swa_jlo(int P0, int W) { const int lowk = P0 - W + 1; return lowk > 0 ? lowk / KVBLK : 0; }
__device__ __forceinline__ int swa_jhi(int P0, int L) { int j = (P0 + QB - 1) / KVBLK + 1; const int jm = L / KVBLK; return j > jm ? jm : j; }
__device__ __forceinline__ bf16x8 ld8(const bf16* p) { return *reinterpret_cast<const bf16x8*>(p); }
#define ROWP(p, rs_, k0, rr) ((p) + (size_t)(k0) * (rs_) + (unsigned)(((rr) * (int)(rs_)) + sc))
#define VMW() asm volatile("s_waitcnt vmcnt(0)" ::: "memory")
#define SLOAD(B_, k0) do { const bf16* vb_ = (B_).V + (size_t)(k0) * (B_).rs; const bf16* kb_ = (B_).K + (size_t)(k0) * (B_).rs;     \
                           unsigned o0_ = (unsigned)(sr * (int)(B_).rs + sc), o1_ = o0_ + 32u * (unsigned)(B_).rs; asm volatile("" : "+v"(o0_), "+v"(o1_));       \
                           S.st_v0 = ld8(vb_ + o0_); S.st_v1 = ld8(vb_ + o1_); S.st_k0 = ld8(kb_ + o0_); S.st_k1 = ld8(kb_ + o1_);                                  \
                           if ((tid & 15) == 0) { S.st_b0 = kbias_raw((B_), (k0) + sr); S.st_b1 = kbias_raw((B_), (k0) + 32 + sr); } } while (0)
#define SWRITE_K(bf, B_) do { *(bf16x8*)(K_lds + (bf) * SHM_K + kws) = S.st_k0; *(bf16x8*)(K_lds + (bf) * SHM_K + kws + 32 * 256) = S.st_k1;       \
                          if ((tid & 15) == 0) { kbl[(bf) * 64 + sr] = kbias_fin((B_), S.st_b0); kbl[(bf) * 64 + 32 + sr] = kbias_fin((B_), S.st_b1); } } while (0)
#define SWRITE_V(bf) do { *(bf16x8*)(V_lds + (bf) * SHM_V + vst0) = S.st_v0; *(bf16x8*)(V_lds + (bf) * SHM_V + vst1) = S.st_v1; } while (0)
#define QLOAD(B_) do { const int ri_ = (wid * QBLK + r32 < (B_).nvalid) ? wid * QBLK + r32 : (B_).nvalid - 1;                                    \
        const bf16* qp_ = (B_).Q + (unsigned)(ri_ * (int)(B_).rs + hi * 8);                                                                       \
        _Pragma("unroll") for (int hf_ = 0; hf_ < 2; ++hf_) { bf16x8 t_[4];                                                                      \
            _Pragma("unroll") for (int d0 = 0; d0 < 4; ++d0) t_[d0] = ld8(qp_ + (hf_ * 4 + d0) * 16);                                           \
            _Pragma("unroll") for (int d0 = 0; d0 < 4; ++d0) *(__attribute__((address_space(3))) bf16x8*)(q_lds + (hf_ * 4 + d0) * 1024) = t_[d0]; } } while (0)

__device__ __forceinline__ void prime(const Blk& cur, char* lds, Seam& S) {
    int tid_o = threadIdx.x; asm volatile("" : "+v"(tid_o));
    const int tid = tid_o, wid = __builtin_amdgcn_readfirstlane(tid >> 6), lane = tid & 63, r32 = lane & 31, hi = lane >> 5;
    const int sr = tid >> 4, sc = (tid & 15) * 8, kws = KSWZ(sr, sc * 2); char* K_lds = lds + 2 * SHM_V; float* kbl = (float*)(lds + LDS_KB); __attribute__((address_space(3))) char* q_lds = (__attribute__((address_space(3))) char*)(lds + LDS_Q + wid * 8192 + lane * 16);
    const int kb0 = (swa_jhi(cur.P0, cur.L) - 1) * KVBLK;
    S.st_b0 = 0.f; S.st_b1 = 0.f;
    QLOAD(cur);
    SLOAD(cur, kb0); VMW(); SWRITE_K(0, cur);
    __syncthreads();
}
#ifndef ATT_SK
#define ATT_SK true
#endif
struct AttnArgs { const bf16* QKV; unsigned char* ws; long offOA, offOP0, offOP2x; float* LSE; const float* CUM; };
__device__ __forceinline__ Blk decode(int i, const AttnArgs& A);
template <bool SK>
__device__ __forceinline__ bool block(const Blk& cur, Blk& nxt, int pend, int nitems, volatile int* slot, const AttnArgs& A, char* lds, Seam& S) {
    int tid_o = threadIdx.x; asm volatile("" : "+v"(tid_o));
    const int tid = tid_o, wid = __builtin_amdgcn_readfirstlane(tid >> 6), lane = tid & 63, r32 = lane & 31, hi = lane >> 5;
    const int W = cur.W;
    const int j_lo = swa_jlo(cur.P0, W);
    const int j_hi = swa_jhi(cur.P0, cur.L);
    const int NT = j_hi - j_lo;
    const int qlo = cur.P0 + wid * QBLK, qm = qlo + r32 - 4 * hi;
    char* V_lds = lds; char* K_lds = lds + 2 * SHM_V;
    float* ws = (float*)(lds + LDS_WS) + wid * 64; float* li_l = ws, * al_l = ws + 32; float* kbl = (float*)(lds + LDS_KB); __attribute__((address_space(3))) char* q_lds = (__attribute__((address_space(3))) char*)(lds + LDS_Q + wid * 8192 + lane * 16);
    float m_reg = -1e30f, l_reg = 0; f32x16 o[4] = {};
    const int sr = tid >> 4, sc = (tid & 15) * 8, vst0 = v_st(sr, sc), vst1 = v_st(32 + sr, sc), kws = KSWZ(sr, sc * 2);
    const int vb0 = (int)(uintptr_t)V_lds + v_rd_base(lane);
#define RESC(a) do { if (__any((a) < 1.f)) { if (hi == 0) al_l[r32] = (a); asm volatile("s_waitcnt lgkmcnt(0)" ::: "memory");              \
                     for (int d_ = 0; d_ < 4; ++d_) for (int r = 0; r < 16; ++r) o[d_][r] *= al_l[crow(r, hi)]; } } while (0)
#define KBASE(t) ((j_hi - 1 - (t)) * KVBLK)
#define ACT(t) (KBASE(t) <= qlo + QBLK - 1 && KBASE(t) + KVBLK - 1 >= qlo - W + 1)
#define MASKT(P0_, P1_, t) do { const int kb_ = KBASE(t); if ((!SK || ACT(t)) && (kb_ + KVBLK - 1 > qlo || kb_ <= qlo + QBLK - 1 - W)) mask_tile(P0_, P1_, qm - kb_, (unsigned)W); } while (0)
    f32x16 pA0, pA1, pB0, pB1; float mnA, mnB, alA, alB; bf16x8 pa0, pa1, pa2, pa3;
    SWRITE_V(0); SBAR();
    if (NT > 1) SLOAD(cur, KBASE(1));
    SBAR(); qkt<0, SK>(pA0, pA1, K_lds, kbl, r32, hi, q_lds, ACT(0));
    MASKT(pA0, pA1, 0); partialSM(pA0, pA1, m_reg, mnA, alA);
    if (NT > 1) { VMW(); SWRITE_V(1); SWRITE_K(1, cur); }
    __syncthreads();
#define HALF_STEP(PX0, PX1, mnX, alX, PY0, PY1, alY, t, KB, VB, SB) do {                                                      \
        SBAR(); qkt<KB, SK>(PX0, PX1, K_lds, kbl, r32, hi, q_lds, ACT(t));                                                     \
        finishSM(PY0, PY1, alY, l_reg, pa0, pa1, pa2, pa3); SBAR();                                                           \
        if ((t) + 1 < NT) { SLOAD(cur, KBASE((t) + 1)); SBAR(); }                                                             \
        pv_tile<VB, SK>(o, vb0, pa0, pa1, pa2, pa3, ACT((t) - 1)); MASKT(PX0, PX1, (t)); partialSM(PX0, PX1, m_reg, mnX, alX); \
        __syncthreads();                                                                                                      \
        if ((t) + 1 < NT) { VMW(); SWRITE_V(SB); SWRITE_K(SB, cur); }                                                              \
        RESC(alX); __syncthreads(); } while (0)
    for (int t = 1; t + 1 < NT; t += 2) {
        HALF_STEP(pB0, pB1, mnB, alB, pA0, pA1, alA, t, 1, 0, 0);
        HALF_STEP(pA0, pA1, mnA, alA, pB0, pB1, alB, t + 1, 0, 1, 1);
    }
    const bool even = (NT & 1) == 0;
    if (even) { SBAR(); qkt<1, SK>(pB0, pB1, K_lds, kbl, r32, hi, q_lds, ACT(NT - 1)); SBAR(); }
    if (tid == 0) slot[0] = pend;
    __syncthreads();
    const int ni = __builtin_amdgcn_readfirstlane(slot[0]); const bool last = ni >= nitems;
    nxt = decode(last ? 0 : ni, A);
    if (!last) { const int kbn = (swa_jhi(nxt.P0, nxt.L) - 1) * KVBLK;
        SLOAD(nxt, kbn); SBAR();
        QLOAD(nxt); }
    SBAR();
    finishSM(pA0, pA1, alA, l_reg, pa0, pa1, pa2, pa3); SBAR();
    pv_tile<0, SK>(o, vb0, pa0, pa1, pa2, pa3, ACT(even ? NT - 2 : NT - 1));
    if (even) { MASKT(pB0, pB1, NT - 1); partialSM(pB0, pB1, m_reg, mnB, alB); __syncthreads(); RESC(alB);
        finishSM(pB0, pB1, alB, l_reg, pa0, pa1, pa2, pa3); SBAR(); pv_tile<1, SK>(o, vb0, pa0, pa1, pa2, pa3, ACT(NT - 1)); }
    SBAR(); if (!last) SWRITE_K(0, nxt); SBAR();
    int lne_ = (int)(threadIdx.x & 63u); asm volatile("" : "+v"(lne_)); const int r32e = lne_ & 31, hie = lne_ >> 5;
    if (hie == 0) li_l[r32e] = l_reg; asm volatile("s_waitcnt lgkmcnt(0)" ::: "memory");
    float rli[16];
#pragma unroll
    for (int r = 0; r < 16; ++r) rli[r] = __builtin_amdgcn_rcpf(li_l[crow(r, hie)]);
    bf16* Ow = cur.O + (size_t)(wid * QBLK) * cur.os;
#pragma unroll
    for (int r = 0; r < 16; ++r) { const int orow = crow(r, hie); const bool ok = (wid * QBLK + orow < cur.nvalid) && ((r32e & 1) == 0);
#pragma unroll
        for (int d0 = 0; d0 < 4; ++d0) { const float v = o[d0][r] * rli[r]; const float vn = __shfl_xor(v, 1);
            if (ok) *(unsigned*)(Ow + (unsigned)(orow * (int)cur.os + d0 * 32 + r32e)) = cvtpk(v, vn); } }
    if (cur.LSE && hie == 0 && wid * QBLK + r32e < cur.nvalid)
        cur.LSE[(unsigned)((wid * QBLK + r32e) * cur.ls)] = m_reg + __builtin_amdgcn_logf(l_reg) - cur.sd2 * (float)(wid * QBLK + r32e);
    __syncthreads();
    return last;
#undef RESC
#undef KBASE
#undef ACT
#undef MASKT
#undef HALF_STEP
}
#undef ROWP
#undef VMW
#undef SLOAD
#undef SWRITE_K
#undef SWRITE_V
#undef QLOAD

constexpr int NITEMS = 256 + 256 + 256 + 512;
__device__ __forceinline__ Blk decode(int i_in, const AttnArgs& A) {
    const int i = __builtin_amdgcn_readfirstlane(i_in);
    Blk b; int bh, qb, res, dil, pat; const bool fox = i < 256;
    if (i < 256) { qb = 7 - (i >> 5); bh = i & 31; res = 0; dil = 1; pat = 0; }
    else if (i < 512) { const int j = i - 256; qb = 7 - (j >> 5); bh = j & 31; res = 0; dil = 1; pat = 0; }
    else if (i < 768) { const int j = i - 512; bh = j & 31; const int rest = j >> 5; res = rest >> 1; qb = rest & 1; dil = 4; pat = 1; }
    else { const int j = i - 768; bh = j & 31; res = j >> 5; qb = 0; dil = 16; pat = 2; }
    const int bb = bh >> 3, h = bh & 7, L = 2048 / dil, P0 = qb * 256;
    const size_t tok0 = (size_t)bb * 2048 + res;
    const int seg = fox ? 0 : 3;
    const bf16* base = A.QKV + tok0 * 6144 + h * 128;
    const int opitch = fox ? 2048 : 1024;
    b.rs = (long)dil * 6144; b.os = (long)dil * opitch; b.ls = dil * 8;
    b.Q = base + seg * 1024 + (size_t)P0 * b.rs; b.K = base + (seg + 1) * 1024; b.V = base + (seg + 2) * 1024;
    long ooff = A.offOP0 + (long)pat * (16l << 20) + (pat == 2 ? A.offOP2x : 0l); ooff = fox ? A.offOA : ooff;
    bf16* ob = (bf16*)(A.ws + ooff);
    b.O = ob + (tok0 + (size_t)P0 * dil) * opitch + h * 128;
    float* lb = A.LSE + (size_t)pat * (8192 * 8);
    b.LSE = fox ? nullptr : lb + (tok0 + (size_t)P0 * dil) * 8 + h;
    b.CUM = fox ? A.CUM + (size_t)bh * 2048 : nullptr;
    b.cref = 0.f;
    b.P0 = P0; b.L = L; b.W = fox ? (1 << 30) : 129; b.nvalid = (L - P0) < QB ? (L - P0) : QB;
    b.sd2 = fox ? 0.f : __builtin_amdgcn_exp2f(-(float)(h + 1)) * (float)dil * LOG2E;
    return b;
}
__device__ __forceinline__ void attn_phase(char* lds, const AttnArgs& A, unsigned* ctr, int first = 0) {
    volatile int* slot = (volatile int*)(lds + LDS_SLOT);
    const int G = (int)gridDim.x, ci = first + (int)blockIdx.x;
    if (ci >= NITEMS) return;
    Blk cur = decode(ci, A); Seam S;
    prime(cur, lds, S);
    for (;;) {
        int pend = NITEMS; if (threadIdx.x == 0) pend = first + G + (int)atomicAdd(ctr, 1u);
        Blk nxt; bool last;
        if (cur.CUM) last = block<false>(cur, nxt, pend, NITEMS, slot, A, lds, S);
        else last = block<true>(cur, nxt, pend, NITEMS, slot, A, lds, S);
        if (last) break;
        cur = nxt;
    }
}
#undef SBAR
}

#define GAS __attribute__((address_space(1)))
#define LAS __attribute__((address_space(3)))
typedef unsigned short bf16;
typedef unsigned v4u __attribute__((ext_vector_type(4)));
typedef float f32x4 __attribute__((ext_vector_type(4)));
constexpr int NWAVES = 8;
constexpr int NB = 4, SEQ = 2048, DM = 2048, M = NB * SEQ, NH = 8, HD = 128, DFF = 5632, NUP = 2 * DFF, INC = 10248, NPROJ = 10240;
constexpr float EPS = 1e-6f;
constexpr float LOG2E_F = 1.4426950408889634f;
constexpr size_t MiB = 1u << 20;
constexpr size_t WS_CTL = 0, WS_BAR = 64 * 1024;
constexpr size_t WS_GAIN = 2 * MiB, WS_RSTD = 3 * MiB;
constexpr size_t WS_SSQ = 256 * 1024, WS_CUM = 512 * 1024, WS_LOGF = 768 * 1024, WS_LSE = 1 * MiB;
constexpr size_t WS_WIN = 4 * MiB, WS_WBRF = 44 * MiB, WS_WBRD = 48 * MiB, WS_WOUT = 52 * MiB, WS_WUP = 60 * MiB, WS_WDN = 104 * MiB;
constexpr size_t WS_XN = 126 * MiB;
constexpr size_t WS_QKV = 158 * MiB;
constexpr size_t WS_GATES = 254 * MiB;
constexpr size_t WS_OA = 4 * MiB, WS_OB = 20 * MiB;
constexpr size_t WS_OP0 = 126 * MiB, WS_OP1 = 142 * MiB, WS_OP2 = 318 * MiB;
constexpr size_t WS_T = 158 * MiB, WS_MG = 222 * MiB;
constexpr size_t WS_XB = 126 * MiB;
#ifndef CONV_ALIGN
#define CONV_ALIGN false
#endif
#ifndef FUSED_CONV
#define FUSED_CONV 0
#endif
constexpr size_t WS_U = 158 * MiB;
constexpr size_t WS_ACT = FUSED_CONV ? 158 * MiB : 4 * MiB, WS_US = 254 * MiB;
constexpr size_t WS_END = 334 * MiB;
constexpr int RING_BYTES = 131072, XL_OFF = RING_BYTES, BARST_OFF = 143360, LDS_BYTES = 147456;
static_assert(att::LDS_END <= LDS_BYTES, "attention LDS");

__device__ __forceinline__ unsigned f2bf(float f) { unsigned u = __builtin_bit_cast(unsigned, f); return (u + 0x7fffu + ((u >> 16) & 1u)) >> 16; }
__device__ __forceinline__ unsigned pk2(float lo, float hi) { return f2bf(lo) | (f2bf(hi) << 16); }
__device__ __forceinline__ float wave_sum(float v) {
#pragma unroll
    for (int o = 1; o < 64; o <<= 1) v += __shfl_xor(v, o);
    return v;
}
template <int MODE, bool NTST>
__device__ __forceinline__ void transpose_matrix(const float* W, int K, int Nsrc, int Ndst, bf16* WT, int Kdst, int koff, const float* kscale, int rot, int gw, int NGW, LAS float* scr, int lane) {
    const int nblk = Ndst / 32, nitems = (K / 64) * nblk, rr = lane >> 3, c4 = (lane & 7) * 4, c = lane & 7;
    int it = gw - rot; if (it < 0) it += NGW;
    f32x4 v[8]; int k0 = 0, n0 = 0;
#define TM_LOAD(dst, IT, K0, N0) do { const int kb_ = (IT) / nblk; N0 = 32 * ((IT) - kb_ * nblk); K0 = 64 * kb_;                                   \
        const int sc_ = MODE == 0 ? N0 : (MODE == 1 ? (N0 < 3072 ? N0 : N0 + 8) : (((N0 >> 7) & 1) * 5632 + 128 * (N0 >> 8) + (N0 & 127)));       \
        _Pragma("unroll") for (int i = 0; i < 8; ++i) dst[i] = __builtin_nontemporal_load((const f32x4*)(W + (size_t)(K0 + 8 * i + rr) * Nsrc + sc_ + c4)); } while (0)
    if (it < nitems) TM_LOAD(v, it, k0, n0);
    while (it < nitems) {
        const int itn = it + NGW; f32x4 vn[8]; int k0n = 0, n0n = 0;
        if (itn < nitems) TM_LOAD(vn, itn, k0n, n0n);
        if (kscale) {
#pragma unroll
            for (int i = 0; i < 8; ++i) v[i] = v[i] * kscale[k0 + 8 * i + rr]; }
#pragma unroll
        for (int i = 0; i < 8; ++i) { LAS float* d = scr + (8 * i + rr) * 33 + c4; d[0] = v[i][0]; d[1] = v[i][1]; d[2] = v[i][2]; d[3] = v[i][3]; }
        asm volatile("s_waitcnt lgkmcnt(0)" ::: "memory");
#pragma unroll
        for (int j = 0; j < 4; ++j) { const int n = (lane >> 3) + 8 * j; const LAS float* sp = scr + (8 * c) * 33 + n;
            v4u o; o.x = pk2(sp[0 * 33], sp[1 * 33]); o.y = pk2(sp[2 * 33], sp[3 * 33]); o.z = pk2(sp[4 * 33], sp[5 * 33]); o.w = pk2(sp[6 * 33], sp[7 * 33]);
            if constexpr (NTST) __builtin_nontemporal_store(o, (v4u*)(WT + (size_t)(n0 + n) * Kdst + koff + k0 + 8 * c)); else *(v4u*)(WT + (size_t)(n0 + n) * Kdst + koff + k0 + 8 * c) = o; }
        asm volatile("s_waitcnt lgkmcnt(0)" ::: "memory");
        it = itn; k0 = k0n; n0 = n0n;
#pragma unroll
        for (int i = 0; i < 8; ++i) v[i] = vn[i];
    }
#undef TM_LOAD
}

typedef GAS unsigned gu32;
#define RLX_AGENT __ATOMIC_RELAXED, __HIP_MEMORY_SCOPE_AGENT
#define XB_TMO      128
#define XB_XCNT(j)  (256  + 64 * (j))
#define XB_XSUB(j)  (1280 + 64 * (j))
#define XB_XGEN(j)  (2304 + 64 * (j))
#define XB_TOP      3328
#define XB_TOPGEN   3392
#define XCD_BAR_WORDS 3456
#define XB_SPIN_CAP (1u << 18)

__device__ __forceinline__ unsigned xb_ld(unsigned* p)              { return __hip_atomic_load(p, __ATOMIC_RELAXED, __HIP_MEMORY_SCOPE_AGENT); }
__device__ __forceinline__ unsigned xb_add(unsigned* p, unsigned v) { return __hip_atomic_fetch_add(p, v, __ATOMIC_RELAXED, __HIP_MEMORY_SCOPE_AGENT); }
__device__ __forceinline__ unsigned xb_xcc_id() { return (unsigned)__builtin_amdgcn_s_getreg((3 << 11) | 20) & 0xFu; }
#define XB_SPIN(cond, bar) do { unsigned _sp = 0; while (cond) { __builtin_amdgcn_s_sleep(1); \
    if ((++_sp & 255u) == 0u) { if (xb_ld(&(bar)[XB_TMO])) break; if (_sp > XB_SPIN_CAP) { atomicAdd(&(bar)[XB_TMO], 1u); break; } } } } while (0)

struct XcdBarrier {
    unsigned* bar; unsigned x;
    volatile LAS unsigned* st;
};

__device__ __forceinline__ XcdBarrier xcd_barrier_post(unsigned* bar, volatile LAS unsigned* st) {
    XcdBarrier b; b.bar = bar; b.x = xb_xcc_id(); b.st = st;
    if (threadIdx.x == 0) (void)xb_add(&bar[XB_XCNT(b.x)], 1u);
    return b;
}
__device__ __forceinline__ void xcd_barrier_complete(unsigned* bar, unsigned x, unsigned& nloc, unsigned& nx) {
    const unsigned G = gridDim.x * gridDim.y * gridDim.z;
    unsigned sum, cnt, mine, sp = 0u;
    for (;;) {
        sum = 0u; cnt = 0u; mine = 0u;
#pragma unroll
        for (unsigned j = 0; j < 16; ++j) { const unsigned c = xb_ld(&bar[XB_XCNT(j)]); sum += c; cnt += (c > 0u) ? 1u : 0u; mine = (j == x) ? c : mine; }
        if (sum == G) break;
        __builtin_amdgcn_s_sleep(1);
        if ((++sp & 255u) == 0u) { if (xb_ld(&bar[XB_TMO])) break; if (sp > XB_SPIN_CAP) { atomicAdd(&bar[XB_TMO], 1u); break; } }
    }
    nloc = mine > 0u ? mine : 1u; nx = cnt > 0u ? cnt : 1u;
}

__device__ __forceinline__ void xcd_barrier(const XcdBarrier& b) {
    asm volatile("s_waitcnt vmcnt(0)" ::: "memory");
    __syncthreads();
    if (threadIdx.x == 0) {
        unsigned* bar = b.bar;
        __builtin_amdgcn_s_waitcnt(0);
        unsigned nloc = b.st[0], nx = b.st[1];
        if (nloc == 0u) { xcd_barrier_complete(bar, b.x, nloc, nx); b.st[0] = nloc; b.st[1] = nx; }
        const unsigned old = xb_add(&bar[XB_XSUB(b.x)], 1u);
        const unsigned gen = old / nloc;
        if (old + 1u == (gen + 1u) * nloc) {
            __builtin_amdgcn_fence(__ATOMIC_RELEASE, "agent");
            asm volatile("s_waitcnt vmcnt(0)" ::: "memory");
            const unsigned og = xb_add(&bar[XB_TOP], 1u);
            const unsigned tg = og / nx;
            if (og + 1u == (tg + 1u) * nx) xb_add(&bar[XB_TOPGEN], 1u);
            else XB_SPIN(xb_ld(&bar[XB_TOPGEN]) == tg, bar);
            __builtin_amdgcn_fence(__ATOMIC_ACQUIRE, "agent");
            xb_add(&bar[XB_XGEN(b.x)], 1u);
            asm volatile("s_waitcnt vmcnt(0)" ::: "memory");
        } else {
            XB_SPIN(xb_ld(&bar[XB_XGEN(b.x)]) == gen, bar);
            __builtin_amdgcn_fence(__ATOMIC_ACQUIRE, "agent");
            asm volatile("s_waitcnt vmcnt(0)" ::: "memory");
        }
    }
    __syncthreads();
}
#ifndef PROBE_REPEAT
#define PROBE_REPEAT -1
#endif
#ifndef PROBE_FIRST
#define PROBE_FIRST 0
#endif
#define REPS(k) ((PROBE_REPEAT == (k)) ? 2 : 1)
struct Args { const float* in[16]; float* out; unsigned char* ws; unsigned long long flags; };
#define IDS() int tid_o = threadIdx.x; asm volatile("" : "+v"(tid_o)); const int tid = tid_o, lane = tid & 63, wave = __builtin_amdgcn_readfirstlane(tid >> 6); (void)lane; (void)wave
#define OPQ() int z_ = 0; asm volatile("" : "+s"(z_))
#define INP(k) (args.in[z_ + (k)])

__global__ void __launch_bounds__(NWAVES * 64, 2) fwd_mega(Args args) {
    extern __shared__ __attribute__((aligned(16))) unsigned char lds[];
    cg::grid_group grid = cg::this_grid();
    LAS unsigned char* lds3 = (LAS unsigned char*)lds;
    const int G = gridDim.x, bx = blockIdx.x;
    if (threadIdx.x < 2) ((volatile LAS unsigned*)(lds3 + BARST_OFF))[threadIdx.x] = 0u;
    __syncthreads();
    unsigned char* ws = args.ws;
    const XcdBarrier xbar = xcd_barrier_post((unsigned*)(ws + WS_BAR), (volatile LAS unsigned*)(lds3 + BARST_OFF));
    float* out = args.out;
    bf16* Win_t = (bf16*)(ws + WS_WIN); bf16* Wbrf_t = (bf16*)(ws + WS_WBRF); bf16* Wbrd_t = (bf16*)(ws + WS_WBRD); bf16* Wout_t = (bf16*)(ws + WS_WOUT);
    bf16* Wup_t = (bf16*)(ws + WS_WUP); bf16* Wdn_t = (bf16*)(ws + WS_WDN);
    bf16* XN = (bf16*)(ws + WS_XN); bf16* QKV = (bf16*)(ws + WS_QKV); bf16* GATES = (bf16*)(ws + WS_GATES);
    bf16* OA = (bf16*)(ws + WS_OA); bf16* OB = (bf16*)(ws + WS_OB); bf16* OP0 = (bf16*)(ws + WS_OP0); bf16* OP1 = (bf16*)(ws + WS_OP1); bf16* OP2 = (bf16*)(ws + WS_OP2);
    float* T = (float*)(ws + WS_T); bf16* MG = (bf16*)(ws + WS_MG); bf16* XB = (bf16*)(ws + WS_XB); bf16* ACT = (bf16*)(ws + WS_ACT); bf16* U = (bf16*)(ws + WS_U); float* US = (float*)(ws + WS_US); (void)U; (void)US;
    float* SSQ = (float*)(ws + WS_SSQ); float* CUM = (float*)(ws + WS_CUM); float* LOGF = (float*)(ws + WS_LOGF); float* LSE = (float*)(ws + WS_LSE);
    unsigned* ctl = (unsigned*)(ws + WS_CTL); float* GAIN = (float*)(ws + WS_GAIN); float* RSTD = (float*)(ws + WS_RSTD);

#if !defined(ONLY) || ONLY == 0
    _Pragma("unroll 1") for (int rep_ = 0; rep_ < REPS(0); ++rep_) {
        IDS();
        OPQ(); const float* x = INP(0); const float* g_attn = INP(1); const float* w_in = INP(2); const float* b_forget = INP(3); const float* gq_fox = INP(4); const float* gk_fox = INP(5); const float* gq_dil = INP(6); const float* gk_dil = INP(7);
        const float* w_br_fox = INP(8); const float* w_br_dil = INP(9); const float* w_out = INP(10); const float* g_ffn = INP(11); const float* w_up = INP(12); const float* w_down = INP(15);
        if (bx == 1) for (int i = tid; i < 1024; i += NWAVES * 64) { GAIN[i] = gq_fox[i]; GAIN[1024 + i] = gk_fox[i]; GAIN[2048 + i] = gq_dil[i]; GAIN[3072 + i] = gk_dil[i]; }
        LAS float* scr = (LAS float*)(lds3 + wave * 16384);
        const int gw = bx * NWAVES + wave, NGW = G * NWAVES;
        constexpr int I_IN = (DM / 64) * (NPROJ / 32), I_BR = (1024 / 64) * (DM / 32), I_OUT = (DM / 64) * (DM / 32), I_UP = (DM / 64) * (NUP / 32);
        transpose_matrix<1, false>(w_in, DM, INC, NPROJ, Win_t, DM, 0, nullptr, 0, gw, NGW, scr, lane);
        transpose_matrix<0, true>(w_br_fox, 1024, DM, DM, Wbrf_t, 2048, 0, nullptr, I_IN % NGW, gw, NGW, scr, lane);
        transpose_matrix<0, true>(w_br_dil, 1024, DM, DM, Wbrf_t, 2048, 1024, nullptr, (I_IN + I_BR) % NGW, gw, NGW, scr, lane);
        transpose_matrix<0, true>(w_out, DM, DM, DM, Wout_t, DM, 0, nullptr, (I_IN + 2 * I_BR) % NGW, gw, NGW, scr, lane);
        transpose_matrix<2, true>(w_up, DM, NUP, NUP, Wup_t, DM, 0, g_ffn, (I_IN + 2 * I_BR + I_OUT) % NGW, gw, NGW, scr, lane);
        transpose_matrix<0, true>(w_down, DFF, DM, DM, Wdn_t, DFF, 0, nullptr, (I_IN + 2 * I_BR + I_OUT + I_UP) % NGW, gw, NGW, scr, lane);
        __syncthreads();
        LAS float* wf = (LAS float*)lds3;
        {
            const float* wsrc = w_in + 3072 + (tid & 7);
#pragma unroll 1
            for (int b0 = 0; b0 < 32; b0 += 8) { float tv[8];
#pragma unroll
                for (int q = 0; q < 8; ++q) tv[q] = wsrc[(size_t)((tid + (b0 + q) * NWAVES * 64) >> 3) * INC];
#pragma unroll
                for (int q = 0; q < 8; ++q) wf[tid + (b0 + q) * NWAVES * 64] = tv[q]; }
        }
        __syncthreads();
        for (int m = gw; m < M; m += NGW) {
            const f32x4* xr = (const f32x4*)(x + (size_t)m * DM) + lane; const f32x4* gr = (const f32x4*)g_attn + lane;
            f32x4 v[8]; float s = 0.f;
#pragma unroll
            for (int j = 0; j < 8; ++j) { v[j] = __builtin_nontemporal_load(xr + 64 * j); s += (v[j][0] * v[j][0] + v[j][1] * v[j][1]) + (v[j][2] * v[j][2] + v[j][3] * v[j][3]); }
            const float rstd = 1.f / sqrtf(wave_sum(s) * (1.f / DM) + EPS);
            float fa[8] = {0.f, 0.f, 0.f, 0.f, 0.f, 0.f, 0.f, 0.f};
            unsigned long long* o8 = (unsigned long long*)(XN + (size_t)m * DM) + lane;
#pragma unroll
            for (int j = 0; j < 8; ++j) { const f32x4 h = v[j] * rstd * gr[64 * j];
                o8[64 * j] = (unsigned long long)pk2(h[0], h[1]) | ((unsigned long long)pk2(h[2], h[3]) << 32);
#pragma unroll
                for (int c = 0; c < 4; ++c) { const LAS f32x4* wp = (const LAS f32x4*)(wf + (size_t)(256 * j + 4 * lane + c) * 8); const f32x4 wa = wp[0], wb = wp[1];
                    fa[0] = fmaf(h[c], wa[0], fa[0]); fa[1] = fmaf(h[c], wa[1], fa[1]); fa[2] = fmaf(h[c], wa[2], fa[2]); fa[3] = fmaf(h[c], wa[3], fa[3]);
                    fa[4] = fmaf(h[c], wb[0], fa[4]); fa[5] = fmaf(h[c], wb[1], fa[5]); fa[6] = fmaf(h[c], wb[2], fa[6]); fa[7] = fmaf(h[c], wb[3], fa[7]); }
                asm volatile("" ::: "memory"); }
#pragma unroll
            for (int hh = 0; hh < 8; ++hh) fa[hh] = wave_sum(fa[hh]);
            if (lane < 8) { float z = fa[0];
#pragma unroll
                for (int hh = 1; hh < 8; ++hh) z = (lane == hh) ? fa[hh] : z;
                z += b_forget[lane];
                LOGF[(size_t)m * 8 + lane] = fminf(z, 0.f) - log1pf(expf(-fabsf(z))); }
        }
        __syncthreads();
    }
#endif
    if (args.flags & 1ull) grid.sync();
    xcd_barrier(xbar);

#if !defined(ONLY) || ONLY == 1
    _Pragma("unroll 1") for (int rep_ = 0; rep_ < REPS(1); ++rep_) {
        if (rep_ > 0) xcd_barrier(xbar);
        IDS();
        if (bx < NB * NH) { const int bb = bx >> 3, h = bx & 7; LAS float* wt = (LAS float*)lds3;
            float v[4]; float s = 0.f;
#pragma unroll
            for (int j = 0; j < 4; ++j) { v[j] = LOGF[((size_t)bb * SEQ + 4 * tid + j) * 8 + h]; s += v[j]; v[j] = s; }
            float inc = s;
#pragma unroll
            for (int o = 1; o < 64; o <<= 1) { const float t = __shfl_up(inc, o); if (lane >= o) inc += t; }
            if (lane == 63) wt[wave] = inc;
            __syncthreads();
            float off = inc - s;
            for (int w = 0; w < wave; ++w) off += wt[w];
#pragma unroll
            for (int j = 0; j < 4; ++j) CUM[(size_t)bx * SEQ + 4 * tid + j] = off + v[j];
            __syncthreads();
        }
        pg8::Gemm g{XN, Win_t, M, NPROJ, DM}; pg8::StaticOrder S; S.init(M, NPROJ, G, bx);
        pg8::EpiProj E{QKV, GATES, GAIN, (LAS float*)(lds3 + XL_OFF)};
        pg8::gemm_phase<pg8::EpiProj, pg8::StaticOrder, true, true>(lds3, g, S, E);
    }
#endif
    xcd_barrier(xbar);

#if !defined(ONLY) || ONLY == 2
    _Pragma("unroll 1") for (int rep_ = 0; rep_ < REPS(2); ++rep_) {
        if (rep_ > 0) xcd_barrier(xbar);
        IDS();
        const att::AttnArgs A{QKV, ws, (long)WS_OA, (long)WS_OP0, (long)WS_OP2 - (long)WS_OP0 - 32 * (long)MiB, LSE, CUM};
        att::attn_phase((char*)lds, A, ctl + 16 * rep_, rep_ ? PROBE_FIRST : 0);
    }
#endif
    xcd_barrier(xbar);

#if !defined(ONLY) || ONLY == 3
    _Pragma("unroll 1") for (int rep_ = 0; rep_ < REPS(3); ++rep_) {
        if (rep_ > 0) xcd_barrier(xbar);
        IDS();
        const int gt = bx * (NWAVES * 64) + tid, NT = G * NWAVES * 64;
        for (int i = gt; i < M * 128; i += NT) { const int m = i >> 7, c8 = (i & 127) * 8, h = c8 >> 7;
            const float l0 = LSE[(size_t)m * 8 + h], l1 = LSE[(size_t)(M + m) * 8 + h], l2 = LSE[(size_t)(2 * M + m) * 8 + h];
            const float mx = fmaxf(l0, fmaxf(l1, l2));
            float w0 = __builtin_amdgcn_exp2f(l0 - mx), w1 = __builtin_amdgcn_exp2f(l1 - mx), w2 = __builtin_amdgcn_exp2f(l2 - mx);
            const float inv = 1.f / (w0 + w1 + w2); w0 *= inv; w1 *= inv; w2 *= inv;
            const v4u a = __builtin_nontemporal_load((const v4u*)(OP0 + (size_t)m * 1024 + c8)), b = __builtin_nontemporal_load((const v4u*)(OP1 + (size_t)m * 1024 + c8)), c = __builtin_nontemporal_load((const v4u*)(OP2 + (size_t)m * 1024 + c8));
            v4u o;
#pragma unroll
            for (int k = 0; k < 4; ++k) { const float lo = w0 * pg8::bflo(a[k]) + w1 * pg8::bflo(b[k]) + w2 * pg8::bflo(c[k]), hi = w0 * pg8::bfhi(a[k]) + w1 * pg8::bfhi(b[k]) + w2 * pg8::bfhi(c[k]); o[k] = pk2(lo, hi); }
            *(v4u*)(OA + (size_t)m * 2048 + 1024 + c8) = o; }
    }
#endif
    xcd_barrier(xbar);

#if !defined(ONLY) || ONLY == 4
    _Pragma("unroll 1") for (int rep_ = 0; rep_ < REPS(4); ++rep_) {
        if (rep_ > 0) xcd_barrier(xbar);
        IDS();
        pg8::StaticOrder S; S.init(M, DM, G, bx);
        pg8::Gemm g{OA, Wbrf_t, M, DM, 2048}; pg8::EpiBr E{GATES, MG};
        pg8::gemm_phase<pg8::EpiBr, pg8::StaticOrder, true, true>(lds3, g, S, E);
    }
#endif
    xcd_barrier(xbar);

#if !defined(ONLY) || ONLY == 5
    _Pragma("unroll 1") for (int rep_ = 0; rep_ < REPS(5); ++rep_) {
        if (rep_ > 0) xcd_barrier(xbar);
        IDS();
        pg8::Gemm g{MG, Wout_t, M, DM, DM}; pg8::StaticOrder S; S.init(M, DM, G, bx);
        OPQ(); pg8::EpiOut E{INP(0), XB, SSQ};
        pg8::gemm_phase<pg8::EpiOut, pg8::StaticOrder, false, true>(lds3, g, S, E);
    }
#endif
    xcd_barrier(xbar);

#if !defined(ONLY) || ONLY == 6
    _Pragma("unroll 1") for (int rep_ = 0; rep_ < REPS(6); ++rep_) {
        if (rep_ > 0) xcd_barrier(xbar);
        IDS();
#pragma unroll 1
        for (int r0 = tid; r0 < M; r0 += 8 * NWAVES * 64) { f32x4 sa[8], sb[8];
#pragma unroll
            for (int q = 0; q < 8; ++q) { const size_t r = (size_t)(r0 + q * NWAVES * 64); sa[q] = *(const f32x4*)(SSQ + r * 8); sb[q] = *(const f32x4*)(SSQ + r * 8 + 4); }
#pragma unroll
            for (int q = 0; q < 8; ++q) RSTD[r0 + q * NWAVES * 64] = 1.f / sqrtf((((sa[q][0] + sa[q][1]) + (sa[q][2] + sa[q][3])) + ((sb[q][0] + sb[q][1]) + (sb[q][2] + sb[q][3]))) * (1.f / DM) + EPS); }
        asm volatile("s_waitcnt vmcnt(0)" ::: "memory"); __syncthreads();
        pg8::Gemm g{XB, Wup_t, M, NUP, DM}; pg8::StaticOrder S; S.init(M, NUP, G, bx);
#if FUSED_CONV
        OPQ(); pg8::EpiUpConv E{RSTD, INP(13), INP(14), ACT, US, (LAS float*)(lds3 + XL_OFF)};
        pg8::gemm_phase<pg8::EpiUpConv, pg8::StaticOrder, CONV_ALIGN, true>(lds3, g, S, E);
#else
        pg8::EpiUp E{RSTD, U};
        pg8::gemm_phase<pg8::EpiUp, pg8::StaticOrder, true, true>(lds3, g, S, E);
#endif
    }
#endif
    xcd_barrier(xbar);

#if (!defined(ONLY) || ONLY == 8) && !FUSED_CONV
    _Pragma("unroll 1") for (int rep_ = 0; rep_ < REPS(8); ++rep_) {
        if (rep_ > 0) xcd_barrier(xbar);
        IDS();
        OPQ(); const float* w_conv = INP(13); const float* b_conv = INP(14);
        const int gt = bx * (NWAVES * 64) + tid, NTH = G * NWAVES * 64;
        for (int it = gt; it < 704 * 512; it += NTH) { const int r = it / 704, k = it - r * 704, t0 = r * 16, pn = k >> 4, j8 = (k & 15) * 8;
            const unsigned ug = 256 * pn + j8, c = 8 * k;
            float wg[3][8], wv[3][8], bg[8], bv[8];
#pragma unroll
            for (int tp = 0; tp < 3; ++tp)
#pragma unroll
                for (int q = 0; q < 2; ++q) { const f32x4 a = *(const f32x4*)(w_conv + tp * NUP + c + 4 * q), b = *(const f32x4*)(w_conv + tp * NUP + DFF + c + 4 * q);
#pragma unroll
                    for (int j = 0; j < 4; ++j) { wg[tp][4 * q + j] = a[j]; wv[tp][4 * q + j] = b[j]; } }
#pragma unroll
            for (int q = 0; q < 2; ++q) { const f32x4 a = *(const f32x4*)(b_conv + c + 4 * q), b = *(const f32x4*)(b_conv + DFF + c + 4 * q);
#pragma unroll
                for (int j = 0; j < 4; ++j) { bg[4 * q + j] = a[j]; bv[4 * q + j] = b[j]; } }
            float g2[8], g1[8], v2[8], v1[8];
            if ((t0 & (SEQ - 1)) == 0) {
#pragma unroll
                for (int j = 0; j < 8; ++j) { g2[j] = 0.f; g1[j] = 0.f; v2[j] = 0.f; v1[j] = 0.f; }
            } else {
                const v4u a2 = *(const v4u*)(U + (size_t)(t0 - 2) * NUP + ug), b2 = *(const v4u*)(U + (size_t)(t0 - 2) * NUP + ug + 128);
                const v4u a1 = *(const v4u*)(U + (size_t)(t0 - 1) * NUP + ug), b1 = *(const v4u*)(U + (size_t)(t0 - 1) * NUP + ug + 128);
#pragma unroll
                for (int q = 0; q < 4; ++q) { g2[2 * q] = pg8::bflo(a2[q]); g2[2 * q + 1] = pg8::bfhi(a2[q]); v2[2 * q] = pg8::bflo(b2[q]); v2[2 * q + 1] = pg8::bfhi(b2[q]);
                    g1[2 * q] = pg8::bflo(a1[q]); g1[2 * q + 1] = pg8::bfhi(a1[q]); v1[2 * q] = pg8::bflo(b1[q]); v1[2 * q + 1] = pg8::bfhi(b1[q]); }
            }
            for (int i4 = 0; i4 < 16; i4 += 4) {
                v4u a0[4], b0[4];
#pragma unroll
                for (int i = 0; i < 4; ++i) { const size_t t = (size_t)(t0 + i4 + i);
                    a0[i] = __builtin_nontemporal_load((const v4u*)(U + t * NUP + ug)); b0[i] = __builtin_nontemporal_load((const v4u*)(U + t * NUP + ug + 128)); }
#pragma unroll
                for (int i = 0; i < 4; ++i) { const size_t t = (size_t)(t0 + i4 + i);
                    float g0[8], v0[8], o[8];
#pragma unroll
                    for (int q = 0; q < 4; ++q) { g0[2 * q] = pg8::bflo(a0[i][q]); g0[2 * q + 1] = pg8::bfhi(a0[i][q]); v0[2 * q] = pg8::bflo(b0[i][q]); v0[2 * q + 1] = pg8::bfhi(b0[i][q]); }
#pragma unroll
                    for (int j = 0; j < 8; ++j) { const float gt_ = fmaf(wg[0][j], g2[j], fmaf(wg[1][j], g1[j], fmaf(wg[2][j], g0[j], bg[j])));
                        const float vl = fmaf(wv[0][j], v2[j], fmaf(wv[1][j], v1[j], fmaf(wv[2][j], v0[j], bv[j])));
                        o[j] = gt_ * pg8::sigm(gt_) * vl; g2[j] = g1[j]; g1[j] = g0[j]; v2[j] = v1[j]; v1[j] = v0[j]; }
                    v4u w; w.x = pk2(o[0], o[1]); w.y = pk2(o[2], o[3]); w.z = pk2(o[4], o[5]); w.w = pk2(o[6], o[7]);
                    *(v4u*)(ACT + t * DFF + c) = w; } }
        }
    }
#endif
    #if !FUSED_CONV
    xcd_barrier(xbar);
#endif

#if !defined(ONLY) || ONLY == 7
    _Pragma("unroll 1") for (int rep_ = 0; rep_ < REPS(7); ++rep_) {
        if (rep_ > 0) xcd_barrier(xbar);
        IDS();
        pg8::StaticOrder S; S.init(M, DM, G, bx);
#if FUSED_CONV
        {
            OPQ(); const float* w_conv = INP(13); const float* b_conv = INP(14); pg8::Unit u0;
            if (S.next(0, u0)) {
                for (int i = tid; i < 4 * DFF; i += NWAVES * 64) { const int gq = i / DFF, c = i - gq * DFF, Gi = 4 * u0.pm + gq; const bool first = (Gi & 31) == 0;
                    const float* up = US + (size_t)Gi * 4 * NUP;
                    float cv[2][2];
#pragma unroll
                    for (int bj = 0; bj < 2; ++bj) { const int uc = bj * DFF + c; const float u0v = first ? 0.f : up[uc], u1v = first ? 0.f : up[NUP + uc], u2v = up[2 * NUP + uc], u3v = up[3 * NUP + uc];
                        const float w0 = w_conv[uc], w1 = w_conv[NUP + uc], w2 = w_conv[2 * NUP + uc], bb = b_conv[uc];
                        cv[bj][0] = fmaf(w0, u0v, fmaf(w1, u1v, fmaf(w2, u2v, bb))); cv[bj][1] = fmaf(w0, u1v, fmaf(w1, u2v, fmaf(w2, u3v, bb))); }
#pragma unroll
                    for (int t = 0; t < 2; ++t) { const float gte = cv[0][t]; ACT[(size_t)(64 * Gi + t) * DFF + c] = (bf16)f2bf(gte * pg8::sigm(gte) * cv[1][t]); } }
            }
            asm volatile("s_waitcnt vmcnt(0)" ::: "memory"); __threadfence(); __syncthreads();
        }
#endif
        pg8::Gemm g{ACT, Wdn_t, M, DM, DFF};
        pg8::EpiFinal E{XB, out};
        pg8::gemm_phase<pg8::EpiFinal, pg8::StaticOrder, false, true>(lds3, g, S, E);
    }
#endif
}

extern "C" void kernel_launch(void* const* d_in, const int* in_sizes, int n_in, void* d_out, int out_size, void* d_ws, size_t ws_size, hipStream_t stream) {
    static int grid = 0;
    if (grid == 0) {
        if (n_in != 16 || in_sizes[0] != M * DM || out_size != M * DM || ws_size < WS_END) { fprintf(stderr, "kernel_launch: unexpected shapes (n_in %d, in0 %d, out %d, ws %zu)\n", n_in, n_in > 0 ? in_sizes[0] : -1, out_size, ws_size); grid = -1; return; }
        int dev = 0, cus = 0, per_cu = 0;
        (void)hipGetDevice(&dev); (void)hipDeviceGetAttribute(&cus, hipDeviceAttributeMultiprocessorCount, dev);
        if (hipFuncSetAttribute((const void*)fwd_mega, hipFuncAttributeMaxDynamicSharedMemorySize, LDS_BYTES) != hipSuccess) { fprintf(stderr, "kernel_launch: hipFuncSetAttribute failed\n"); grid = -1; return; }
        if (hipOccupancyMaxActiveBlocksPerMultiprocessor(&per_cu, (const void*)fwd_mega, NWAVES * 64, LDS_BYTES) != hipSuccess || per_cu < 1) { fprintf(stderr, "kernel_launch: occupancy query says %d\n", per_cu); per_cu = 1; }
        (void)hipGetLastError();
        grid = cus * 1;
        if (grid != 256) fprintf(stderr, "kernel_launch: %d CUs; the single-unit GEMM phases assume 256\n", grid);
    }
    if (grid < 0) return;
    if (hipMemsetAsync(d_ws, 0, 128 * 1024, stream) != hipSuccess) { fprintf(stderr, "kernel_launch: hipMemsetAsync failed\n"); return; }
    Args a{};
    for (int i = 0; i < 16; ++i) a.in[i] = (const float*)d_in[i];
    a.out = (float*)d_out; a.ws = (unsigned char*)d_ws;
    void* kargs[] = {&a};
    hipError_t e = hipLaunchCooperativeKernel((const void*)fwd_mega, dim3(grid), dim3(NWAVES * 64), kargs, LDS_BYTES, stream);
    if (e != hipSuccess) fprintf(stderr, "cooperative launch failed: %s (grid %d)\n", hipGetErrorString(e), grid);
}
```

```cpp
#include <hip/hip_runtime.h>
#include <hip/hip_cooperative_groups.h>
#include <cstdio>
#include <cstdint>
namespace cg = cooperative_groups;
namespace pg8 {
#define PG8_LAS __attribute__((address_space(3)))
typedef unsigned short bf16_t;
typedef short bf16x8 __attribute__((ext_vector_type(8)));
typedef float f32x4 __attribute__((ext_vector_type(4)));
typedef unsigned u32x4 __attribute__((ext_vector_type(4)));
constexpr int BM = 256, BK = 64, HALF = 128, HTB = HALF * BK * 2  , STAGE_BYTES = 8 * HTB, NXCD = 8, WGM = 8;

__host__ __device__ __forceinline__ int lds_byte(int r, int c) { const int st = (r >> 4) * 2 + (c >> 5), rr = r & 15, cc = c & 31, ob = rr * 64 + cc * 2; return st * 1024 + (ob ^ (((ob >> 9) & 1) << 5)); }
__host__ __device__ __forceinline__ void stage_rc(int b, int& R, int& C) { const int st = b / 1024, sb = b % 1024, swz = sb ^ (((sb >> 9) & 1) << 5); R = (st >> 1) * 16 + swz / 64; C = (st & 1) * 32 + (swz % 64) / 2; }
__host__ __device__ __forceinline__ int perm32(int rho) { const int n = rho >> 4, i = rho & 15; return 8 * (i >> 2) + 4 * n + (i & 3); }

struct Unit { int pm, pn; };
struct Gemm { const bf16_t* A; const bf16_t* Bt; int M, N, K; };

struct StaticOrder {
    int nM, nN, nwg, G, c;
    __host__ __device__ void init(int M, int N, int G_, int c_) { nM = M / BM; nN = N / BM; nwg = nM * nN; G = G_; c = c_; }
    __host__ __device__ bool next(int i, Unit& u) const {
        const long L = (long)i * G + c; if (L >= nwg) return false;
        int wgid = (int)L; { const int q = nwg / NXCD, r = nwg % NXCD, xcd = wgid % NXCD, off = wgid / NXCD; wgid = (xcd < r ? xcd * (q + 1) : r * (q + 1) + (xcd - r) * q) + off; }
        const int nig = WGM * nN, gid = wgid / nig, fm = gid * WGM, gsz = (nM - fm) < WGM ? (nM - fm) : WGM;
        u.pm = fm + ((wgid % nig) % gsz); u.pn = (wgid % nig) / gsz; return true;
    }
    __device__ __forceinline__ void a_ready(const Unit&) const {}
    __device__ __forceinline__ void done(const Unit&) const {}
};

__device__ __forceinline__ unsigned cvt_pk_bf16(float lo, float hi) { unsigned r; asm volatile("v_cvt_pk_bf16_f32 %0, %1, %2" : "=v"(r) : "v"(lo), "v"(hi)); return r; }
typedef unsigned u32x4e __attribute__((ext_vector_type(4)));
constexpr float LOG2E = 1.4426950408889634f;
constexpr float EPSN = 1e-6f;
constexpr float QSCALE = 0.08838834764831845f * 1.4426950408889634f;
__device__ __forceinline__ float sigm(float x) { return __builtin_amdgcn_rcpf(1.f + __builtin_amdgcn_exp2f(-x * LOG2E)); }
__device__ __forceinline__ float bflo(unsigned w) { return __uint_as_float(w << 16); }
__device__ __forceinline__ float bfhi(unsigned w) { return __uint_as_float(w & 0xffff0000u); }
__device__ __forceinline__ u32x4e pack8f(const f32x4 a, const f32x4 b) { u32x4e w; w.x = cvt_pk_bf16(a[0], a[1]); w.y = cvt_pk_bf16(a[2], a[3]); w.z = cvt_pk_bf16(b[0], b[1]); w.w = cvt_pk_bf16(b[2], b[3]); return w; }
#define EPI_LDSBAR() do { asm volatile("s_waitcnt lgkmcnt(0)" ::: "memory"); __builtin_amdgcn_s_barrier(); asm volatile("" ::: "memory"); } while (0)

struct EpiProj {
    static constexpr bool PERM = true, AFTER_DRAIN = false, HAS_MID = false;
    bf16_t* QKV; bf16_t* GATES; const float* gains; PG8_LAS float* xl;
    __device__ __forceinline__ void operator()(f32x4 (&acc)[2][2][4][2], const Unit& u, int wr, int wc, int fr, int fq) const {
        const int colt = u.pn * BM, row0 = u.pm * BM + wr * 64 + fr, seg = colt >> 10;
        const bool norm = (seg == 0) | (seg == 1) | (seg == 3) | (seg == 4);
        if (!norm) {
            bf16_t* base; int ldc, col0;
            if (colt >= 6144) { base = GATES; ldc = 4096; col0 = colt - 6144; } else { base = QKV; ldc = 6144; col0 = colt; }
            col0 += wc * 32 + 8 * fq;
#pragma unroll
            for (int ai = 0; ai < 2; ++ai)
#pragma unroll
                for (int m = 0; m < 4; ++m) { bf16_t* rowp = base + (size_t)(row0 + ai * HALF + m * 16) * ldc + col0;
#pragma unroll
                    for (int bj = 0; bj < 2; ++bj) *(u32x4e*)(rowp + bj * HALF) = pack8f(acc[ai][bj][m][0], acc[ai][bj][m][1]); }
        } else {
#pragma unroll
            for (int ai = 0; ai < 2; ++ai)
#pragma unroll
                for (int m = 0; m < 4; ++m)
#pragma unroll
                    for (int bj = 0; bj < 2; ++bj) { const f32x4 a = acc[ai][bj][m][0], b = acc[ai][bj][m][1];
                        float s = (a[0] * a[0] + a[1] * a[1]) + (a[2] * a[2] + a[3] * a[3]) + (b[0] * b[0] + b[1] * b[1]) + (b[2] * b[2] + b[3] * b[3]);
                        s += __shfl_xor(s, 16); s += __shfl_xor(s, 32);
                        if (fq == 0) xl[((ai * HALF + wr * 64 + m * 16 + fr) * 2 + bj) * 4 + wc] = s; }
            EPI_LDSBAR();
            const float* gp = gains + (seg - (seg >= 3 ? 1 : 0)) * 1024 + (colt & 1023) + wc * 32 + 8 * fq;
            const float qs = (seg == 0 || seg == 3) ? QSCALE : 1.f;
            f32x4 g[2][2];
#pragma unroll
            for (int bj = 0; bj < 2; ++bj)
#pragma unroll
                for (int n = 0; n < 2; ++n) g[bj][n] = *(const f32x4*)(gp + bj * HALF + 4 * n) * qs;
            bf16_t* base = QKV + colt + wc * 32 + 8 * fq;
#pragma unroll
            for (int ai = 0; ai < 2; ++ai)
#pragma unroll
                for (int m = 0; m < 4; ++m) { bf16_t* rowp = base + (size_t)(row0 + ai * HALF + m * 16) * 6144;
#pragma unroll
                    for (int bj = 0; bj < 2; ++bj) { const f32x4 p = *(const PG8_LAS f32x4*)(xl + ((ai * HALF + wr * 64 + m * 16 + fr) * 2 + bj) * 4);
                        const float rs = __builtin_amdgcn_rsqf(((p[0] + p[1]) + (p[2] + p[3])) * (1.f / 128.f) + EPSN);
                        *(u32x4e*)(rowp + bj * HALF) = pack8f(acc[ai][bj][m][0] * rs * g[bj][0], acc[ai][bj][m][1] * rs * g[bj][1]); } }
        }
    }
};

__device__ __forceinline__ void gate8(const bf16_t* p, f32x4& s0, f32x4& s1) {
    const u32x4e w = *(const u32x4e*)p;
    s0[0] = sigm(bflo(w.x)); s0[1] = sigm(bfhi(w.x)); s0[2] = sigm(bflo(w.y)); s0[3] = sigm(bfhi(w.y));
    s1[0] = sigm(bflo(w.z)); s1[1] = sigm(bfhi(w.z)); s1[2] = sigm(bflo(w.w)); s1[3] = sigm(bfhi(w.w));
}
struct EpiBr {
    static constexpr bool PERM = true, AFTER_DRAIN = false, HAS_MID = true;
    const bf16_t* G; bf16_t* MG;
    __device__ __forceinline__ void mid(f32x4 (&acc)[2][2][4][2], const Unit& u, int wr, int wc, int fr_in, int fq_in) const {
        (void)fr_in; (void)fq_in; int ln_ = (int)(threadIdx.x & 63u); asm volatile("" : "+v"(ln_)); const int fr = ln_ & 15, fq = ln_ >> 4;
        const int row0 = u.pm * BM + wr * 64 + fr, col0 = u.pn * BM + wc * 32 + 8 * fq;
#define RAT(x, y) ((1.f + __builtin_amdgcn_exp2f(-(y) * LOG2E)) * __builtin_amdgcn_rcpf(1.f + __builtin_amdgcn_exp2f(-(x) * LOG2E)))
#pragma unroll
        for (int ai = 0; ai < 2; ++ai) {
            u32x4e ga[4][2], gb[4][2];
#pragma unroll
            for (int m = 0; m < 4; ++m)
#pragma unroll
                for (int bj = 0; bj < 2; ++bj) { const bf16_t* gp = G + (size_t)(row0 + ai * HALF + m * 16) * 4096 + col0 + bj * HALF; ga[m][bj] = *(const u32x4e*)gp; gb[m][bj] = *(const u32x4e*)(gp + 2048); }
#pragma unroll
            for (int m = 0; m < 4; ++m)
#pragma unroll
                for (int bj = 0; bj < 2; ++bj) { const u32x4e a = ga[m][bj], b = gb[m][bj]; f32x4 r0, r1;
                    r0[0] = RAT(bflo(a.x), bflo(b.x)); r0[1] = RAT(bfhi(a.x), bfhi(b.x)); r0[2] = RAT(bflo(a.y), bflo(b.y)); r0[3] = RAT(bfhi(a.y), bfhi(b.y));
                    r1[0] = RAT(bflo(a.z), bflo(b.z)); r1[1] = RAT(bfhi(a.z), bfhi(b.z)); r1[2] = RAT(bflo(a.w), bflo(b.w)); r1[3] = RAT(bfhi(a.w), bfhi(b.w));
                    acc[ai][bj][m][0] = acc[ai][bj][m][0] * r0; acc[ai][bj][m][1] = acc[ai][bj][m][1] * r1; }
            asm volatile("" ::: "memory"); __builtin_amdgcn_sched_barrier(0); }
#undef RAT
    }
    __device__ __forceinline__ void operator()(f32x4 (&acc)[2][2][4][2], const Unit& u, int wr, int wc, int fr, int fq) const {
        const int row0 = u.pm * BM + wr * 64 + fr, col0 = u.pn * BM + wc * 32 + 8 * fq;
#pragma unroll
        for (int ai = 0; ai < 2; ++ai)
#pragma unroll
            for (int m = 0; m < 4; ++m) { const size_t row = (size_t)(row0 + ai * HALF + m * 16);
#pragma unroll
                for (int bj = 0; bj < 2; ++bj) { const int col = col0 + bj * HALF; f32x4 s0, s1; gate8(G + row * 4096 + 2048 + col, s0, s1);
                    *(u32x4e*)(MG + row * 2048 + col) = pack8f(acc[ai][bj][m][0] * s0, acc[ai][bj][m][1] * s1); } }
    }
};
struct EpiOut {
    static constexpr bool PERM = true, AFTER_DRAIN = true, HAS_MID = false;
    const float* X; bf16_t* XB; float* SSQ;
    __device__ __forceinline__ void fused(f32x4 (&acc)[2][2][4][2], const Unit& u, int wr, int wc, int fr, int fq, PG8_LAS unsigned char* lds, int wid, int lane) const {
        PG8_LAS float* P = (PG8_LAS float*)lds;
        const int row0 = u.pm * BM + wr * 64 + fr, col0 = u.pn * BM + wc * 32 + 8 * fq;
#pragma unroll
        for (int ai = 0; ai < 2; ++ai)
#pragma unroll
            for (int m = 0; m < 4; ++m) { const size_t row = (size_t)(row0 + ai * HALF + m * 16); float ss = 0.f;
#pragma unroll
                for (int bj = 0; bj < 2; ++bj) { const size_t off = row * 2048 + col0 + bj * HALF;
                    const f32x4 v0 = acc[ai][bj][m][0] + __builtin_nontemporal_load((const f32x4*)(X + off)), v1 = acc[ai][bj][m][1] + __builtin_nontemporal_load((const f32x4*)(X + off + 4));
                    *(u32x4e*)(XB + off) = pack8f(v0, v1);
                    ss += (v0[0] * v0[0] + v0[1] * v0[1]) + (v0[2] * v0[2] + v0[3] * v0[3]) + (v1[0] * v1[0] + v1[1] * v1[1]) + (v1[2] * v1[2] + v1[3] * v1[3]); }
                ss += __shfl_xor(ss, 16); ss += __shfl_xor(ss, 32);
                if (fq == 0) P[(ai * HALF + wr * 64 + m * 16 + fr) * 4 + wc] = ss; }
        EPI_LDSBAR();
        const int tid = wid * 64 + lane;
        if (tid < 256) { const f32x4 p = *(const PG8_LAS f32x4*)(P + tid * 4); SSQ[(size_t)(u.pm * BM + tid) * 8 + u.pn] = (p[0] + p[1]) + (p[2] + p[3]); }
    }
};
#ifndef CONV_LDSW
#define CONV_LDSW 0
#endif
__device__ __forceinline__ float ror1f(float v) { return __builtin_bit_cast(float, __builtin_amdgcn_update_dpp(0, __builtin_bit_cast(int, v), 0x121, 0xf, 0xf, false)); }
__device__ __forceinline__ float ror2f(float v) { return __builtin_bit_cast(float, __builtin_amdgcn_update_dpp(0, __builtin_bit_cast(int, v), 0x122, 0xf, 0xf, false)); }
struct EpiUpConv {
    static constexpr bool PERM = true, AFTER_DRAIN = false, HAS_MID = false;
    const float* RSTD; const float* wconv; const float* bconv; bf16_t* ACT; float* US; PG8_LAS float* xl;
    __device__ __forceinline__ void operator()(f32x4 (&acc)[2][2][4][2], const Unit& u, int wr, int wc, int fr_in, int fq_in) const {
        typedef unsigned u32x2e __attribute__((ext_vector_type(2)));
        PG8_LAS float* wl = xl + (unsigned)(wr * 4 + wc) * 256u;
        { const unsigned L_ = threadIdx.x & 63u, ucol_ = (L_ >> 5) * 5632u + (unsigned)u.pn * 128u + (unsigned)wc * 32u + (L_ & 31u);
          const float t0_ = wconv[ucol_], t1_ = wconv[11264u + ucol_], t2_ = wconv[22528u + ucol_], t3_ = bconv[ucol_];
          wl[L_] = t0_; wl[64u + L_] = t1_; wl[128u + L_] = t2_; wl[192u + L_] = t3_;
          asm volatile("s_waitcnt lgkmcnt(0)" ::: "memory"); }
        (void)fr_in; (void)fq_in; int ln_ = (int)(threadIdx.x & 63u); asm volatile("" : "+v"(ln_)); const int fr = ln_ & 15, fq = ln_ >> 4;
        const unsigned cw = (unsigned)(u.pn * 128 + wc * 32 + 8 * fq), row0 = (unsigned)(u.pm * BM + wr * 64 + fr);
        const bool lo = fr < 2, hi14 = fr >= 14, f1 = fr >= 1, f2 = fr >= 2;
#pragma unroll
        for (int ai = 0; ai < 2; ++ai) { const unsigned G = (unsigned)(4 * u.pm + 2 * ai + wr);
            float rs[4];
#pragma unroll
            for (int m = 0; m < 4; ++m) rs[m] = RSTD[row0 + ai * HALF + m * 16];
            const unsigned aoff = (row0 + ai * HALF) * 5632u + cw;
            const unsigned us_lo = (G * 4 + 2 + (fr & 1)) * 11264u; const bool sthi = hi14 && (G + 1 < 128);
#pragma unroll
            for (int n = 0; n < 2; ++n) {
#pragma unroll
                for (int j = 0; j < 4; ++j) { unsigned col = cw + 4 * n + j; asm volatile("" : "+v"(col));
#pragma unroll
                    for (int bj = 0; bj < 2; ++bj) { const unsigned ucol = bj * 5632 + col;
                        const unsigned lc = (unsigned)bj * 32u + (col - (unsigned)u.pn * 128u - (unsigned)wc * 32u);
                        const float w0 = wl[lc], w1 = wl[64u + lc], w2 = wl[128u + lc], bb = wl[192u + lc];
                        float pa1 = 0.f, pa2 = 0.f;
#pragma unroll
                        for (int m = 0; m < 4; ++m) { const float uu = acc[ai][bj][m][n][j] * rs[m];
                            if (m == 0) { if (lo) US[us_lo + ucol] = uu; }
                            if (m == 3) { if (sthi) US[us_lo + 22528u + ucol] = uu; }
                            const float a1 = ror1f(uu), a2 = ror2f(uu);
                            const float p1 = f1 ? a1 : pa1, p2 = f2 ? a2 : pa2;
                            acc[ai][bj][m][n][j] = fmaf(w0, p2, fmaf(w1, p1, fmaf(w2, uu, bb)));
                            pa1 = a1; pa2 = a2; }
                        }
#pragma unroll
                    for (int m = 0; m < 4; ++m) { const float g0 = acc[ai][0][m][n][j]; acc[ai][0][m][n][j] = g0 * sigm(g0) * acc[ai][1][m][n][j]; }
                    asm volatile("" ::: "memory"); }
#pragma unroll
                for (int m = 0; m < 4; ++m) { u32x2e w; w.x = cvt_pk_bf16(acc[ai][0][m][n][0], acc[ai][0][m][n][1]); w.y = cvt_pk_bf16(acc[ai][0][m][n][2], acc[ai][0][m][n][3]);
                    if (!(m == 0 && lo)) *(u32x2e*)(ACT + (aoff + (unsigned)(m * 16 * 5632 + 4 * n))) = w; }
                asm volatile("" ::: "memory"); __builtin_amdgcn_sched_barrier(0); } }
    }
};
struct EpiUp {
    static constexpr bool PERM = true, AFTER_DRAIN = false, HAS_MID = false;
    const float* RSTD; bf16_t* U;
    __device__ __forceinline__ void operator()(f32x4 (&acc)[2][2][4][2], const Unit& u, int wr, int wc, int fr, int fq) const {
        const int row0 = u.pm * BM + wr * 64 + fr, col0 = u.pn * BM + wc * 32 + 8 * fq;
#pragma unroll
        for (int ai = 0; ai < 2; ++ai)
#pragma unroll
            for (int m = 0; m < 4; ++m) { const int row = row0 + ai * HALF + m * 16; const float rs = RSTD[row]; bf16_t* rowp = U + (size_t)row * 11264 + col0;
#pragma unroll
                for (int bj = 0; bj < 2; ++bj) *(u32x4e*)(rowp + bj * HALF) = pack8f(acc[ai][bj][m][0] * rs, acc[ai][bj][m][1] * rs); }
    }
};
struct EpiFinal {
    static constexpr bool PERM = true, AFTER_DRAIN = false, HAS_MID = false;
    const bf16_t* XB; float* OUT;
    __device__ __forceinline__ void operator()(f32x4 (&acc)[2][2][4][2], const Unit& u, int wr, int wc, int fr, int fq) const {
        const int row0 = u.pm * BM + wr * 64 + fr, col0 = u.pn * BM + wc * 32 + 8 * fq;
#pragma unroll
        for (int ai = 0; ai < 2; ++ai)
#pragma unroll
            for (int m = 0; m < 4; ++m)
#pragma unroll
                for (int bj = 0; bj < 2; ++bj) { const size_t off = (size_t)(row0 + ai * HALF + m * 16) * 2048 + col0 + bj * HALF;
                    const u32x4e w = __builtin_nontemporal_load((const u32x4e*)(XB + off));
                    const f32x4 a = {bflo(w.x), bfhi(w.x), bflo(w.y), bfhi(w.y)}, b = {bflo(w.z), bfhi(w.z), bflo(w.w), bfhi(w.w)};
                    __builtin_nontemporal_store(a + acc[ai][bj][m][0], (f32x4*)(OUT + off)); __builtin_nontemporal_store(b + acc[ai][bj][m][1], (f32x4*)(OUT + off + 4)); }
    }
};

template <class Epi, class Sched, bool ALIGN_EPI = false, bool SP2 = false>
__device__ __forceinline__ void gemm_phase(PG8_LAS unsigned char* lds, const Gemm g, const Sched& S, const Epi& E) {
    int tid_o = threadIdx.x; asm volatile("" : "+v"(tid_o));
    const int tid = tid_o, wid = __builtin_amdgcn_readfirstlane(tid >> 6), lane = tid & 63, wr = wid >> 2, wc = wid & 3, fr = lane & 15, fq = lane >> 4;
    const int K = g.K, nt = K / BK;
    unsigned voffA[1], voffB[1];
#pragma unroll
    for (int i = 0; i < 1; ++i) { int R, C; stage_rc(tid * 16 + i * 8192, R, C); const int Rb = Epi::PERM ? ((R & ~31) + perm32(R & 31)) : R;
        voffA[i] = (unsigned)(R * K + C) * 2u; voffB[i] = (unsigned)(Rb * K + C) * 2u; }
    const size_t vstep = (size_t)K * 128;
    const size_t kstep = (size_t)(BK * 2);
    const size_t hstep = (size_t)HALF * K * 2;
    const size_t tstep = 2 * hstep;
    const unsigned ldsw = (unsigned)wid * 1024u;
    const int aoff = lds_byte(wr * 64 + fr, fq * 8), boff = lds_byte(wc * 32 + fr, fq * 8);
#define PG8_SA(b, h) (((b) * 2 + (h)) * HTB)
#define PG8_SB(b, h) ((4 + (b) * 2 + (h)) * HTB)
#define PG8_STAGE(bufoff, gbase, voff) do { _Pragma("unroll") for (int _i = 0; _i < 2; ++_i) \
        __builtin_amdgcn_global_load_lds((const unsigned*)((const char*)(gbase) + (size_t)_i * vstep + (voff)[0]), (PG8_LAS unsigned*)(lds + (bufoff) + ldsw + _i * 8192), 16, 0, 0); } while (0)
#define PG8_LDA(dst, b, h) do { _Pragma("unroll") for (int m = 0; m < 4; ++m) _Pragma("unroll") for (int k = 0; k < 2; ++k) dst[m][k] = *(const PG8_LAS bf16x8*)(lds + PG8_SA(b, h) + aoff + m * 2048 + k * 1024); } while (0)
#define PG8_LDB(dst, b, h) do { _Pragma("unroll") for (int n = 0; n < 2; ++n) _Pragma("unroll") for (int k = 0; k < 2; ++k) dst[n][k] = *(const PG8_LAS bf16x8*)(lds + PG8_SB(b, h) + boff + n * 2048 + k * 1024); } while (0)
#define PG8_MMA(ai, bj, At, Bt) do { __builtin_amdgcn_s_setprio(1); _Pragma("unroll") for (int m = 0; m < 4; ++m) _Pragma("unroll") for (int n = 0; n < 2; ++n) _Pragma("unroll") for (int k = 0; k < 2; ++k) \
        acc[ai][bj][m][n] = __builtin_amdgcn_mfma_f32_16x16x32_bf16(Bt[n][k], At[m][k], acc[ai][bj][m][n], 0, 0, 0); __builtin_amdgcn_s_setprio(0); } while (0)
#define PG8_WAIT_V(n) asm volatile("s_waitcnt vmcnt(" #n ")" ::: "memory")
#define PG8_WAIT_L(n) asm volatile("s_waitcnt lgkmcnt(" #n ")" ::: "memory")
#define PG8_BAR __builtin_amdgcn_s_barrier()
#define PG8_SCHED __builtin_amdgcn_sched_barrier(0)
    Unit cur, nxt; int ui = 0;
    if (!S.next(0, cur)) return;
    f32x4 acc[2][2][4][2];
#pragma unroll
    for (int a = 0; a < 2; ++a)
#pragma unroll
        for (int b = 0; b < 2; ++b)
#pragma unroll
            for (int m = 0; m < 4; ++m)
#pragma unroll
                for (int n = 0; n < 2; ++n) acc[a][b][m][n] = (f32x4){0.f, 0.f, 0.f, 0.f};
    bf16x8 At[4][2], B0[2][2], B1[2][2];
    const char* cA = (const char*)g.A + (size_t)cur.pm * tstep; const char* cB = (const char*)g.Bt + (size_t)cur.pn * tstep;
    S.a_ready(cur);
    if constexpr (SP2) {
        PG8_STAGE(PG8_SB(0, 0), cB, voffB); PG8_STAGE(PG8_SB(0, 1), cB + hstep, voffB); PG8_STAGE(PG8_SA(0, 0), cA, voffA); PG8_STAGE(PG8_SA(0, 1), cA + hstep, voffA);
        if (wr == 1) PG8_BAR;
        PG8_WAIT_V(2); PG8_BAR;
        PG8_STAGE(PG8_SB(1, 0), cB + kstep, voffB); PG8_STAGE(PG8_SA(1, 0), cA + kstep, voffA); PG8_STAGE(PG8_SB(1, 1), cB + hstep + kstep, voffB);
        PG8_WAIT_V(6); PG8_BAR;
    } else {
        PG8_STAGE(PG8_SB(0, 0), cB, voffB); PG8_STAGE(PG8_SA(0, 0), cA, voffA); PG8_STAGE(PG8_SB(0, 1), cB + hstep, voffB); PG8_STAGE(PG8_SA(0, 1), cA + hstep, voffA);
        if (wr == 1) PG8_BAR;
        PG8_WAIT_V(4); PG8_BAR;
        PG8_STAGE(PG8_SB(1, 0), cB + kstep, voffB); PG8_STAGE(PG8_SA(1, 0), cA + kstep, voffA); PG8_STAGE(PG8_SB(1, 1), cB + hstep + kstep, voffB);
        PG8_WAIT_V(6); PG8_BAR;
    }
    for (;;) {
        const bool has_next = S.next(ui + 1, nxt);
        const char* nA = has_next ? (const char*)g.A + (size_t)nxt.pm * tstep : cA; const char* nB = has_next ? (const char*)g.Bt + (size_t)nxt.pn * tstep : cB;
        for (int t = 0; t < nt; t += 2) {
            if constexpr (Epi::HAS_MID) { if (t == (nt >> 1)) E.mid(acc, cur, wr, wc, fr, fq); }
            const bool last = (t == nt - 2);
            const char* a1 = cA + (size_t)(t + 1) * kstep;
            const char* a2 = last ? nA : cA + (size_t)(t + 2) * kstep; const char* b2 = last ? nB : cB + (size_t)(t + 2) * kstep;
            const char* a3 = a2 + kstep; const char* b3 = b2 + kstep;
            if (last && has_next) S.a_ready(nxt);
            if constexpr (SP2) {
            PG8_LDB(B0, 0, 0); PG8_LDB(B1, 0, 1); PG8_SCHED; PG8_LDA(At, 0, 0); PG8_STAGE(PG8_SA(1, 1), a1 + hstep, voffA);
            PG8_WAIT_V(8); PG8_WAIT_L(0); PG8_BAR; PG8_MMA(0, 0, At, B0); PG8_MMA(0, 1, At, B1); PG8_BAR; PG8_SCHED;
            PG8_LDA(At, 0, 1); PG8_STAGE(PG8_SB(0, 0), b2, voffB); PG8_STAGE(PG8_SB(0, 1), b2 + hstep, voffB); PG8_STAGE(PG8_SA(0, 0), a2, voffA);
            PG8_WAIT_V(8); PG8_WAIT_L(0); PG8_BAR; PG8_MMA(1, 0, At, B0); PG8_MMA(1, 1, At, B1); PG8_BAR; PG8_SCHED;
            PG8_LDB(B0, 1, 0); PG8_LDB(B1, 1, 1); PG8_SCHED; PG8_LDA(At, 1, 0); PG8_STAGE(PG8_SA(0, 1), a2 + hstep, voffA);
            PG8_WAIT_V(8); PG8_WAIT_L(0); PG8_BAR; PG8_MMA(0, 0, At, B0); PG8_MMA(0, 1, At, B1); PG8_BAR; PG8_SCHED;
            PG8_LDA(At, 1, 1); PG8_STAGE(PG8_SB(1, 0), b3, voffB); PG8_STAGE(PG8_SB(1, 1), b3 + hstep, voffB); PG8_STAGE(PG8_SA(1, 0), a3, voffA);
            PG8_WAIT_V(8); PG8_WAIT_L(0); PG8_BAR; PG8_MMA(1, 0, At, B0); PG8_MMA(1, 1, At, B1); PG8_BAR; PG8_SCHED;
            } else {
            PG8_LDB(B0, 0, 0); PG8_SCHED; PG8_LDA(At, 0, 0); PG8_STAGE(PG8_SA(1, 1), a1 + hstep, voffA);
            PG8_WAIT_L(8); PG8_BAR; PG8_WAIT_L(0); PG8_MMA(0, 0, At, B0); PG8_BAR; PG8_SCHED;
            PG8_LDB(B1, 0, 1); PG8_STAGE(PG8_SB(0, 0), b2, voffB);
            PG8_BAR; PG8_WAIT_L(0); PG8_MMA(0, 1, At, B1); PG8_BAR;
            PG8_LDA(At, 0, 1); PG8_STAGE(PG8_SA(0, 0), a2, voffA);
            PG8_BAR; PG8_WAIT_L(0); PG8_MMA(1, 0, At, B0); PG8_BAR; PG8_SCHED;
            PG8_STAGE(PG8_SB(0, 1), b2 + hstep, voffB);
            PG8_WAIT_V(6); PG8_BAR; PG8_MMA(1, 1, At, B1); PG8_BAR;
            PG8_LDB(B0, 1, 0); PG8_SCHED; PG8_LDA(At, 1, 0); PG8_STAGE(PG8_SA(0, 1), a2 + hstep, voffA);
            PG8_WAIT_L(8); PG8_BAR; PG8_WAIT_L(0); PG8_MMA(0, 0, At, B0); PG8_BAR; PG8_SCHED;
            PG8_LDB(B1, 1, 1); PG8_STAGE(PG8_SB(1, 0), b3, voffB);
            PG8_BAR; PG8_WAIT_L(0); PG8_MMA(0, 1, At, B1); PG8_BAR;
            PG8_LDA(At, 1, 1); PG8_STAGE(PG8_SA(1, 0), a3, voffA);
            PG8_BAR; PG8_WAIT_L(0); PG8_MMA(1, 0, At, B0); PG8_BAR; PG8_SCHED;
            PG8_STAGE(PG8_SB(1, 1), b3 + hstep, voffB);
            PG8_WAIT_V(6); PG8_BAR; PG8_MMA(1, 1, At, B1); PG8_BAR;
            }
        }
        if constexpr (ALIGN_EPI) { if (wr == 0) PG8_BAR; }
        if constexpr (!Epi::AFTER_DRAIN) { E(acc, cur, wr, wc, fr, fq); S.done(cur); }
        if (!has_next) break;
#pragma unroll
        for (int a = 0; a < 2; ++a)
#pragma unroll
            for (int b = 0; b < 2; ++b)
#pragma unroll
                for (int m = 0; m < 4; ++m)
#pragma unroll
                    for (int n = 0; n < 2; ++n) acc[a][b][m][n] = (f32x4){0.f, 0.f, 0.f, 0.f};
        cur = nxt; cA = nA; cB = nB; ++ui;
        if constexpr (ALIGN_EPI) { if (wr == 1) PG8_BAR; }
    }
    PG8_WAIT_V(0);
    if constexpr (!ALIGN_EPI) { if (wr == 0) PG8_BAR; }
    PG8_BAR;
    if constexpr (Epi::AFTER_DRAIN) { E.fused(acc, cur, wr, wc, fr, fq, lds, wid, lane); S.done(cur); }
#undef PG8_SA
#undef PG8_SB
#undef PG8_STAGE
#undef PG8_LDA
#undef PG8_LDB
#undef PG8_MMA
#undef PG8_WAIT_V
#undef PG8_WAIT_L
#undef PG8_BAR
#undef PG8_SCHED
}
}

namespace att {
typedef unsigned short bf16;
constexpr int D = 128, NW = 8, QBLK = 32, KVBLK = 64, QB = NW * QBLK;
constexpr int SHM_V = KVBLK * D * 2, SHM_K = KVBLK * D * 2;
constexpr int LDS_WS = 2 * SHM_V + 2 * SHM_K, LDS_KB = LDS_WS + NW * 64 * 4, LDS_SLOT = LDS_KB + 2 * 64 * 4, LDS_Q = LDS_SLOT + 256, LDS_END = LDS_Q + NW * 8192;
constexpr float SCALE = 1.f, THR = 8.f;
typedef short bf16x8 __attribute__((ext_vector_type(8)));
typedef short s16x4 __attribute__((ext_vector_type(4)));
typedef float f32x16 __attribute__((ext_vector_type(16)));
typedef float f32x4 __attribute__((ext_vector_type(4)));
typedef unsigned u32x4 __attribute__((ext_vector_type(4)));
template <class A, class Bt> struct same_t { static constexpr bool v = false; };
template <class A> struct same_t<A, A> { static constexpr bool v = true; };

#define KSWZ(row, colB) ((row) * 256 + ((colB) ^ (((row) & 7) << 4)))
#define SBAR() __builtin_amdgcn_sched_barrier(0)
__device__ __forceinline__ int v_st(int k, int c) { const int kk = (k & ~0xC) | ((k & 4) << 1) | ((k & 8) >> 1); return ((kk >> 3) * 4 + (c >> 5)) * 512 + ((kk & 7) * 32 + (c & 31)) * 2; }
__device__ __forceinline__ int v_rd_base(int lane) { return ((lane & 3) << 3) | (((lane >> 2) & 3) << 6) | (((lane >> 4) & 1) << 5) | (((lane >> 5) & 1) << 8); }
constexpr int v_rd_off(int d0, int ks, int half) { return d0 * 512 + ks * 4096 + half * 2048; }
__device__ __forceinline__ int crow(int r, int hi) { return (r & 3) + 8 * (r >> 2) + 4 * hi; }
__device__ __forceinline__ unsigned cvtpk(float lo, float hi) {
    unsigned r; asm volatile("v_cvt_pk_bf16_f32 %0, %1, %2" : "=v"(r) : "v"(lo), "v"(hi)); return r;
}
__device__ __forceinline__ bf16x8 pack8(f32x4 a, f32x4 b) {
    u32x4 w = {cvtpk(a[0], a[1]), cvtpk(a[2], a[3]), cvtpk(b[0], b[1]), cvtpk(b[2], b[3])};
    return *reinterpret_cast<bf16x8*>(&w);
}
template <class T> __device__ __forceinline__ bf16x8 load8(const T* p) {
    if constexpr (same_t<T, float>::v) { return pack8(*(const f32x4*)p, *(const f32x4*)(p + 4)); }
    else { return *reinterpret_cast<const bf16x8*>(p); }
}
__device__ __forceinline__ void mask_tile(f32x16& p0, f32x16& p1, int dq, unsigned W) {
    const float NEG = -__builtin_inff();
#pragma unroll
    for (int r = 0; r < 16; ++r) {
        const int c = (r & 3) + 8 * (r >> 2);
        if ((unsigned)(dq - c) >= W) p0[r] = NEG;
        if ((unsigned)(dq - c - 32) >= W) p1[r] = NEG;
    }
}
__device__ __forceinline__ void partialSM(f32x16& p0, f32x16& p1, float& m_reg, float& mn, float& alpha) {
    float pmax = p0[0]; for (int r = 1; r < 16; ++r) pmax = fmaxf(pmax, p0[r]); for (int r = 0; r < 16; ++r) pmax = fmaxf(pmax, p1[r]);
    { auto rr = __builtin_amdgcn_permlane32_swap(__float_as_uint(pmax), __float_as_uint(pmax), false, false);
      pmax = fmaxf(__uint_as_float(rr[0]), __uint_as_float(rr[1])); }
    constexpr float C2 = 1.f;
    if (__builtin_expect(__all((pmax - m_reg) * SCALE <= THR), 1)) { mn = m_reg; alpha = 1.f; }
    else { mn = fmaxf(m_reg, pmax); alpha = __builtin_amdgcn_exp2f((m_reg - mn) * C2); m_reg = mn; }
    const float mnL = -mn * C2;
    for (int r = 0; r < 16; ++r) p0[r] = fmaf(p0[r], C2, mnL); for (int r = 0; r < 16; ++r) p1[r] = fmaf(p1[r], C2, mnL);
    for (int r = 0; r < 16; ++r) p0[r] = __builtin_amdgcn_exp2f(p0[r]);
}
__device__ __forceinline__ void finishSM(f32x16& p0, f32x16& p1, float alpha, float& l_reg, bf16x8& pa0, bf16x8& pa1, bf16x8& pa2, bf16x8& pa3) {
    for (int r = 0; r < 16; ++r) p1[r] = __builtin_amdgcn_exp2f(p1[r]);
    float ps = 0; for (int r = 0; r < 16; ++r) ps += p0[r]; for (int r = 0; r < 16; ++r) ps += p1[r];
    { auto rr = __builtin_amdgcn_permlane32_swap(__float_as_uint(ps), __float_as_uint(ps), false, false);
      ps = __uint_as_float(rr[0]) + __uint_as_float(rr[1]); }
    l_reg = l_reg * alpha + ps;
#define PK4(P, B_, OUT) do { unsigned a0 = cvtpk(P[B_+0], P[B_+1]), a1 = cvtpk(P[B_+2], P[B_+3]);                          \
        unsigned b0 = cvtpk(P[B_+4], P[B_+5]), b1 = cvtpk(P[B_+6], P[B_+7]);                                             \
        auto r0 = __builtin_amdgcn_permlane32_swap(a0, b0, false, false); auto r1 = __builtin_amdgcn_permlane32_swap(a1, b1, false, false); \
        u32x4 w = {r0[0], r1[0], r0[1], r1[1]}; OUT = *reinterpret_cast<bf16x8*>(&w); } while (0)
    PK4(p0, 0, pa0); PK4(p0, 8, pa1); PK4(p1, 0, pa2); PK4(p1, 8, pa3);
#undef PK4
}
template <int KB, bool SK>
__device__ __forceinline__ void qkt(f32x16& p0, f32x16& p1, const char* K_lds, const float* kbl, int r32, int hi, const __attribute__((address_space(3))) char* q_lds, bool act) {
    if (SK && !act) { const float NEG = -__builtin_inff();
#pragma unroll
        for (int r = 0; r < 16; ++r) { p0[r] = NEG; p1[r] = NEG; } return; }
    { const float* kb_ = kbl + KB * 64 + 4 * hi;
#pragma unroll
      for (int j = 0; j < 4; ++j) { const f32x4 a = *(const f32x4*)(kb_ + 8 * j), b = *(const f32x4*)(kb_ + 32 + 8 * j);
          p0[4 * j] = a[0]; p0[4 * j + 1] = a[1]; p0[4 * j + 2] = a[2]; p0[4 * j + 3] = a[3];
          p1[4 * j] = b[0]; p1[4 * j + 1] = b[1]; p1[4 * j + 2] = b[2]; p1[4 * j + 3] = b[3]; } }
    const char* kb[4];
#pragma unroll
    for (int dd = 0; dd < 4; ++dd) kb[dd] = K_lds + KB * SHM_K + KSWZ(r32, (dd * 16 + hi * 8) * 2);
#pragma unroll
    for (int d0 = 0; d0 < 8; ++d0) { const char* a = kb[d0 & 3] + (d0 >> 2) * 128;
        bf16x8 b0 = *reinterpret_cast<const bf16x8*>(a);
        bf16x8 b1 = *reinterpret_cast<const bf16x8*>(a + 32 * 256);
        const bf16x8 q_ = *(const __attribute__((address_space(3))) bf16x8*)(q_lds + d0 * 1024);
        p0 = __builtin_amdgcn_mfma_f32_32x32x16_bf16(b0, q_, p0, 0, 0, 0);
        p1 = __builtin_amdgcn_mfma_f32_32x32x16_bf16(b1, q_, p1, 0, 0, 0); }
}
template <int VB, bool SK>
__device__ __forceinline__ void pv_tile(f32x16* o, int vb0, bf16x8 pa0, bf16x8 pa1, bf16x8 pa2, bf16x8 pa3, bool act) {
    if (SK && !act) return;
#define TRRD(dst, off) asm volatile("ds_read_b64_tr_b16 %0, %1 offset:%2" : "=&v"(dst) : "v"(vb0), "i"(off) : "memory")
#define PV_D0(d0) do { s16x4 l0, l1, l2, l3, h0, h1, h2, h3; constexpr int b_ = VB * SHM_V + v_rd_off(d0, 0, 0);     \
        TRRD(l0, b_); TRRD(h0, b_ + 2048); TRRD(l1, b_ + 4096); TRRD(h1, b_ + 6144); TRRD(l2, b_ + 8192); TRRD(h2, b_ + 10240); TRRD(l3, b_ + 12288); TRRD(h3, b_ + 14336); \
        asm volatile("s_waitcnt lgkmcnt(0)" ::: "memory"); SBAR();                 \
        o[d0] = __builtin_amdgcn_mfma_f32_32x32x16_bf16(pa0, (bf16x8){l0[0], l0[1], l0[2], l0[3], h0[0], h0[1], h0[2], h0[3]}, o[d0], 0, 0, 0);   \
        o[d0] = __builtin_amdgcn_mfma_f32_32x32x16_bf16(pa1, (bf16x8){l1[0], l1[1], l1[2], l1[3], h1[0], h1[1], h1[2], h1[3]}, o[d0], 0, 0, 0);   \
        o[d0] = __builtin_amdgcn_mfma_f32_32x32x16_bf16(pa2, (bf16x8){l2[0], l2[1], l2[2], l2[3], h2[0], h2[1], h2[2], h2[3]}, o[d0], 0, 0, 0);   \
        o[d0] = __builtin_amdgcn_mfma_f32_32x32x16_bf16(pa3, (bf16x8){l3[0], l3[1], l3[2], l3[3], h3[0], h3[1], h3[2], h3[3]}, o[d0], 0, 0, 0); } while (0)
    PV_D0(0); PV_D0(1); PV_D0(2); PV_D0(3);
#undef PV_D0
#undef TRRD
}

constexpr float LOG2E = 1.4426950408889634f;
struct Blk {
    const bf16* Q; const bf16* K; const bf16* V; bf16* O; float* LSE; const float* CUM;
    long rs, os; int ls;
    int P0, L, W, nvalid; float sd2, cref;
};
struct Seam { bf16x8 st_v0, st_v1, st_k0, st_k1; float st_b0, st_b1; };
__device__ __forceinline__ float kbias_raw(const Blk& B, int key) { return B.CUM ? B.CUM[key] : B.sd2 * (float)(key - B.P0); }
__device__ __forceinline__ float kbias_fin(const Blk& B, float raw) { return B.CUM ? -raw * LOG2E : raw; }
__device__ __forceinline__ int swa_jlo(int P0, int W) { const int lowk = P0 - W + 1; return lowk > 0 ? lowk / KVBLK : 0; }
__device__ __forceinline__ int swa_jhi(int P0, int L) { int j = (P0 + QB - 1) / KVBLK + 1; const int jm = L / KVBLK; return j > jm ? jm : j; }
__device__ __forceinline__ bf16x8 ld8(const bf16* p) { return *reinterpret_cast<const bf16x8*>(p); }
#define ROWP(p, rs_, k0, rr) ((p) + (size_t)(k0) * (rs_) + (unsigned)(((rr) * (int)(rs_)) + sc))
#define VMW() asm volatile("s_waitcnt vmcnt(0)" ::: "memory")
#define SLOAD(B_, k0) do { const bf16* vb_ = (B_).V + (size_t)(k0) * (B_).rs; const bf16* kb_ = (B_).K + (size_t)(k0) * (B_).rs;     \
                           unsigned o0_ = (unsigned)(sr * (int)(B_).rs + sc), o1_ = o0_ + 32u * (unsigned)(B_).rs; asm volatile("" : "+v"(o0_), "+v"(o1_));       \
                           S.st_v0 = ld8(vb_ + o0_); S.st_v1 = ld8(vb_ + o1_); S.st_k0 = ld8(kb_ + o0_); S.st_k1 = ld8(kb_ + o1_);                                  \
                           if ((tid & 15) == 0) { S.st_b0 = kbias_raw((B_), (k0) + sr); S.st_b1 = kbias_raw((B_), (k0) + 32 + sr); } } while (0)
#define SWRITE_K(bf, B_) do { *(bf16x8*)(K_lds + (bf) * SHM_K + kws) = S.st_k0; *(bf16x8*)(K_lds + (bf) * SHM_K + kws + 32 * 256) = S.st_k1;       \
                          if ((tid & 15) == 0) { kbl[(bf) * 64 + sr] = kbias_fin((B_), S.st_b0); kbl[(bf) * 64 + 32 + sr] = kbias_fin((B_), S.st_b1); } } while (0)
#define SWRITE_V(bf) do { *(bf16x8*)(V_lds + (bf) * SHM_V + vst0) = S.st_v0; *(bf16x8*)(V_lds + (bf) * SHM_V + vst1) = S.st_v1; } while (0)
#define QLOAD(B_) do { const int ri_ = (wid * QBLK + r32 < (B_).nvalid) ? wid * QBLK + r32 : (B_).nvalid - 1;                                    \
        const bf16* qp_ = (B_).Q + (unsigned)(ri_ * (int)(B_).rs + hi * 8);                                                                       \
        _Pragma("unroll") for (int hf_ = 0; hf_ < 2; ++hf_) { bf16x8 t_[4];                                                                      \
            _Pragma("unroll") for (int d0 = 0; d0 < 4; ++d0) t_[d0] = ld8(qp_ + (hf_ * 4 + d0) * 16);                                           \
            _Pragma("unroll") for (int d0 = 0; d0 < 4; ++d0) *(__attribute__((address_space(3))) bf16x8*)(q_lds + (hf_ * 4 + d0) * 1024) = t_[d0]; } } while (0)

__device__ __forceinline__ void prime(const Blk& cur, char* lds, Seam& S) {
    int tid_o = threadIdx.x; asm volatile("" : "+v"(tid_o));
    const int tid = tid_o, wid = __builtin_amdgcn_readfirstlane(tid >> 6), lane = tid & 63, r32 = lane & 31, hi = lane >> 5;
    const int sr = tid >> 4, sc = (tid & 15) * 8, kws = KSWZ(sr, sc * 2); char* K_lds = lds + 2 * SHM_V; float* kbl = (float*)(lds + LDS_KB); __attribute__((address_space(3))) char* q_lds = (__attribute__((address_space(3))) char*)(lds + LDS_Q + wid * 8192 + lane * 16);
    const int kb0 = (swa_jhi(cur.P0, cur.L) - 1) * KVBLK;
    S.st_b0 = 0.f; S.st_b1 = 0.f;
    QLOAD(cur);
    SLOAD(cur, kb0); VMW(); SWRITE_K(0, cur);
    __syncthreads();
}
#ifndef ATT_SK
#define ATT_SK true
#endif
struct AttnArgs { const bf16* QKV; unsigned char* ws; long offOA, offOP0, offOP2x; float* LSE; const float* CUM; };
__device__ __forceinline__ Blk decode(int i, const AttnArgs& A);
template <bool SK>
__device__ __forceinline__ bool block(const Blk& cur, Blk& nxt, int pend, int nitems, volatile int* slot, const AttnArgs& A, char* lds, Seam& S) {
    int tid_o = threadIdx.x; asm volatile("" : "+v"(tid_o));
    const int tid = tid_o, wid = __builtin_amdgcn_readfirstlane(tid >> 6), lane = tid & 63, r32 = lane & 31, hi = lane >> 5;
    const int W = cur.W;
    const int j_lo = swa_jlo(cur.P0, W);
    const int j_hi = swa_jhi(cur.P0, cur.L);
    const int NT = j_hi - j_lo;
    const int qlo = cur.P0 + wid * QBLK, qm = qlo + r32 - 4 * hi;
    char* V_lds = lds; char* K_lds = lds + 2 * SHM_V;
    float* ws = (float*)(lds + LDS_WS) + wid * 64; float* li_l = ws, * al_l = ws + 32; float* kbl = (float*)(lds + LDS_KB); __attribute__((address_space(3))) char* q_lds = (__attribute__((address_space(3))) char*)(lds + LDS_Q + wid * 8192 + lane * 16);
    float m_reg = -1e30f, l_reg = 0; f32x16 o[4] = {};
    const int sr = tid >> 4, sc = (tid & 15) * 8, vst0 = v_st(sr, sc), vst1 = v_st(32 + sr, sc), kws = KSWZ(sr, sc * 2);
    const int vb0 = (int)(uintptr_t)V_lds + v_rd_base(lane);
#define RESC(a) do { if (__any((a) < 1.f)) { if (hi == 0) al_l[r32] = (a); asm volatile("s_waitcnt lgkmcnt(0)" ::: "memory");              \
                     for (int d_ = 0; d_ < 4; ++d_) for (int r = 0; r < 16; ++r) o[d_][r] *= al_l[crow(r, hi)]; } } while (0)
#define KBASE(t) ((j_hi - 1 - (t)) * KVBLK)
#define ACT(t) (KBASE(t) <= qlo + QBLK - 1 && KBASE(t) + KVBLK - 1 >= qlo - W + 1)
#define MASKT(P0_, P1_, t) do { const int kb_ = KBASE(t); if ((!SK || ACT(t)) && (kb_ + KVBLK - 1 > qlo || kb_ <= qlo + QBLK - 1 - W)) mask_tile(P0_, P1_, qm - kb_, (unsigned)W); } while (0)
    f32x16 pA0, pA1, pB0, pB1; float mnA, mnB, alA, alB; bf16x8 pa0, pa1, pa2, pa3;
    SWRITE_V(0); SBAR();
    if (NT > 1) SLOAD(cur, KBASE(1));
    SBAR(); qkt<0, SK>(pA0, pA1, K_lds, kbl, r32, hi, q_lds, ACT(0));
    MASKT(pA0, pA1, 0); partialSM(pA0, pA1, m_reg, mnA, alA);
    if (NT > 1) { VMW(); SWRITE_V(1); SWRITE_K(1, cur); }
    __syncthreads();
#define HALF_STEP(PX0, PX1, mnX, alX, PY0, PY1, alY, t, KB, VB, SB) do {                                                      \
        SBAR(); qkt<KB, SK>(PX0, PX1, K_lds, kbl, r32, hi, q_lds, ACT(t));                                                     \
        finishSM(PY0, PY1, alY, l_reg, pa0, pa1, pa2, pa3); SBAR();                                                           \
        if ((t) + 1 < NT) { SLOAD(cur, KBASE((t) + 1)); SBAR(); }                                                             \
        pv_tile<VB, SK>(o, vb0, pa0, pa1, pa2, pa3, ACT((t) - 1)); MASKT(PX0, PX1, (t)); partialSM(PX0, PX1, m_reg, mnX, alX); \
        __syncthreads();                                                                                                      \
        if ((t) + 1 < NT) { VMW(); SWRITE_V(SB); SWRITE_K(SB, cur); }                                                              \
        RESC(alX); __syncthreads(); } while (0)
    for (int t = 1; t + 1 < NT; t += 2) {
        HALF_STEP(pB0, pB1, mnB, alB, pA0, pA1, alA, t, 1, 0, 0);
        HALF_STEP(pA0, pA1, mnA, alA, pB0, pB1, alB, t + 1, 0, 1, 1);
    }
    const bool even = (NT & 1) == 0;
    if (even) { SBAR(); qkt<1, SK>(pB0, pB1, K_lds, kbl, r32, hi, q_lds, ACT(NT - 1)); SBAR(); }
    if (tid == 0) slot[0] = pend;
    __syncthreads();
    const int ni = __builtin_amdgcn_readfirstlane(slot[0]); const bool last = ni >= nitems;
    nxt = decode(last ? 0 : ni, A);
    if (!last) { const int kbn = (swa_jhi(nxt.P0, nxt.L) - 1) * KVBLK;
        SLOAD(nxt, kbn); SBAR();
        QLOAD(nxt); }
    SBAR();
    finishSM(pA0, pA1, alA, l_reg, pa0, pa1, pa2, pa3); SBAR();
    pv_tile<0, SK>(o, vb0, pa0, pa1, pa2, pa3, ACT(even ? NT - 2 : NT - 1));
    if (even) { MASKT(pB0, pB1, NT - 1); partialSM(pB0, pB1, m_reg, mnB, alB); __syncthreads(); RESC(alB);
        finishSM(pB0, pB1, alB, l_reg, pa0, pa1, pa2, pa3); SBAR(); pv_tile<1, SK>(o, vb0, pa0, pa1, pa2, pa3, ACT(NT - 1)); }
    SBAR(); if (!last) SWRITE_K(0, nxt); SBAR();
    int lne_ = (int)(threadIdx.x & 63u); asm volatile("" : "+v"(lne_)); const int r32e = lne_ & 31, hie = lne_ >> 5;
    if (hie == 0) li_l[r32e] = l_reg; asm volatile("s_waitcnt lgkmcnt(0)" ::: "memory");
    float rli[16];
#pragma unroll
    for (int r = 0; r < 16; ++r) rli[r] = __builtin_amdgcn_rcpf(li_l[crow(r, hie)]);
    bf16* Ow = cur.O + (size_t)(wid * QBLK) * cur.os;
#pragma unroll
    for (int r = 0; r < 16; ++r) { const int orow = crow(r, hie); const bool ok = (wid * QBLK + orow < cur.nvalid) && ((r32e & 1) == 0);
#pragma unroll
        for (int d0 = 0; d0 < 4; ++d0) { const float v = o[d0][r] * rli[r]; const float vn = __shfl_xor(v, 1);
            if (ok) *(unsigned*)(Ow + (unsigned)(orow * (int)cur.os + d0 * 32 + r32e)) = cvtpk(v, vn); } }
    if (cur.LSE && hie == 0 && wid * QBLK + r32e < cur.nvalid)
        cur.LSE[(unsigned)((wid * QBLK + r32e) * cur.ls)] = m_reg + __builtin_amdgcn_logf(l_reg) - cur.sd2 * (float)(wid * QBLK + r32e);
    __syncthreads();
    return last;
#undef RESC
#undef KBASE
#undef ACT
#undef MASKT
#undef HALF_STEP
}
#undef ROWP
#undef VMW
#undef SLOAD
#undef SWRITE_K
#undef SWRITE_V
#undef QLOAD

constexpr int NITEMS = 256 + 256 + 256 + 512;
__device__ __forceinline__ Blk decode(int i_in, const AttnArgs& A) {
    const int i = __builtin_amdgcn_readfirstlane(i_in);
    Blk b; int bh, qb, res, dil, pat; const bool fox = i < 256;
    if (i < 256) { qb = 7 - (i >> 5); bh = i & 31; res = 0; dil = 1; pat = 0; }
    else if (i < 512) { const int j = i - 256; qb = 7 - (j >> 5); bh = j & 31; res = 0; dil = 1; pat = 0; }
    else if (i < 768) { const int j = i - 512; bh = j & 31; const int rest = j >> 5; res = rest >> 1; qb = rest & 1; dil = 4; pat = 1; }
    else { const int j = i - 768; bh = j & 31; res = j >> 5; qb = 0; dil = 16; pat = 2; }
    const int bb = bh >> 3, h = bh & 7, L = 2048 / dil, P0 = qb * 256;
    const size_t tok0 = (size_t)bb * 2048 + res;
    const int seg = fox ? 0 : 3;
    const bf16* base = A.QKV + tok0 * 6144 + h * 128;
    const int opitch = fox ? 2048 : 1024;
    b.rs = (long)dil * 6144; b.os = (long)dil * opitch; b.ls = dil * 8;
    b.Q = base + seg * 1024 + (size_t)P0 * b.rs; b.K = base + (seg + 1) * 1024; b.V = base + (seg + 2) * 1024;
    long ooff = A.offOP0 + (long)pat * (16l << 20) + (pat == 2 ? A.offOP2x : 0l); ooff = fox ? A.offOA : ooff;
    bf16* ob = (bf16*)(A.ws + ooff);
    b.O = ob + (tok0 + (size_t)P0 * dil) * opitch + h * 128;
    float* lb = A.LSE + (size_t)pat * (8192 * 8);
    b.LSE = fox ? nullptr : lb + (tok0 + (size_t)P0 * dil) * 8 + h;
    b.CUM = fox ? A.CUM + (size_t)bh * 2048 : nullptr;
    b.cref = 0.f;
    b.P0 = P0; b.L = L; b.W = fox ? (1 << 30) : 129; b.nvalid = (L - P0) < QB ? (L - P0) : QB;
    b.sd2 = fox ? 0.f : __builtin_amdgcn_exp2f(-(float)(h + 1)) * (float)dil * LOG2E;
    return b;
}
__device__ __forceinline__ void attn_phase(char* lds, const AttnArgs& A, unsigned* ctr, int first = 0) {
    volatile int* slot = (volatile int*)(lds + LDS_SLOT);
    const int G = (int)gridDim.x, ci = first + (int)blockIdx.x;
    if (ci >= NITEMS) return;
    Blk cur = decode(ci, A); Seam S;
    prime(cur, lds, S);
    for (;;) {
        int pend = NITEMS; if (threadIdx.x == 0) pend = first + G + (int)atomicAdd(ctr, 1u);
        Blk nxt; bool last;
        if (cur.CUM) last = block<false>(cur, nxt, pend, NITEMS, slot, A, lds, S);
        else last = block<true>(cur, nxt, pend, NITEMS, slot, A, lds, S);
        if (last) break;
        cur = nxt;
    }
}
#undef SBAR
}

#define GAS __attribute__((address_space(1)))
#define LAS __attribute__((address_space(3)))
typedef unsigned short bf16;
typedef unsigned v4u __attribute__((ext_vector_type(4)));
typedef float f32x4 __attribute__((ext_vector_type(4)));
constexpr int NWAVES = 8;
constexpr int NB = 4, SEQ = 2048, DM = 2048, M = NB * SEQ, NH = 8, HD = 128, DFF = 5632, NUP = 2 * DFF, INC = 10248, NPROJ = 10240;
constexpr float EPS = 1e-6f;
constexpr float LOG2E_F = 1.4426950408889634f;
constexpr size_t MiB = 1u << 20;
constexpr size_t WS_CTL = 0, WS_BAR = 64 * 1024;
constexpr size_t WS_GAIN = 2 * MiB, WS_RSTD = 3 * MiB;
constexpr size_t WS_SSQ = 256 * 1024, WS_CUM = 512 * 1024, WS_LOGF = 768 * 1024, WS_LSE = 1 * MiB;
constexpr size_t WS_WIN = 4 * MiB, WS_WBRF = 44 * MiB, WS_WBRD = 48 * MiB, WS_WOUT = 52 * MiB, WS_WUP = 60 * MiB, WS_WDN = 104 * MiB;
constexpr size_t WS_XN = 126 * MiB;
constexpr size_t WS_QKV = 158 * MiB;
constexpr size_t WS_GATES = 254 * MiB;
constexpr size_t WS_OA = 4 * MiB, WS_OB = 20 * MiB;
constexpr size_t WS_OP0 = 126 * MiB, WS_OP1 = 142 * MiB, WS_OP2 = 318 * MiB;
constexpr size_t WS_T = 158 * MiB, WS_MG = 222 * MiB;
constexpr size_t WS_XB = 126 * MiB;
#ifndef CONV_ALIGN
#define CONV_ALIGN false
#endif
#ifndef FUSED_CONV
#define FUSED_CONV 0
#endif
constexpr size_t WS_U = 158 * MiB;
constexpr size_t WS_ACT = FUSED_CONV ? 158 * MiB : 4 * MiB, WS_US = 254 * MiB;
constexpr size_t WS_END = 334 * MiB;
constexpr int RING_BYTES = 131072, XL_OFF = RING_BYTES, BARST_OFF = 143360, LDS_BYTES = 147456;
static_assert(att::LDS_END <= LDS_BYTES, "attention LDS");

__device__ __forceinline__ unsigned f2bf(float f) { unsigned u = __builtin_bit_cast(unsigned, f); return (u + 0x7fffu + ((u >> 16) & 1u)) >> 16; }
__device__ __forceinline__ unsigned pk2(float lo, float hi) { return f2bf(lo) | (f2bf(hi) << 16); }
__device__ __forceinline__ float wave_sum(float v) {
#pragma unroll
    for (int o = 1; o < 64; o <<= 1) v += __shfl_xor(v, o);
    return v;
}
template <int MODE, bool NTST>
__device__ __forceinline__ void transpose_matrix(const float* W, int K, int Nsrc, int Ndst, bf16* WT, int Kdst, int koff, const float* kscale, int rot, int gw, int NGW, LAS float* scr, int lane) {
    const int nblk = Ndst / 32, nitems = (K / 64) * nblk, rr = lane >> 3, c4 = (lane & 7) * 4, c = lane & 7;
    int it = gw - rot; if (it < 0) it += NGW;
    f32x4 v[8]; int k0 = 0, n0 = 0;
#define TM_LOAD(dst, IT, K0, N0) do { const int kb_ = (IT) / nblk; N0 = 32 * ((IT) - kb_ * nblk); K0 = 64 * kb_;                                   \
        const int sc_ = MODE == 0 ? N0 : (MODE == 1 ? (N0 < 3072 ? N0 : N0 + 8) : (((N0 >> 7) & 1) * 5632 + 128 * (N0 >> 8) + (N0 & 127)));       \
        _Pragma("unroll") for (int i = 0; i < 8; ++i) dst[i] = __builtin_nontemporal_load((const f32x4*)(W + (size_t)(K0 + 8 * i + rr) * Nsrc + sc_ + c4)); } while (0)
    if (it < nitems) TM_LOAD(v, it, k0, n0);
    while (it < nitems) {
        const int itn = it + NGW; f32x4 vn[8]; int k0n = 0, n0n = 0;
        if (itn < nitems) TM_LOAD(vn, itn, k0n, n0n);
        if (kscale) {
#pragma unroll
            for (int i = 0; i < 8; ++i) v[i] = v[i] * kscale[k0 + 8 * i + rr]; }
#pragma unroll
        for (int i = 0; i < 8; ++i) { LAS float* d = scr + (8 * i + rr) * 33 + c4; d[0] = v[i][0]; d[1] = v[i][1]; d[2] = v[i][2]; d[3] = v[i][3]; }
        asm volatile("s_waitcnt lgkmcnt(0)" ::: "memory");
#pragma unroll
        for (int j = 0; j < 4; ++j) { const int n = (lane >> 3) + 8 * j; const LAS float* sp = scr + (8 * c) * 33 + n;
            v4u o; o.x = pk2(sp[0 * 33], sp[1 * 33]); o.y = pk2(sp[2 * 33], sp[3 * 33]); o.z = pk2(sp[4 * 33], sp[5 * 33]); o.w = pk2(sp[6 * 33], sp[7 * 33]);
            if constexpr (NTST) __builtin_nontemporal_store(o, (v4u*)(WT + (size_t)(n0 + n) * Kdst + koff + k0 + 8 * c)); else *(v4u*)(WT + (size_t)(n0 + n) * Kdst + koff + k0 + 8 * c) = o; }
        asm volatile("s_waitcnt lgkmcnt(0)" ::: "memory");
        it = itn; k0 = k0n; n0 = n0n;
#pragma unroll
        for (int i = 0; i < 8; ++i) v[i] = vn[i];
    }
#undef TM_LOAD
}

typedef GAS unsigned gu32;
#define RLX_AGENT __ATOMIC_RELAXED, __HIP_MEMORY_SCOPE_AGENT
#define XB_TMO      128
#define XB_XCNT(j)  (256  + 64 * (j))
#define XB_XSUB(j)  (1280 + 64 * (j))
#define XB_XGEN(j)  (2304 + 64 * (j))
#define XB_TOP      3328
#define XB_TOPGEN   3392
#define XCD_BAR_WORDS 3456
#define XB_SPIN_CAP (1u << 18)

__device__ __forceinline__ unsigned xb_ld(unsigned* p)              { return __hip_atomic_load(p, __ATOMIC_RELAXED, __HIP_MEMORY_SCOPE_AGENT); }
__device__ __forceinline__ unsigned xb_add(unsigned* p, unsigned v) { return __hip_atomic_fetch_add(p, v, __ATOMIC_RELAXED, __HIP_MEMORY_SCOPE_AGENT); }
__device__ __forceinline__ unsigned xb_xcc_id() { return (unsigned)__builtin_amdgcn_s_getreg((3 << 11) | 20) & 0xFu; }
#define XB_SPIN(cond, bar) do { unsigned _sp = 0; while (cond) { __builtin_amdgcn_s_sleep(1); \
    if ((++_sp & 255u) == 0u) { if (xb_ld(&(bar)[XB_TMO])) break; if (_sp > XB_SPIN_CAP) { atomicAdd(&(bar)[XB_TMO], 1u); break; } } } } while (0)

struct XcdBarrier {
    unsigned* bar; unsigned x;
    volatile LAS unsigned* st;
};

__device__ __forceinline__ XcdBarrier xcd_barrier_post(unsigned* bar, volatile LAS unsigned* st) {
    XcdBarrier b; b.bar = bar; b.x = xb_xcc_id(); b.st = st;
    if (threadIdx.x == 0) (void)xb_add(&bar[XB_XCNT(b.x)], 1u);
    return b;
}
__device__ __forceinline__ void xcd_barrier_complete(unsigned* bar, unsigned x, unsigned& nloc, unsigned& nx) {
    const unsigned G = gridDim.x * gridDim.y * gridDim.z;
    unsigned sum, cnt, mine, sp = 0u;
    for (;;) {
        sum = 0u; cnt = 0u; mine = 0u;
#pragma unroll
        for (unsigned j = 0; j < 16; ++j) { const unsigned c = xb_ld(&bar[XB_XCNT(j)]); sum += c; cnt += (c > 0u) ? 1u : 0u; mine = (j == x) ? c : mine; }
        if (sum == G) break;
        __builtin_amdgcn_s_sleep(1);
        if ((++sp & 255u) == 0u) { if (xb_ld(&bar[XB_TMO])) break; if (sp > XB_SPIN_CAP) { atomicAdd(&bar[XB_TMO], 1u); break; } }
    }
    nloc = mine > 0u ? mine : 1u; nx = cnt > 0u ? cnt : 1u;
}

__device__ __forceinline__ void xcd_barrier(const XcdBarrier& b) {
    asm volatile("s_waitcnt vmcnt(0)" ::: "memory");
    __syncthreads();
    if (threadIdx.x == 0) {
        unsigned* bar = b.bar;
        __builtin_amdgcn_s_waitcnt(0);
        unsigned nloc = b.st[0], nx = b.st[1];
        if (nloc == 0u) { xcd_barrier_complete(bar, b.x, nloc, nx); b.st[0] = nloc; b.st[1] = nx; }
        const unsigned old = xb_add(&bar[XB_XSUB(b.x)], 1u);
        const unsigned gen = old / nloc;
        if (old + 1u == (gen + 1u) * nloc) {
            __builtin_amdgcn_fence(__ATOMIC_RELEASE, "agent");
            asm volatile("s_waitcnt vmcnt(0)" ::: "memory");
            const unsigned og = xb_add(&bar[XB_TOP], 1u);
            const unsigned tg = og / nx;
            if (og + 1u == (tg + 1u) * nx) xb_add(&bar[XB_TOPGEN], 1u);
            else XB_SPIN(xb_ld(&bar[XB_TOPGEN]) == tg, bar);
            __builtin_amdgcn_fence(__ATOMIC_ACQUIRE, "agent");
            xb_add(&bar[XB_XGEN(b.x)], 1u);
            asm volatile("s_waitcnt vmcnt(0)" ::: "memory");
        } else {
            XB_SPIN(xb_ld(&bar[XB_XGEN(b.x)]) == gen, bar);
            __builtin_amdgcn_fence(__ATOMIC_ACQUIRE, "agent");
            asm volatile("s_waitcnt vmcnt(0)" ::: "memory");
        }
    }
    __syncthreads();
}
#ifndef PROBE_REPEAT
#define PROBE_REPEAT -1
#endif
#ifndef PROBE_FIRST
#define PROBE_FIRST 0
#endif
#define REPS(k) ((PROBE_REPEAT == (k)) ? 2 : 1)
struct Args { const float* in[16]; float* out; unsigned char* ws; unsigned long long flags; };
#define IDS() int tid_o = threadIdx.x; asm volatile("" : "+v"(tid_o)); const int tid = tid_o, lane = tid & 63, wave = __builtin_amdgcn_readfirstlane(tid >> 6); (void)lane; (void)wave
#define OPQ() int z_ = 0; asm volatile("" : "+s"(z_))
#define INP(k) (args.in[z_ + (k)])

__global__ void __launch_bounds__(NWAVES * 64, 2) fwd_mega(Args args) {
    extern __shared__ __attribute__((aligned(16))) unsigned char lds[];
    cg::grid_group grid = cg::this_grid();
    LAS unsigned char* lds3 = (LAS unsigned char*)lds;
    const int G = gridDim.x, bx = blockIdx.x;
    if (threadIdx.x < 2) ((volatile LAS unsigned*)(lds3 + BARST_OFF))[threadIdx.x] = 0u;
    __syncthreads();
    unsigned char* ws = args.ws;
    const XcdBarrier xbar = xcd_barrier_post((unsigned*)(ws + WS_BAR), (volatile LAS unsigned*)(lds3 + BARST_OFF));
    float* out = args.out;
    bf16* Win_t = (bf16*)(ws + WS_WIN); bf16* Wbrf_t = (bf16*)(ws + WS_WBRF); bf16* Wbrd_t = (bf16*)(ws + WS_WBRD); bf16* Wout_t = (bf16*)(ws + WS_WOUT);
    bf16* Wup_t = (bf16*)(ws + WS_WUP); bf16* Wdn_t = (bf16*)(ws + WS_WDN);
    bf16* XN = (bf16*)(ws + WS_XN); bf16* QKV = (bf16*)(ws + WS_QKV); bf16* GATES = (bf16*)(ws + WS_GATES);
    bf16* OA = (bf16*)(ws + WS_OA); bf16* OB = (bf16*)(ws + WS_OB); bf16* OP0 = (bf16*)(ws + WS_OP0); bf16* OP1 = (bf16*)(ws + WS_OP1); bf16* OP2 = (bf16*)(ws + WS_OP2);
    float* T = (float*)(ws + WS_T); bf16* MG = (bf16*)(ws + WS_MG); bf16* XB = (bf16*)(ws + WS_XB); bf16* ACT = (bf16*)(ws + WS_ACT); bf16* U = (bf16*)(ws + WS_U); float* US = (float*)(ws + WS_US); (void)U; (void)US;
    float* SSQ = (float*)(ws + WS_SSQ); float* CUM = (float*)(ws + WS_CUM); float* LOGF = (float*)(ws + WS_LOGF); float* LSE = (float*)(ws + WS_LSE);
    unsigned* ctl = (unsigned*)(ws + WS_CTL); float* GAIN = (float*)(ws + WS_GAIN); float* RSTD = (float*)(ws + WS_RSTD);

#if !defined(ONLY) || ONLY == 0
    _Pragma("unroll 1") for (int rep_ = 0; rep_ < REPS(0); ++rep_) {
        IDS();
        OPQ(); const float* x = INP(0); const float* g_attn = INP(1); const float* w_in = INP(2); const float* b_forget = INP(3); const float* gq_fox = INP(4); const float* gk_fox = INP(5); const float* gq_dil = INP(6); const float* gk_dil = INP(7);
        const float* w_br_fox = INP(8); const float* w_br_dil = INP(9); const float* w_out = INP(10); const float* g_ffn = INP(11); const float* w_up = INP(12); const float* w_down = INP(15);
        if (bx == 1) for (int i = tid; i < 1024; i += NWAVES * 64) { GAIN[i] = gq_fox[i]; GAIN[1024 + i] = gk_fox[i]; GAIN[2048 + i] = gq_dil[i]; GAIN[3072 + i] = gk_dil[i]; }
        LAS float* scr = (LAS float*)(lds3 + wave * 16384);
        const int gw = bx * NWAVES + wave, NGW = G * NWAVES;
        constexpr int I_IN = (DM / 64) * (NPROJ / 32), I_BR = (1024 / 64) * (DM / 32), I_OUT = (DM / 64) * (DM / 32), I_UP = (DM / 64) * (NUP / 32);
        transpose_matrix<1, false>(w_in, DM, INC, NPROJ, Win_t, DM, 0, nullptr, 0, gw, NGW, scr, lane);
        transpose_matrix<0, true>(w_br_fox, 1024, DM, DM, Wbrf_t, 2048, 0, nullptr, I_IN % NGW, gw, NGW, scr, lane);
        transpose_matrix<0, true>(w_br_dil, 1024, DM, DM, Wbrf_t, 2048, 1024, nullptr, (I_IN + I_BR) % NGW, gw, NGW, scr, lane);
        transpose_matrix<0, true>(w_out, DM, DM, DM, Wout_t, DM, 0, nullptr, (I_IN + 2 * I_BR) % NGW, gw, NGW, scr, lane);
        transpose_matrix<2, true>(w_up, DM, NUP, NUP, Wup_t, DM, 0, g_ffn, (I_IN + 2 * I_BR + I_OUT) % NGW, gw, NGW, scr, lane);
        transpose_matrix<0, true>(w_down, DFF, DM, DM, Wdn_t, DFF, 0, nullptr, (I_IN + 2 * I_BR + I_OUT + I_UP) % NGW, gw, NGW, scr, lane);
        __syncthreads();
        LAS float* wf = (LAS float*)lds3;
        {
            const float* wsrc = w_in + 3072 + (tid & 7);
#pragma unroll 1
            for (int b0 = 0; b0 < 32; b0 += 8) { float tv[8];
#pragma unroll
                for (int q = 0; q < 8; ++q) tv[q] = wsrc[(size_t)((tid + (b0 + q) * NWAVES * 64) >> 3) * INC];
#pragma unroll
                for (int q = 0; q < 8; ++q) wf[tid + (b0 + q) * NWAVES * 64] = tv[q]; }
        }
        __syncthreads();
        for (int m = gw; m < M; m += NGW) {
            const f32x4* xr = (const f32x4*)(x + (size_t)m * DM) + lane; const f32x4* gr = (const f32x4*)g_attn + lane;
            f32x4 v[8]; float s = 0.f;
#pragma unroll
            for (int j = 0; j < 8; ++j) { v[j] = __builtin_nontemporal_load(xr + 64 * j); s += (v[j][0] * v[j][0] + v[j][1] * v[j][1]) + (v[j][2] * v[j][2] + v[j][3] * v[j][3]); }
            const float rstd = 1.f / sqrtf(wave_sum(s) * (1.f / DM) + EPS);
            float fa[8] = {0.f, 0.f, 0.f, 0.f, 0.f, 0.f, 0.f, 0.f};
            unsigned long long* o8 = (unsigned long long*)(XN + (size_t)m * DM) + lane;
#pragma unroll
            for (int j = 0; j < 8; ++j) { const f32x4 h = v[j] * rstd * gr[64 * j];
                o8[64 * j] = (unsigned long long)pk2(h[0], h[1]) | ((unsigned long long)pk2(h[2], h[3]) << 32);
#pragma unroll
                for (int c = 0; c < 4; ++c) { const LAS f32x4* wp = (const LAS f32x4*)(wf + (size_t)(256 * j + 4 * lane + c) * 8); const f32x4 wa = wp[0], wb = wp[1];
                    fa[0] = fmaf(h[c], wa[0], fa[0]); fa[1] = fmaf(h[c], wa[1], fa[1]); fa[2] = fmaf(h[c], wa[2], fa[2]); fa[3] = fmaf(h[c], wa[3], fa[3]);
                    fa[4] = fmaf(h[c], wb[0], fa[4]); fa[5] = fmaf(h[c], wb[1], fa[5]); fa[6] = fmaf(h[c], wb[2], fa[6]); fa[7] = fmaf(h[c], wb[3], fa[7]); }
                asm volatile("" ::: "memory"); }
#pragma unroll
            for (int hh = 0; hh < 8; ++hh) fa[hh] = wave_sum(fa[hh]);
            if (lane < 8) { float z = fa[0];
#pragma unroll
                for (int hh = 1; hh < 8; ++hh) z = (lane == hh) ? fa[hh] : z;
                z += b_forget[lane];
                LOGF[(size_t)m * 8 + lane] = fminf(z, 0.f) - log1pf(expf(-fabsf(z))); }
        }
        __syncthreads();
    }
#endif
    if (args.flags & 1ull) grid.sync();
    xcd_barrier(xbar);

#if !defined(ONLY) || ONLY == 1
    _Pragma("unroll 1") for (int rep_ = 0; rep_ < REPS(1); ++rep_) {
        if (rep_ > 0) xcd_barrier(xbar);
        IDS();
        if (bx < NB * NH) { const int bb = bx >> 3, h = bx & 7; LAS float* wt = (LAS float*)lds3;
            float v[4]; float s = 0.f;
#pragma unroll
            for (int j = 0; j < 4; ++j) { v[j] = LOGF[((size_t)bb * SEQ + 4 * tid + j) * 8 + h]; s += v[j]; v[j] = s; }
            float inc = s;
#pragma unroll
            for (int o = 1; o < 64; o <<= 1) { const float t = __shfl_up(inc, o); if (lane >= o) inc += t; }
            if (lane == 63) wt[wave] = inc;
            __syncthreads();
            float off = inc - s;
            for (int w = 0; w < wave; ++w) off += wt[w];
#pragma unroll
            for (int j = 0; j < 4; ++j) CUM[(size_t)bx * SEQ + 4 * tid + j] = off + v[j];
            __syncthreads();
        }
        pg8::Gemm g{XN, Win_t, M, NPROJ, DM}; pg8::StaticOrder S; S.init(M, NPROJ, G, bx);
        pg8::EpiProj E{QKV, GATES, GAIN, (LAS float*)(lds3 + XL_OFF)};
        pg8::gemm_phase<pg8::EpiProj, pg8::StaticOrder, true, true>(lds3, g, S, E);
    }
#endif
    xcd_barrier(xbar);

#if !defined(ONLY) || ONLY == 2
    _Pragma("unroll 1") for (int rep_ = 0; rep_ < REPS(2); ++rep_) {
        if (rep_ > 0) xcd_barrier(xbar);
        IDS();
        const att::AttnArgs A{QKV, ws, (long)WS_OA, (long)WS_OP0, (long)WS_OP2 - (long)WS_OP0 - 32 * (long)MiB, LSE, CUM};
        att::attn_phase((char*)lds, A, ctl + 16 * rep_, rep_ ? PROBE_FIRST : 0);
    }
#endif
    xcd_barrier(xbar);

#if !defined(ONLY) || ONLY == 3
    _Pragma("unroll 1") for (int rep_ = 0; rep_ < REPS(3); ++rep_) {
        if (rep_ > 0) xcd_barrier(xbar);
        IDS();
        const int gt = bx * (NWAVES * 64) + tid, NT = G * NWAVES * 64;
        for (int i = gt; i < M * 128; i += NT) { const int m = i >> 7, c8 = (i & 127) * 8, h = c8 >> 7;
            const float l0 = LSE[(size_t)m * 8 + h], l1 = LSE[(size_t)(M + m) * 8 + h], l2 = LSE[(size_t)(2 * M + m) * 8 + h];
            const float mx = fmaxf(l0, fmaxf(l1, l2));
            float w0 = __builtin_amdgcn_exp2f(l0 - mx), w1 = __builtin_amdgcn_exp2f(l1 - mx), w2 = __builtin_amdgcn_exp2f(l2 - mx);
            const float inv = 1.f / (w0 + w1 + w2); w0 *= inv; w1 *= inv; w2 *= inv;
            const v4u a = __builtin_nontemporal_load((const v4u*)(OP0 + (size_t)m * 1024 + c8)), b = __builtin_nontemporal_load((const v4u*)(OP1 + (size_t)m * 1024 + c8)), c = __builtin_nontemporal_load((const v4u*)(OP2 + (size_t)m * 1024 + c8));
            v4u o;
#pragma unroll
            for (int k = 0; k < 4; ++k) { const float lo = w0 * pg8::bflo(a[k]) + w1 * pg8::bflo(b[k]) + w2 * pg8::bflo(c[k]), hi = w0 * pg8::bfhi(a[k]) + w1 * pg8::bfhi(b[k]) + w2 * pg8::bfhi(c[k]); o[k] = pk2(lo, hi); }
            *(v4u*)(OA + (size_t)m * 2048 + 1024 + c8) = o; }
    }
#endif
    xcd_barrier(xbar);

#if !defined(ONLY) || ONLY == 4
    _Pragma("unroll 1") for (int rep_ = 0; rep_ < REPS(4); ++rep_) {
        if (rep_ > 0) xcd_barrier(xbar);
        IDS();
        pg8::StaticOrder S; S.init(M, DM, G, bx);
        pg8::Gemm g{OA, Wbrf_t, M, DM, 2048}; pg8::EpiBr E{GATES, MG};
        pg8::gemm_phase<pg8::EpiBr, pg8::StaticOrder, true, true>(lds3, g, S, E);
    }
#endif
    xcd_barrier(xbar);

#if !defined(ONLY) || ONLY == 5
    _Pragma("unroll 1") for (int rep_ = 0; rep_ < REPS(5); ++rep_) {
        if (rep_ > 0) xcd_barrier(xbar);
        IDS();
        pg8::Gemm g{MG, Wout_t, M, DM, DM}; pg8::StaticOrder S; S.init(M, DM, G, bx);
        OPQ(); pg8::EpiOut E{INP(0), XB, SSQ};
        pg8::gemm_phase<pg8::EpiOut, pg8::StaticOrder, false, true>(lds3, g, S, E);
    }
#endif
    xcd_barrier(xbar);

#if !defined(ONLY) || ONLY == 6
    _Pragma("unroll 1") for (int rep_ = 0; rep_ < REPS(6); ++rep_) {
        if (rep_ > 0) xcd_barrier(xbar);
        IDS();
#pragma unroll 1
        for (int r0 = tid; r0 < M; r0 += 8 * NWAVES * 64) { f32x4 sa[8], sb[8];
#pragma unroll
            for (int q = 0; q < 8; ++q) { const size_t r = (size_t)(r0 + q * NWAVES * 64); sa[q] = *(const f32x4*)(SSQ + r * 8); sb[q] = *(const f32x4*)(SSQ + r * 8 + 4); }
#pragma unroll
            for (int q = 0; q < 8; ++q) RSTD[r0 + q * NWAVES * 64] = 1.f / sqrtf((((sa[q][0] + sa[q][1]) + (sa[q][2] + sa[q][3])) + ((sb[q][0] + sb[q][1]) + (sb[q][2] + sb[q][3]))) * (1.f / DM) + EPS); }
        asm volatile("s_waitcnt vmcnt(0)" ::: "memory"); __syncthreads();
        pg8::Gemm g{XB, Wup_t, M, NUP, DM}; pg8::StaticOrder S; S.init(M, NUP, G, bx);
#if FUSED_CONV
        OPQ(); pg8::EpiUpConv E{RSTD, INP(13), INP(14), ACT, US, (LAS float*)(lds3 + XL_OFF)};
        pg8::gemm_phase<pg8::EpiUpConv, pg8::StaticOrder, CONV_ALIGN, true>(lds3, g, S, E);
#else
        pg8::EpiUp E{RSTD, U};
        pg8::gemm_phase<pg8::EpiUp, pg8::StaticOrder, true, true>(lds3, g, S, E);
#endif
    }
#endif
    xcd_barrier(xbar);

#if (!defined(ONLY) || ONLY == 8) && !FUSED_CONV
    _Pragma("unroll 1") for (int rep_ = 0; rep_ < REPS(8); ++rep_) {
        if (rep_ > 0) xcd_barrier(xbar);
        IDS();
        OPQ(); const float* w_conv = INP(13); const float* b_conv = INP(14);
        const int gt = bx * (NWAVES * 64) + tid, NTH = G * NWAVES * 64;
        for (int it = gt; it < 704 * 512; it += NTH) { const int r = it / 704, k = it - r * 704, t0 = r * 16, pn = k >> 4, j8 = (k & 15) * 8;
            const unsigned ug = 256 * pn + j8, c = 8 * k;
            float wg[3][8], wv[3][8], bg[8], bv[8];
#pragma unroll
            for (int tp = 0; tp < 3; ++tp)
#pragma unroll
                for (int q = 0; q < 2; ++q) { const f32x4 a = *(const f32x4*)(w_conv + tp * NUP + c + 4 * q), b = *(const f32x4*)(w_conv + tp * NUP + DFF + c + 4 * q);
#pragma unroll
                    for (int j = 0; j < 4; ++j) { wg[tp][4 * q + j] = a[j]; wv[tp][4 * q + j] = b[j]; } }
#pragma unroll
            for (int q = 0; q < 2; ++q) { const f32x4 a = *(const f32x4*)(b_conv + c + 4 * q), b = *(const f32x4*)(b_conv + DFF + c + 4 * q);
#pragma unroll
                for (int j = 0; j < 4; ++j) { bg[4 * q + j] = a[j]; bv[4 * q + j] = b[j]; } }
            float g2[8], g1[8], v2[8], v1[8];
            if ((t0 & (SEQ - 1)) == 0) {
#pragma unroll
                for (int j = 0; j < 8; ++j) { g2[j] = 0.f; g1[j] = 0.f; v2[j] = 0.f; v1[j] = 0.f; }
            } else {
                const v4u a2 = *(const v4u*)(U + (size_t)(t0 - 2) * NUP + ug), b2 = *(const v4u*)(U + (size_t)(t0 - 2) * NUP + ug + 128);
                const v4u a1 = *(const v4u*)(U + (size_t)(t0 - 1) * NUP + ug), b1 = *(const v4u*)(U + (size_t)(t0 - 1) * NUP + ug + 128);
#pragma unroll
                for (int q = 0; q < 4; ++q) { g2[2 * q] = pg8::bflo(a2[q]); g2[2 * q + 1] = pg8::bfhi(a2[q]); v2[2 * q] = pg8::bflo(b2[q]); v2[2 * q + 1] = pg8::bfhi(b2[q]);
                    g1[2 * q] = pg8::bflo(a1[q]); g1[2 * q + 1] = pg8::bfhi(a1[q]); v1[2 * q] = pg8::bflo(b1[q]); v1[2 * q + 1] = pg8::bfhi(b1[q]); }
            }
            for (int i4 = 0; i4 < 16; i4 += 4) {
                v4u a0[4], b0[4];
#pragma unroll
                for (int i = 0; i < 4; ++i) { const size_t t = (size_t)(t0 + i4 + i);
                    a0[i] = __builtin_nontemporal_load((const v4u*)(U + t * NUP + ug)); b0[i] = __builtin_nontemporal_load((const v4u*)(U + t * NUP + ug + 128)); }
#pragma unroll
                for (int i = 0; i < 4; ++i) { const size_t t = (size_t)(t0 + i4 + i);
                    float g0[8], v0[8], o[8];
#pragma unroll
                    for (int q = 0; q < 4; ++q) { g0[2 * q] = pg8::bflo(a0[i][q]); g0[2 * q + 1] = pg8::bfhi(a0[i][q]); v0[2 * q] = pg8::bflo(b0[i][q]); v0[2 * q + 1] = pg8::bfhi(b0[i][q]); }
#pragma unroll
                    for (int j = 0; j < 8; ++j) { const float gt_ = fmaf(wg[0][j], g2[j], fmaf(wg[1][j], g1[j], fmaf(wg[2][j], g0[j], bg[j])));
                        const float vl = fmaf(wv[0][j], v2[j], fmaf(wv[1][j], v1[j], fmaf(wv[2][j], v0[j], bv[j])));
                        o[j] = gt_ * pg8::sigm(gt_) * vl; g2[j] = g1[j]; g1[j] = g0[j]; v2[j] = v1[j]; v1[j] = v0[j]; }
                    v4u w; w.x = pk2(o[0], o[1]); w.y = pk2(o[2], o[3]); w.z = pk2(o[4], o[5]); w.w = pk2(o[6], o[7]);
                    *(v4u*)(ACT + t * DFF + c) = w; } }
        }
    }
#endif
    #if !FUSED_CONV
    xcd_barrier(xbar);
#endif

#if !defined(ONLY) || ONLY == 7
    _Pragma("unroll 1") for (int rep_ = 0; rep_ < REPS(7); ++rep_) {
        if (rep_ > 0) xcd_barrier(xbar);
        IDS();
        pg8::StaticOrder S; S.init(M, DM, G, bx);
#if FUSED_CONV
        {
            OPQ(); const float* w_conv = INP(13); const float* b_conv = INP(14); pg8::Unit u0;
            if (S.next(0, u0)) {
                for (int i = tid; i < 4 * DFF; i += NWAVES * 64) { const int gq = i / DFF, c = i - gq * DFF, Gi = 4 * u0.pm + gq; const bool first = (Gi & 31) == 0;
                    const float* up = US + (size_t)Gi * 4 * NUP;
                    float cv[2][2];
#pragma unroll
                    for (int bj = 0; bj < 2; ++bj) { const int uc = bj * DFF + c; const float u0v = first ? 0.f : up[uc], u1v = first ? 0.f : up[NUP + uc], u2v = up[2 * NUP + uc], u3v = up[3 * NUP + uc];
                        const float w0 = w_conv[uc], w1 = w_conv[NUP + uc], w2 = w_conv[2 * NUP + uc], bb = b_conv[uc];
                        cv[bj][0] = fmaf(w0, u0v, fmaf(w1, u1v, fmaf(w2, u2v, bb))); cv[bj][1] = fmaf(w0, u1v, fmaf(w1, u2v, fmaf(w2, u3v, bb))); }
#pragma unroll
                    for (int t = 0; t < 2; ++t) { const float gte = cv[0][t]; ACT[(size_t)(64 * Gi + t) * DFF + c] = (bf16)f2bf(gte * pg8::sigm(gte) * cv[1][t]); } }
            }
            asm volatile("s_waitcnt vmcnt(0)" ::: "memory"); __threadfence(); __syncthreads();
        }
#endif
        pg8::Gemm g{ACT, Wdn_t, M, DM, DFF};
        pg8::EpiFinal E{XB, out};
        pg8::gemm_phase<pg8::EpiFinal, pg8::StaticOrder, true, true>(lds3, g, S, E);
    }
#endif
}

extern "C" void kernel_launch(void* const* d_in, const int* in_sizes, int n_in, void* d_out, int out_size, void* d_ws, size_t ws_size, hipStream_t stream) {
    static int grid = 0;
    if (grid == 0) {
        if (n_in != 16 || in_sizes[0] != M * DM || out_size != M * DM || ws_size < WS_END) { fprintf(stderr, "kernel_launch: unexpected shapes (n_in %d, in0 %d, out %d, ws %zu)\n", n_in, n_in > 0 ? in_sizes[0] : -1, out_size, ws_size); grid = -1; return; }
        int dev = 0, cus = 0, per_cu = 0;
        (void)hipGetDevice(&dev); (void)hipDeviceGetAttribute(&cus, hipDeviceAttributeMultiprocessorCount, dev);
        if (hipFuncSetAttribute((const void*)fwd_mega, hipFuncAttributeMaxDynamicSharedMemorySize, LDS_BYTES) != hipSuccess) { fprintf(stderr, "kernel_launch: hipFuncSetAttribute failed\n"); grid = -1; return; }
        if (hipOccupancyMaxActiveBlocksPerMultiprocessor(&per_cu, (const void*)fwd_mega, NWAVES * 64, LDS_BYTES) != hipSuccess || per_cu < 1) { fprintf(stderr, "kernel_launch: occupancy query says %d\n", per_cu); per_cu = 1; }
        (void)hipGetLastError();
        grid = cus * 1;
        if (grid != 256) fprintf(stderr, "kernel_launch: %d CUs; the single-unit GEMM phases assume 256\n", grid);
    }
    if (grid < 0) return;
    if (hipMemsetAsync(d_ws, 0, 128 * 1024, stream) != hipSuccess) { fprintf(stderr, "kernel_launch: hipMemsetAsync failed\n"); return; }
    Args a{};
    for (int i = 0; i < 16; ++i) a.in[i] = (const float*)d_in[i];
    a.out = (float*)d_out; a.ws = (unsigned char*)d_ws;
    void* kargs[] = {&a};
    hipError_t e = hipLaunchCooperativeKernel((const void*)fwd_mega, dim3(grid), dim3(NWAVES * 64), kargs, LDS_BYTES, stream);
    if (e != hipSuccess) fprintf(stderr, "cooperative launch failed: %s (grid %d)\n", hipGetErrorString(e), grid);
}
```

```cpp
#include <hip/hip_runtime.h>
#include <hip/hip_cooperative_groups.h>
#include <cstdio>
#include <cstdint>
namespace cg = cooperative_groups;
namespace pg8 {
#define PG8_LAS __attribute__((address_space(3)))
typedef unsigned short bf16_t;
typedef short bf16x8 __attribute__((ext_vector_type(8)));
typedef float f32x4 __attribute__((ext_vector_type(4)));
typedef unsigned u32x4 __attribute__((ext_vector_type(4)));
constexpr int BM = 256, BK = 64, HALF = 128, HTB = HALF * BK * 2  , STAGE_BYTES = 8 * HTB, NXCD = 8, WGM = 4;

__host__ __device__ __forceinline__ int lds_byte(int r, int c) { const int st = (r >> 4) * 2 + (c >> 5), rr = r & 15, cc = c & 31, ob = rr * 64 + cc * 2; return st * 1024 + (ob ^ (((ob >> 9) & 1) << 5)); }
__host__ __device__ __forceinline__ void stage_rc(int b, int& R, int& C) { const int st = b / 1024, sb = b % 1024, swz = sb ^ (((sb >> 9) & 1) << 5); R = (st >> 1) * 16 + swz / 64; C = (st & 1) * 32 + (swz % 64) / 2; }
__host__ __device__ __forceinline__ int perm32(int rho) { const int n = rho >> 4, i = rho & 15; return 8 * (i >> 2) + 4 * n + (i & 3); }

struct Unit { int pm, pn; };
struct Gemm { const bf16_t* A; const bf16_t* Bt; int M, N, K; };

struct StaticOrder {
    int nM, nN, nwg, G, c;
    __host__ __device__ void init(int M, int N, int G_, int c_) { nM = M / BM; nN = N / BM; nwg = nM * nN; G = G_; c = c_; }
    __host__ __device__ bool next(int i, Unit& u) const {
        const long L = (long)i * G + c; if (L >= nwg) return false;
        int wgid = (int)L; { const int q = nwg / NXCD, r = nwg % NXCD, xcd = wgid % NXCD, off = wgid / NXCD; wgid = (xcd < r ? xcd * (q + 1) : r * (q + 1) + (xcd - r) * q) + off; }
        const int nig = WGM * nN, gid = wgid / nig, fm = gid * WGM, gsz = (nM - fm) < WGM ? (nM - fm) : WGM;
        u.pm = fm + ((wgid % nig) % gsz); u.pn = (wgid % nig) / gsz; return true;
    }
    __device__ __forceinline__ void a_ready(const Unit&) const {}
    __device__ __forceinline__ void done(const Unit&) const {}
};

__device__ __forceinline__ unsigned cvt_pk_bf16(float lo, float hi) { unsigned r; asm volatile("v_cvt_pk_bf16_f32 %0, %1, %2" : "=v"(r) : "v"(lo), "v"(hi)); return r; }
typedef unsigned u32x4e __attribute__((ext_vector_type(4)));
constexpr float LOG2E = 1.4426950408889634f;
constexpr float EPSN = 1e-6f;
constexpr float QSCALE = 0.08838834764831845f * 1.4426950408889634f;
__device__ __forceinline__ float sigm(float x) { return __builtin_amdgcn_rcpf(1.f + __builtin_amdgcn_exp2f(-x * LOG2E)); }
__device__ __forceinline__ float bflo(unsigned w) { return __uint_as_float(w << 16); }
__device__ __forceinline__ float bfhi(unsigned w) { return __uint_as_float(w & 0xffff0000u); }
__device__ __forceinline__ u32x4e pack8f(const f32x4 a, const f32x4 b) { u32x4e w; w.x = cvt_pk_bf16(a[0], a[1]); w.y = cvt_pk_bf16(a[2], a[3]); w.z = cvt_pk_bf16(b[0], b[1]); w.w = cvt_pk_bf16(b[2], b[3]); return w; }
#define EPI_LDSBAR() do { asm volatile("s_waitcnt lgkmcnt(0)" ::: "memory"); __builtin_amdgcn_s_barrier(); asm volatile("" ::: "memory"); } while (0)

struct EpiProj {
    static constexpr bool PERM = true, AFTER_DRAIN = false, HAS_MID = false;
    bf16_t* QKV; bf16_t* GATES; const float* gains; PG8_LAS float* xl;
    __device__ __forceinline__ void operator()(f32x4 (&acc)[2][2][4][2], const Unit& u, int wr, int wc, int fr, int fq) const {
        const int colt = u.pn * BM, row0 = u.pm * BM + wr * 64 + fr, seg = colt >> 10;
        const bool norm = (seg == 0) | (seg == 1) | (seg == 3) | (seg == 4);
        if (!norm) {
            bf16_t* base; int ldc, col0;
            if (colt >= 6144) { base = GATES; ldc = 4096; col0 = colt - 6144; } else { base = QKV; ldc = 6144; col0 = colt; }
            col0 += wc * 32 + 8 * fq;
#pragma unroll
            for (int ai = 0; ai < 2; ++ai)
#pragma unroll
                for (int m = 0; m < 4; ++m) { bf16_t* rowp = base + (size_t)(row0 + ai * HALF + m * 16) * ldc + col0;
#pragma unroll
                    for (int bj = 0; bj < 2; ++bj) *(u32x4e*)(rowp + bj * HALF) = pack8f(acc[ai][bj][m][0], acc[ai][bj][m][1]); }
        } else {
#pragma unroll
            for (int ai = 0; ai < 2; ++ai)
#pragma unroll
                for (int m = 0; m < 4; ++m)
#pragma unroll
                    for (int bj = 0; bj < 2; ++bj) { const f32x4 a = acc[ai][bj][m][0], b = acc[ai][bj][m][1];
                        float s = (a[0] * a[0] + a[1] * a[1]) + (a[2] * a[2] + a[3] * a[3]) + (b[0] * b[0] + b[1] * b[1]) + (b[2] * b[2] + b[3] * b[3]);
                        s += __shfl_xor(s, 16); s += __shfl_xor(s, 32);
                        if (fq == 0) xl[((ai * HALF + wr * 64 + m * 16 + fr) * 2 + bj) * 4 + wc] = s; }
            EPI_LDSBAR();
            const float* gp = gains + (seg - (seg >= 3 ? 1 : 0)) * 1024 + (colt & 1023) + wc * 32 + 8 * fq;
            const float qs = (seg == 0 || seg == 3) ? QSCALE : 1.f;
            f32x4 g[2][2];
#pragma unroll
            for (int bj = 0; bj < 2; ++bj)
#pragma unroll
                for (int n = 0; n < 2; ++n) g[bj][n] = *(const f32x4*)(gp + bj * HALF + 4 * n) * qs;
            bf16_t* base = QKV + colt + wc * 32 + 8 * fq;
#pragma unroll
            for (int ai = 0; ai < 2; ++ai)
#pragma unroll
                for (int m = 0; m < 4; ++m) { bf16_t* rowp = base + (size_t)(row0 + ai * HALF + m * 16) * 6144;
#pragma unroll
                    for (int bj = 0; bj < 2; ++bj) { const f32x4 p = *(const PG8_LAS f32x4*)(xl + ((ai * HALF + wr * 64 + m * 16 + fr) * 2 + bj) * 4);
                        const float rs = __builtin_amdgcn_rsqf(((p[0] + p[1]) + (p[2] + p[3])) * (1.f / 128.f) + EPSN);
                        *(u32x4e*)(rowp + bj * HALF) = pack8f(acc[ai][bj][m][0] * rs * g[bj][0], acc[ai][bj][m][1] * rs * g[bj][1]); } }
        }
    }
};

__device__ __forceinline__ void gate8(const bf16_t* p, f32x4& s0, f32x4& s1) {
    const u32x4e w = *(const u32x4e*)p;
    s0[0] = sigm(bflo(w.x)); s0[1] = sigm(bfhi(w.x)); s0[2] = sigm(bflo(w.y)); s0[3] = sigm(bfhi(w.y));
    s1[0] = sigm(bflo(w.z)); s1[1] = sigm(bfhi(w.z)); s1[2] = sigm(bflo(w.w)); s1[3] = sigm(bfhi(w.w));
}
struct EpiBr {
    static constexpr bool PERM = true, AFTER_DRAIN = false, HAS_MID = true;
    const bf16_t* G; bf16_t* MG;
    __device__ __forceinline__ void mid(f32x4 (&acc)[2][2][4][2], const Unit& u, int wr, int wc, int fr_in, int fq_in) const {
        (void)fr_in; (void)fq_in; int ln_ = (int)(threadIdx.x & 63u); asm volatile("" : "+v"(ln_)); const int fr = ln_ & 15, fq = ln_ >> 4;
        const int row0 = u.pm * BM + wr * 64 + fr, col0 = u.pn * BM + wc * 32 + 8 * fq;
#define RAT(x, y) ((1.f + __builtin_amdgcn_exp2f(-(y) * LOG2E)) * __builtin_amdgcn_rcpf(1.f + __builtin_amdgcn_exp2f(-(x) * LOG2E)))
#pragma unroll
        for (int ai = 0; ai < 2; ++ai) {
            u32x4e ga[4][2], gb[4][2];
#pragma unroll
            for (int m = 0; m < 4; ++m)
#pragma unroll
                for (int bj = 0; bj < 2; ++bj) { const bf16_t* gp = G + (size_t)(row0 + ai * HALF + m * 16) * 4096 + col0 + bj * HALF; ga[m][bj] = *(const u32x4e*)gp; gb[m][bj] = *(const u32x4e*)(gp + 2048); }
#pragma unroll
            for (int m = 0; m < 4; ++m)
#pragma unroll
                for (int bj = 0; bj < 2; ++bj) { const u32x4e a = ga[m][bj], b = gb[m][bj]; f32x4 r0, r1;
                    r0[0] = RAT(bflo(a.x), bflo(b.x)); r0[1] = RAT(bfhi(a.x), bfhi(b.x)); r0[2] = RAT(bflo(a.y), bflo(b.y)); r0[3] = RAT(bfhi(a.y), bfhi(b.y));
                    r1[0] = RAT(bflo(a.z), bflo(b.z)); r1[1] = RAT(bfhi(a.z), bfhi(b.z)); r1[2] = RAT(bflo(a.w), bflo(b.w)); r1[3] = RAT(bfhi(a.w), bfhi(b.w));
                    acc[ai][bj][m][0] = acc[ai][bj][m][0] * r0; acc[ai][bj][m][1] = acc[ai][bj][m][1] * r1; }
            asm volatile("" ::: "memory"); __builtin_amdgcn_sched_barrier(0); }
#undef RAT
    }
    __device__ __forceinline__ void operator()(f32x4 (&acc)[2][2][4][2], const Unit& u, int wr, int wc, int fr, int fq) const {
        const int row0 = u.pm * BM + wr * 64 + fr, col0 = u.pn * BM + wc * 32 + 8 * fq;
#pragma unroll
        for (int ai = 0; ai < 2; ++ai)
#pragma unroll
            for (int m = 0; m < 4; ++m) { const size_t row = (size_t)(row0 + ai * HALF + m * 16);
#pragma unroll
                for (int bj = 0; bj < 2; ++bj) { const int col = col0 + bj * HALF; f32x4 s0, s1; gate8(G + row * 4096 + 2048 + col, s0, s1);
                    *(u32x4e*)(MG + row * 2048 + col) = pack8f(acc[ai][bj][m][0] * s0, acc[ai][bj][m][1] * s1); } }
    }
};
struct EpiOut {
    static constexpr bool PERM = true, AFTER_DRAIN = true, HAS_MID = false;
    const float* X; bf16_t* XB; float* SSQ;
    __device__ __forceinline__ void fused(f32x4 (&acc)[2][2][4][2], const Unit& u, int wr, int wc, int fr, int fq, PG8_LAS unsigned char* lds, int wid, int lane) const {
        PG8_LAS float* P = (PG8_LAS float*)lds;
        const int row0 = u.pm * BM + wr * 64 + fr, col0 = u.pn * BM + wc * 32 + 8 * fq;
#pragma unroll
        for (int ai = 0; ai < 2; ++ai)
#pragma unroll
            for (int m = 0; m < 4; ++m) { const size_t row = (size_t)(row0 + ai * HALF + m * 16); float ss = 0.f;
#pragma unroll
                for (int bj = 0; bj < 2; ++bj) { const size_t off = row * 2048 + col0 + bj * HALF;
                    const f32x4 v0 = acc[ai][bj][m][0] + __builtin_nontemporal_load((const f32x4*)(X + off)), v1 = acc[ai][bj][m][1] + __builtin_nontemporal_load((const f32x4*)(X + off + 4));
                    *(u32x4e*)(XB + off) = pack8f(v0, v1);
                    ss += (v0[0] * v0[0] + v0[1] * v0[1]) + (v0[2] * v0[2] + v0[3] * v0[3]) + (v1[0] * v1[0] + v1[1] * v1[1]) + (v1[2] * v1[2] + v1[3] * v1[3]); }
                ss += __shfl_xor(ss, 16); ss += __shfl_xor(ss, 32);
                if (fq == 0) P[(ai * HALF + wr * 64 + m * 16 + fr) * 4 + wc] = ss; }
        EPI_LDSBAR();
        const int tid = wid * 64 + lane;
        if (tid < 256) { const f32x4 p = *(const PG8_LAS f32x4*)(P + tid * 4); SSQ[(size_t)(u.pm * BM + tid) * 8 + u.pn] = (p[0] + p[1]) + (p[2] + p[3]); }
    }
};
#ifndef CONV_LDSW
#define CONV_LDSW 0
#endif
__device__ __forceinline__ float ror1f(float v) { return __builtin_bit_cast(float, __builtin_amdgcn_update_dpp(0, __builtin_bit_cast(int, v), 0x121, 0xf, 0xf, false)); }
__device__ __forceinline__ float ror2f(float v) { return __builtin_bit_cast(float, __builtin_amdgcn_update_dpp(0, __builtin_bit_cast(int, v), 0x122, 0xf, 0xf, false)); }
struct EpiUpConv {
    static constexpr bool PERM = true, AFTER_DRAIN = false, HAS_MID = false;
    const float* RSTD; const float* wconv; const float* bconv; bf16_t* ACT; float* US; PG8_LAS float* xl;
    __device__ __forceinline__ void operator()(f32x4 (&acc)[2][2][4][2], const Unit& u, int wr, int wc, int fr_in, int fq_in) const {
        typedef unsigned u32x2e __attribute__((ext_vector_type(2)));
        PG8_LAS float* wl = xl + (unsigned)(wr * 4 + wc) * 256u;
        { const unsigned L_ = threadIdx.x & 63u, ucol_ = (L_ >> 5) * 5632u + (unsigned)u.pn * 128u + (unsigned)wc * 32u + (L_ & 31u);
          const float t0_ = wconv[ucol_], t1_ = wconv[11264u + ucol_], t2_ = wconv[22528u + ucol_], t3_ = bconv[ucol_];
          wl[L_] = t0_; wl[64u + L_] = t1_; wl[128u + L_] = t2_; wl[192u + L_] = t3_;
          asm volatile("s_waitcnt lgkmcnt(0)" ::: "memory"); }
        (void)fr_in; (void)fq_in; int ln_ = (int)(threadIdx.x & 63u); asm volatile("" : "+v"(ln_)); const int fr = ln_ & 15, fq = ln_ >> 4;
        const unsigned cw = (unsigned)(u.pn * 128 + wc * 32 + 8 * fq), row0 = (unsigned)(u.pm * BM + wr * 64 + fr);
        const bool lo = fr < 2, hi14 = fr >= 14, f1 = fr >= 1, f2 = fr >= 2;
#pragma unroll
        for (int ai = 0; ai < 2; ++ai) { const unsigned G = (unsigned)(4 * u.pm + 2 * ai + wr);
            float rs[4];
#pragma unroll
            for (int m = 0; m < 4; ++m) rs[m] = RSTD[row0 + ai * HALF + m * 16];
            const unsigned aoff = (row0 + ai * HALF) * 5632u + cw;
            const unsigned us_lo = (G * 4 + 2 + (fr & 1)) * 11264u; const bool sthi = hi14 && (G + 1 < 128);
#pragma unroll
            for (int n = 0; n < 2; ++n) {
#pragma unroll
                for (int j = 0; j < 4; ++j) { unsigned col = cw + 4 * n + j; asm volatile("" : "+v"(col));
#pragma unroll
                    for (int bj = 0; bj < 2; ++bj) { const unsigned ucol = bj * 5632 + col;
                        const unsigned lc = (unsigned)bj * 32u + (col - (unsigned)u.pn * 128u - (unsigned)wc * 32u);
                        const float w0 = wl[lc], w1 = wl[64u + lc], w2 = wl[128u + lc], bb = wl[192u + lc];
                        float pa1 = 0.f, pa2 = 0.f;
#pragma unroll
                        for (int m = 0; m < 4; ++m) { const float uu = acc[ai][bj][m][n][j] * rs[m];
                            if (m == 0) { if (lo) US[us_lo + ucol] = uu; }
                            if (m == 3) { if (sthi) US[us_lo + 22528u + ucol] = uu; }
                            const float a1 = ror1f(uu), a2 = ror2f(uu);
                            const float p1 = f1 ? a1 : pa1, p2 = f2 ? a2 : pa2;
                            acc[ai][bj][m][n][j] = fmaf(w0, p2, fmaf(w1, p1, fmaf(w2, uu, bb)));
                            pa1 = a1; pa2 = a2; }
                        }
#pragma unroll
                    for (int m = 0; m < 4; ++m) { const float g0 = acc[ai][0][m][n][j]; acc[ai][0][m][n][j] = g0 * sigm(g0) * acc[ai][1][m][n][j]; }
                    asm volatile("" ::: "memory"); }
#pragma unroll
                for (int m = 0; m < 4; ++m) { u32x2e w; w.x = cvt_pk_bf16(acc[ai][0][m][n][0], acc[ai][0][m][n][1]); w.y = cvt_pk_bf16(acc[ai][0][m][n][2], acc[ai][0][m][n][3]);
                    if (!(m == 0 && lo)) *(u32x2e*)(ACT + (aoff + (unsigned)(m * 16 * 5632 + 4 * n))) = w; }
                asm volatile("" ::: "memory"); __builtin_amdgcn_sched_barrier(0); } }
    }
};
struct EpiUp {
    static constexpr bool PERM = true, AFTER_DRAIN = false, HAS_MID = false;
    const float* RSTD; bf16_t* U;
    __device__ __forceinline__ void operator()(f32x4 (&acc)[2][2][4][2], const Unit& u, int wr, int wc, int fr, int fq) const {
        const int row0 = u.pm * BM + wr * 64 + fr, col0 = u.pn * BM + wc * 32 + 8 * fq;
#pragma unroll
        for (int ai = 0; ai < 2; ++ai)
#pragma unroll
            for (int m = 0; m < 4; ++m) { const int row = row0 + ai * HALF + m * 16; const float rs = RSTD[row]; bf16_t* rowp = U + (size_t)row * 11264 + col0;
#pragma unroll
                for (int bj = 0; bj < 2; ++bj) *(u32x4e*)(rowp + bj * HALF) = pack8f(acc[ai][bj][m][0] * rs, acc[ai][bj][m][1] * rs); }
    }
};
struct EpiFinal {
    static constexpr bool PERM = true, AFTER_DRAIN = false, HAS_MID = false;
    const bf16_t* XB; float* OUT;
    __device__ __forceinline__ void operator()(f32x4 (&acc)[2][2][4][2], const Unit& u, int wr, int wc, int fr, int fq) const {
        const int row0 = u.pm * BM + wr * 64 + fr, col0 = u.pn * BM + wc * 32 + 8 * fq;
#pragma unroll
        for (int ai = 0; ai < 2; ++ai)
#pragma unroll
            for (int m = 0; m < 4; ++m)
#pragma unroll
                for (int bj = 0; bj < 2; ++bj) { const size_t off = (size_t)(row0 + ai * HALF + m * 16) * 2048 + col0 + bj * HALF;
                    const u32x4e w = __builtin_nontemporal_load((const u32x4e*)(XB + off));
                    const f32x4 a = {bflo(w.x), bfhi(w.x), bflo(w.y), bfhi(w.y)}, b = {bflo(w.z), bfhi(w.z), bflo(w.w), bfhi(w.w)};
                    __builtin_nontemporal_store(a + acc[ai][bj][m][0], (f32x4*)(OUT + off)); __builtin_nontemporal_store(b + acc[ai][bj][m][1], (f32x4*)(OUT + off + 4)); }
    }
};

template <class Epi, class Sched, bool ALIGN_EPI = false, bool SP2 = false>
__device__ __forceinline__ void gemm_phase(PG8_LAS unsigned char* lds, const Gemm g, const Sched& S, const Epi& E) {
    int tid_o = threadIdx.x; asm volatile("" : "+v"(tid_o));
    const int tid = tid_o, wid = __builtin_amdgcn_readfirstlane(tid >> 6), lane = tid & 63, wr = wid >> 2, wc = wid & 3, fr = lane & 15, fq = lane >> 4;
    const int K = g.K, nt = K / BK;
    unsigned voffA[1], voffB[1];
#pragma unroll
    for (int i = 0; i < 1; ++i) { int R, C; stage_rc(tid * 16 + i * 8192, R, C); const int Rb = Epi::PERM ? ((R & ~31) + perm32(R & 31)) : R;
        voffA[i] = (unsigned)(R * K + C) * 2u; voffB[i] = (unsigned)(Rb * K + C) * 2u; }
    const size_t vstep = (size_t)K * 128;
    const size_t kstep = (size_t)(BK * 2);
    const size_t hstep = (size_t)HALF * K * 2;
    const size_t tstep = 2 * hstep;
    const unsigned ldsw = (unsigned)wid * 1024u;
    const int aoff = lds_byte(wr * 64 + fr, fq * 8), boff = lds_byte(wc * 32 + fr, fq * 8);
#define PG8_SA(b, h) (((b) * 2 + (h)) * HTB)
#define PG8_SB(b, h) ((4 + (b) * 2 + (h)) * HTB)
#define PG8_STAGE(bufoff, gbase, voff) do { _Pragma("unroll") for (int _i = 0; _i < 2; ++_i) \
        __builtin_amdgcn_global_load_lds((const unsigned*)((const char*)(gbase) + (size_t)_i * vstep + (voff)[0]), (PG8_LAS unsigned*)(lds + (bufoff) + ldsw + _i * 8192), 16, 0, 0); } while (0)
#define PG8_LDA(dst, b, h) do { _Pragma("unroll") for (int m = 0; m < 4; ++m) _Pragma("unroll") for (int k = 0; k < 2; ++k) dst[m][k] = *(const PG8_LAS bf16x8*)(lds + PG8_SA(b, h) + aoff + m * 2048 + k * 1024); } while (0)
#define PG8_LDB(dst, b, h) do { _Pragma("unroll") for (int n = 0; n < 2; ++n) _Pragma("unroll") for (int k = 0; k < 2; ++k) dst[n][k] = *(const PG8_LAS bf16x8*)(lds + PG8_SB(b, h) + boff + n * 2048 + k * 1024); } while (0)
#define PG8_MMA(ai, bj, At, Bt) do { __builtin_amdgcn_s_setprio(1); _Pragma("unroll") for (int m = 0; m < 4; ++m) _Pragma("unroll") for (int n = 0; n < 2; ++n) _Pragma("unroll") for (int k = 0; k < 2; ++k) \
        acc[ai][bj][m][n] = __builtin_amdgcn_mfma_f32_16x16x32_bf16(Bt[n][k], At[m][k], acc[ai][bj][m][n], 0, 0, 0); __builtin_amdgcn_s_setprio(0); } while (0)
#define PG8_WAIT_V(n) asm volatile("s_waitcnt vmcnt(" #n ")" ::: "memory")
#define PG8_WAIT_L(n) asm volatile("s_waitcnt lgkmcnt(" #n ")" ::: "memory")
#define PG8_BAR __builtin_amdgcn_s_barrier()
#define PG8_SCHED __builtin_amdgcn_sched_barrier(0)
    Unit cur, nxt; int ui = 0;
    if (!S.next(0, cur)) return;
    f32x4 acc[2][2][4][2];
#pragma unroll
    for (int a = 0; a < 2; ++a)
#pragma unroll
        for (int b = 0; b < 2; ++b)
#pragma unroll
            for (int m = 0; m < 4; ++m)
#pragma unroll
                for (int n = 0; n < 2; ++n) acc[a][b][m][n] = (f32x4){0.f, 0.f, 0.f, 0.f};
    bf16x8 At[4][2], B0[2][2], B1[2][2];
    const char* cA = (const char*)g.A + (size_t)cur.pm * tstep; const char* cB = (const char*)g.Bt + (size_t)cur.pn * tstep;
    S.a_ready(cur);
    if constexpr (SP2) {
        PG8_STAGE(PG8_SB(0, 0), cB, voffB); PG8_STAGE(PG8_SB(0, 1), cB + hstep, voffB); PG8_STAGE(PG8_SA(0, 0), cA, voffA); PG8_STAGE(PG8_SA(0, 1), cA + hstep, voffA);
        if (wr == 1) PG8_BAR;
        PG8_WAIT_V(2); PG8_BAR;
        PG8_STAGE(PG8_SB(1, 0), cB + kstep, voffB); PG8_STAGE(PG8_SA(1, 0), cA + kstep, voffA); PG8_STAGE(PG8_SB(1, 1), cB + hstep + kstep, voffB);
        PG8_WAIT_V(6); PG8_BAR;
    } else {
        PG8_STAGE(PG8_SB(0, 0), cB, voffB); PG8_STAGE(PG8_SA(0, 0), cA, voffA); PG8_STAGE(PG8_SB(0, 1), cB + hstep, voffB); PG8_STAGE(PG8_SA(0, 1), cA + hstep, voffA);
        if (wr == 1) PG8_BAR;
        PG8_WAIT_V(4); PG8_BAR;
        PG8_STAGE(PG8_SB(1, 0), cB + kstep, voffB); PG8_STAGE(PG8_SA(1, 0), cA + kstep, voffA); PG8_STAGE(PG8_SB(1, 1), cB + hstep + kstep, voffB);
        PG8_WAIT_V(6); PG8_BAR;
    }
    for (;;) {
        const bool has_next = S.next(ui + 1, nxt);
        const char* nA = has_next ? (const char*)g.A + (size_t)nxt.pm * tstep : cA; const char* nB = has_next ? (const char*)g.Bt + (size_t)nxt.pn * tstep : cB;
        for (int t = 0; t < nt; t += 2) {
            if constexpr (Epi::HAS_MID) { if (t == (nt >> 1)) E.mid(acc, cur, wr, wc, fr, fq); }
            const bool last = (t == nt - 2);
            const char* a1 = cA + (size_t)(t + 1) * kstep;
            const char* a2 = last ? nA : cA + (size_t)(t + 2) * kstep; const char* b2 = last ? nB : cB + (size_t)(t + 2) * kstep;
            const char* a3 = a2 + kstep; const char* b3 = b2 + kstep;
            if (last && has_next) S.a_ready(nxt);
            if constexpr (SP2) {
            PG8_LDB(B0, 0, 0); PG8_LDB(B1, 0, 1); PG8_SCHED; PG8_LDA(At, 0, 0); PG8_STAGE(PG8_SA(1, 1), a1 + hstep, voffA);
            PG8_WAIT_V(8); PG8_WAIT_L(0); PG8_BAR; PG8_MMA(0, 0, At, B0); PG8_MMA(0, 1, At, B1); PG8_BAR; PG8_SCHED;
            PG8_LDA(At, 0, 1); PG8_STAGE(PG8_SB(0, 0), b2, voffB); PG8_STAGE(PG8_SB(0, 1), b2 + hstep, voffB); PG8_STAGE(PG8_SA(0, 0), a2, voffA);
            PG8_WAIT_V(8); PG8_WAIT_L(0); PG8_BAR; PG8_MMA(1, 0, At, B0); PG8_MMA(1, 1, At, B1); PG8_BAR; PG8_SCHED;
            PG8_LDB(B0, 1, 0); PG8_LDB(B1, 1, 1); PG8_SCHED; PG8_LDA(At, 1, 0); PG8_STAGE(PG8_SA(0, 1), a2 + hstep, voffA);
            PG8_WAIT_V(8); PG8_WAIT_L(0); PG8_BAR; PG8_MMA(0, 0, At, B0); PG8_MMA(0, 1, At, B1); PG8_BAR; PG8_SCHED;
            PG8_LDA(At, 1, 1); PG8_STAGE(PG8_SB(1, 0), b3, voffB); PG8_STAGE(PG8_SB(1, 1), b3 + hstep, voffB); PG8_STAGE(PG8_SA(1, 0), a3, voffA);
            PG8_WAIT_V(8); PG8_WAIT_L(0); PG8_BAR; PG8_MMA(1, 0, At, B0); PG8_MMA(1, 1, At, B1); PG8_BAR; PG8_SCHED;
            } else {
            PG8_LDB(B0, 0, 0); PG8_SCHED; PG8_LDA(At, 0, 0); PG8_STAGE(PG8_SA(1, 1), a1 + hstep, voffA);
            PG8_WAIT_L(8); PG8_BAR; PG8_WAIT_L(0); PG8_MMA(0, 0, At, B0); PG8_BAR; PG8_SCHED;
            PG8_LDB(B1, 0, 1); PG8_STAGE(PG8_SB(0, 0), b2, voffB);
            PG8_BAR; PG8_WAIT_L(0); PG8_MMA(0, 1, At, B1); PG8_BAR;
            PG8_LDA(At, 0, 1); PG8_STAGE(PG8_SA(0, 0), a2, voffA);
            PG8_BAR; PG8_WAIT_L(0); PG8_MMA(1, 0, At, B0); PG8_BAR; PG8_SCHED;
            PG8_STAGE(PG8_SB(0, 1), b2 + hstep, voffB);
            PG8_WAIT_V(6); PG8_BAR; PG8_MMA(1, 1, At, B1); PG8_BAR;
            PG8_LDB(B0, 1, 0); PG8_SCHED; PG8_LDA(At, 1, 0); PG8_STAGE(PG8_SA(0, 1), a2 + hstep, voffA);
            PG8_WAIT_L(8); PG8_BAR; PG8_WAIT_L(0); PG8_MMA(0, 0, At, B0); PG8_BAR; PG8_SCHED;
            PG8_LDB(B1, 1, 1); PG8_STAGE(PG8_SB(1, 0), b3, voffB);
            PG8_BAR; PG8_WAIT_L(0); PG8_MMA(0, 1, At, B1); PG8_BAR;
            PG8_LDA(At, 1, 1); PG8_STAGE(PG8_SA(1, 0), a3, voffA);
            PG8_BAR; PG8_WAIT_L(0); PG8_MMA(1, 0, At, B0); PG8_BAR; PG8_SCHED;
            PG8_STAGE(PG8_SB(1, 1), b3 + hstep, voffB);
            PG8_WAIT_V(6); PG8_BAR; PG8_MMA(1, 1, At, B1); PG8_BAR;
            }
        }
        if constexpr (ALIGN_EPI) { if (wr == 0) PG8_BAR; }
        if constexpr (!Epi::AFTER_DRAIN) { E(acc, cur, wr, wc, fr, fq); S.done(cur); }
        if (!has_next) break;
#pragma unroll
        for (int a = 0; a < 2; ++a)
#pragma unroll
            for (int b = 0; b < 2; ++b)
#pragma unroll
                for (int m = 0; m < 4; ++m)
#pragma unroll
                    for (int n = 0; n < 2; ++n) acc[a][b][m][n] = (f32x4){0.f, 0.f, 0.f, 0.f};
        cur = nxt; cA = nA; cB = nB; ++ui;
        if constexpr (ALIGN_EPI) { if (wr == 1) PG8_BAR; }
    }
    PG8_WAIT_V(0);
    if constexpr (!ALIGN_EPI) { if (wr == 0) PG8_BAR; }
    PG8_BAR;
    if constexpr (Epi::AFTER_DRAIN) { E.fused(acc, cur, wr, wc, fr, fq, lds, wid, lane); S.done(cur); }
#undef PG8_SA
#undef PG8_SB
#undef PG8_STAGE
#undef PG8_LDA
#undef PG8_LDB
#undef PG8_MMA
#undef PG8_WAIT_V
#undef PG8_WAIT_L
#undef PG8_BAR
#undef PG8_SCHED
}
}

namespace att {
typedef unsigned short bf16;
constexpr int D = 128, NW = 8, QBLK = 32, KVBLK = 64, QB = NW * QBLK;
constexpr int SHM_V = KVBLK * D * 2, SHM_K = KVBLK * D * 2;
constexpr int LDS_WS = 2 * SHM_V + 2 * SHM_K, LDS_KB = LDS_WS + NW * 64 * 4, LDS_SLOT = LDS_KB + 2 * 64 * 4, LDS_Q = LDS_SLOT + 256, LDS_END = LDS_Q + NW * 8192;
constexpr float SCALE = 1.f, THR = 8.f;
typedef short bf16x8 __attribute__((ext_vector_type(8)));
typedef short s16x4 __attribute__((ext_vector_type(4)));
typedef float f32x16 __attribute__((ext_vector_type(16)));
typedef float f32x4 __attribute__((ext_vector_type(4)));
typedef unsigned u32x4 __attribute__((ext_vector_type(4)));
template <class A, class Bt> struct same_t { static constexpr bool v = false; };
template <class A> struct same_t<A, A> { static constexpr bool v = true; };

#define KSWZ(row, colB) ((row) * 256 + ((colB) ^ (((row) & 7) << 4)))
#define SBAR() __builtin_amdgcn_sched_barrier(0)
__device__ __forceinline__ int v_st(int k, int c) { const int kk = (k & ~0xC) | ((k & 4) << 1) | ((k & 8) >> 1); return ((kk >> 3) * 4 + (c >> 5)) * 512 + ((kk & 7) * 32 + (c & 31)) * 2; }
__device__ __forceinline__ int v_rd_base(int lane) { return ((lane & 3) << 3) | (((lane >> 2) & 3) << 6) | (((lane >> 4) & 1) << 5) | (((lane >> 5) & 1) << 8); }
constexpr int v_rd_off(int d0, int ks, int half) { return d0 * 512 + ks * 4096 + half * 2048; }
__device__ __forceinline__ int crow(int r, int hi) { return (r & 3) + 8 * (r >> 2) + 4 * hi; }
__device__ __forceinline__ unsigned cvtpk(float lo, float hi) {
    unsigned r; asm volatile("v_cvt_pk_bf16_f32 %0, %1, %2" : "=v"(r) : "v"(lo), "v"(hi)); return r;
}
__device__ __forceinline__ bf16x8 pack8(f32x4 a, f32x4 b) {
    u32x4 w = {cvtpk(a[0], a[1]), cvtpk(a[2], a[3]), cvtpk(b[0], b[1]), cvtpk(b[2], b[3])};
    return *reinterpret_cast<bf16x8*>(&w);
}
template <class T> __device__ __forceinline__ bf16x8 load8(const T* p) {
    if constexpr (same_t<T, float>::v) { return pack8(*(const f32x4*)p, *(const f32x4*)(p + 4)); }
    else { return *reinterpret_cast<const bf16x8*>(p); }
}
__device__ __forceinline__ void mask_tile(f32x16& p0, f32x16& p1, int dq, unsigned W) {
    const float NEG = -__builtin_inff();
#pragma unroll
    for (int r = 0; r < 16; ++r) {
        const int c = (r & 3) + 8 * (r >> 2);
        if ((unsigned)(dq - c) >= W) p0[r] = NEG;
        if ((unsigned)(dq - c - 32) >= W) p1[r] = NEG;
    }
}
__device__ __forceinline__ void partialSM(f32x16& p0, f32x16& p1, float& m_reg, float& mn, float& alpha) {
    float pmax = p0[0]; for (int r = 1; r < 16; ++r) pmax = fmaxf(pmax, p0[r]); for (int r = 0; r < 16; ++r) pmax = fmaxf(pmax, p1[r]);
    { auto rr = __builtin_amdgcn_permlane32_swap(__float_as_uint(pmax), __float_as_uint(pmax), false, false);
      pmax = fmaxf(__uint_as_float(rr[0]), __uint_as_float(rr[1])); }
    constexpr float C2 = 1.f;
    if (__builtin_expect(__all((pmax - m_reg) * SCALE <= THR), 1)) { mn = m_reg; alpha = 1.f; }
    else { mn = fmaxf(m_reg, pmax); alpha = __builtin_amdgcn_exp2f((m_reg - mn) * C2); m_reg = mn; }
    const float mnL = -mn * C2;
    for (int r = 0; r < 16; ++r) p0[r] = fmaf(p0[r], C2, mnL); for (int r = 0; r < 16; ++r) p1[r] = fmaf(p1[r], C2, mnL);
    for (int r = 0; r < 16; ++r) p0[r] = __builtin_amdgcn_exp2f(p0[r]);
}
__device__ __forceinline__ void finishSM(f32x16& p0, f32x16& p1, float alpha, float& l_reg, bf16x8& pa0, bf16x8& pa1, bf16x8& pa2, bf16x8& pa3) {
    for (int r = 0; r < 16; ++r) p1[r] = __builtin_amdgcn_exp2f(p1[r]);
    float ps = 0; for (int r = 0; r < 16; ++r) ps += p0[r]; for (int r = 0; r < 16; ++r) ps += p1[r];
    { auto rr = __builtin_amdgcn_permlane32_swap(__float_as_uint(ps), __float_as_uint(ps), false, false);
      ps = __uint_as_float(rr[0]) + __uint_as_float(rr[1]); }
    l_reg = l_reg * alpha + ps;
#define PK4(P, B_, OUT) do { unsigned a0 = cvtpk(P[B_+0], P[B_+1]), a1 = cvtpk(P[B_+2], P[B_+3]);                          \
        unsigned b0 = cvtpk(P[B_+4], P[B_+5]), b1 = cvtpk(P[B_+6], P[B_+7]);                                             \
        auto r0 = __builtin_amdgcn_permlane32_swap(a0, b0, false, false); auto r1 = __builtin_amdgcn_permlane32_swap(a1, b1, false, false); \
        u32x4 w = {r0[0], r1[0], r0[1], r1[1]}; OUT = *reinterpret_cast<bf16x8*>(&w); } while (0)
    PK4(p0, 0, pa0); PK4(p0, 8, pa1); PK4(p1, 0, pa2); PK4(p1, 8, pa3);
#undef PK4
}
template <int KB, bool SK>
__device__ __forceinline__ void qkt(f32x16& p0, f32x16& p1, const char* K_lds, const float* kbl, int r32, int hi, const __attribute__((address_space(3))) char* q_lds, bool act) {
    if (SK && !act) { const float NEG = -__builtin_inff();
#pragma unroll
        for (int r = 0; r < 16; ++r) { p0[r] = NEG; p1[r] = NEG; } return; }
    { const float* kb_ = kbl + KB * 64 + 4 * hi;
#pragma unroll
      for (int j = 0; j < 4; ++j) { const f32x4 a = *(const f32x4*)(kb_ + 8 * j), b = *(const f32x4*)(kb_ + 32 + 8 * j);
          p0[4 * j] = a[0]; p0[4 * j + 1] = a[1]; p0[4 * j + 2] = a[2]; p0[4 * j + 3] = a[3];
          p1[4 * j] = b[0]; p1[4 * j + 1] = b[1]; p1[4 * j + 2] = b[2]; p1[4 * j + 3] = b[3]; } }
    const char* kb[4];
#pragma unroll
    for (int dd = 0; dd < 4; ++dd) kb[dd] = K_lds + KB * SHM_K + KSWZ(r32, (dd * 16 + hi * 8) * 2);
#pragma unroll
    for (int d0 = 0; d0 < 8; ++d0) { const char* a = kb[d0 & 3] + (d0 >> 2) * 128;
        bf16x8 b0 = *reinterpret_cast<const bf16x8*>(a);
        bf16x8 b1 = *reinterpret_cast<const bf16x8*>(a + 32 * 256);
        const bf16x8 q_ = *(const __attribute__((address_space(3))) bf16x8*)(q_lds + d0 * 1024);
        p0 = __builtin_amdgcn_mfma_f32_32x32x16_bf16(b0, q_, p0, 0, 0, 0);
        p1 = __builtin_amdgcn_mfma_f32_32x32x16_bf16(b1, q_, p1, 0, 0, 0); }
}
template <int VB, bool SK>
__device__ __forceinline__ void pv_tile(f32x16* o, int vb0, bf16x8 pa0, bf16x8 pa1, bf16x8 pa2, bf16x8 pa3, bool act) {
    if (SK && !act) return;
#define TRRD(dst, off) asm volatile("ds_read_b64_tr_b16 %0, %1 offset:%2" : "=&v"(dst) : "v"(vb0), "i"(off) : "memory")
#define PV_D0(d0) do { s16x4 l0, l1, l2, l3, h0, h1, h2, h3; constexpr int b_ = VB * SHM_V + v_rd_off(d0, 0, 0);     \
        TRRD(l0, b_); TRRD(h0, b_ + 2048); TRRD(l1, b_ + 4096); TRRD(h1, b_ + 6144); TRRD(l2, b_ + 8192); TRRD(h2, b_ + 10240); TRRD(l3, b_ + 12288); TRRD(h3, b_ + 14336); \
        asm volatile("s_waitcnt lgkmcnt(0)" ::: "memory"); SBAR();                 \
        o[d0] = __builtin_amdgcn_mfma_f32_32x32x16_bf16(pa0, (bf16x8){l0[0], l0[1], l0[2], l0[3], h0[0], h0[1], h0[2], h0[3]}, o[d0], 0, 0, 0);   \
        o[d0] = __builtin_amdgcn_mfma_f32_32x32x16_bf16(pa1, (bf16x8){l1[0], l1[1], l1[2], l1[3], h1[0], h1[1], h1[2], h1[3]}, o[d0], 0, 0, 0);   \
        o[d0] = __builtin_amdgcn_mfma_f32_32x32x16_bf16(pa2, (bf16x8){l2[0], l2[1], l2[2], l2[3], h2[0], h2[1], h2[2], h2[3]}, o[d0], 0, 0, 0);   \
        o[d0] = __builtin_amdgcn_mfma_f32_32x32x16_bf16(pa3, (bf16x8){l3[0], l3[1], l3[2], l3[3], h3[0], h3[1], h3[2], h3[3]}, o[d0], 0, 0, 0); } while (0)
    PV_D0(0); PV_D0(1); PV_D0(2); PV_D0(3);
#undef PV_D0
#undef TRRD
}

constexpr float LOG2E = 1.4426950408889634f;
struct Blk {
    const bf16* Q; const bf16* K; const bf16* V; bf16* O; float* LSE; const float* CUM;
    long rs, os; int ls;
    int P0, L, W, nvalid; float sd2, cref;
};
struct Seam { bf16x8 st_v0, st_v1, st_k0, st_k1; float st_b0, st_b1; };
__device__ __forceinline__ float kbias_raw(const Blk& B, int key) { return B.CUM ? B.CUM[key] : B.sd2 * (float)(key - B.P0); }
__device__ __forceinline__ float kbias_fin(const Blk& B, float raw) { return B.CUM ? -raw * LOG2E : raw; }
__device__ __forceinline__ int swa_jlo(int P0, int W) { const int lowk = P0 - W + 1; return lowk > 0 ? lowk / KVBLK : 0; }
__device__ __forceinline__ int swa_jhi(int P0, int L) { int j = (P0 + QB - 1) / KVBLK + 1; const int jm = L / KVBLK; return j > jm ? jm : j; }
__device__ __forceinline__ bf16x8 ld8(const bf16* p) { return *reinterpret_cast<const bf16x8*>(p); }
#define ROWP(p, rs_, k0, rr) ((p) + (size_t)(k0) * (rs_) + (unsigned)(((rr) * (int)(rs_)) + sc))
#define VMW() asm volatile("s_waitcnt vmcnt(0)" ::: "memory")
#define SLOAD(B_, k0) do { const bf16* vb_ = (B_).V + (size_t)(k0) * (B_).rs; const bf16* kb_ = (B_).K + (size_t)(k0) * (B_).rs;     \
                           unsigned o0_ = (unsigned)(sr * (int)(B_).rs + sc), o1_ = o0_ + 32u * (unsigned)(B_).rs; asm volatile("" : "+v"(o0_), "+v"(o1_));       \
                           S.st_v0 = ld8(vb_ + o0_); S.st_v1 = ld8(vb_ + o1_); S.st_k0 = ld8(kb_ + o0_); S.st_k1 = ld8(kb_ + o1_);                                  \
                           if ((tid & 15) == 0) { S.st_b0 = kbias_raw((B_), (k0) + sr); S.st_b1 = kbias_raw((B_), (k0) + 32 + sr); } } while (0)
#define SWRITE_K(bf, B_) do { *(bf16x8*)(K_lds + (bf) * SHM_K + kws) = S.st_k0; *(bf16x8*)(K_lds + (bf) * SHM_K + kws + 32 * 256) = S.st_k1;       \
                          if ((tid & 15) == 0) { kbl[(bf) * 64 + sr] = kbias_fin((B_), S.st_b0); kbl[(bf) * 64 + 32 + sr] = kbias_fin((B_), S.st_b1); } } while (0)
#define SWRITE_V(bf) do { *(bf16x8*)(V_lds + (bf) * SHM_V + vst0) = S.st_v0; *(bf16x8*)(V_lds + (bf) * SHM_V + vst1) = S.st_v1; } while (0)
#define QLOAD(B_) do { const int ri_ = (wid * QBLK + r32 < (B_).nvalid) ? wid * QBLK + r32 : (B_).nvalid - 1;                                    \
        const bf16* qp_ = (B_).Q + (unsigned)(ri_ * (int)(B_).rs + hi * 8);                                                                       \
        _Pragma("unroll") for (int hf_ = 0; hf_ < 2; ++hf_) { bf16x8 t_[4];                                                                      \
            _Pragma("unroll") for (int d0 = 0; d0 < 4; ++d0) t_[d0] = ld8(qp_ + (hf_ * 4 + d0) * 16);                                           \
            _Pragma("unroll") for (int d0 = 0; d0 < 4; ++d0) *(__attribute__((address_space(3))) bf16x8*)(q_lds + (hf_ * 4 + d0) * 1024) = t_[d0]; } } while (0)

__device__ __forceinline__ void prime(const Blk& cur, char* lds, Seam& S) {
    int tid_o = threadIdx.x; asm volatile("" : "+v"(tid_o));
    const int tid = tid_o, wid = __builtin_amdgcn_readfirstlane(tid >> 6), lane = tid & 63, r32 = lane & 31, hi = lane >> 5;
    const int sr = tid >> 4, sc = (tid & 15) * 8, kws = KSWZ(sr, sc * 2); char* K_lds = lds + 2 * SHM_V; float* kbl = (float*)(lds + LDS_KB); __attribute__((address_space(3))) char* q_lds = (__attribute__((address_space(3))) char*)(lds + LDS_Q + wid * 8192 + lane * 16);
    const int kb0 = (swa_jhi(cur.P0, cur.L) - 1) * KVBLK;
    S.st_b0 = 0.f; S.st_b1 = 0.f;
    QLOAD(cur);
    SLOAD(cur, kb0); VMW(); SWRITE_K(0, cur);
    __syncthreads();
}
#ifndef ATT_SK
#define ATT_SK true
#endif
struct AttnArgs { const bf16* QKV; unsigned char* ws; long offOA, offOP0, offOP2x; float* LSE; const float* CUM; };
__device__ __forceinline__ Blk decode(int i, const AttnArgs& A);
template <bool SK>
__device__ __forceinline__ bool block(const Blk& cur, Blk& nxt, int pend, int nitems, volatile int* slot, const AttnArgs& A, char* lds, Seam& S) {
    int tid_o = threadIdx.x; asm volatile("" : "+v"(tid_o));
    const int tid = tid_o, wid = __builtin_amdgcn_readfirstlane(tid >> 6), lane = tid & 63, r32 = lane & 31, hi = lane >> 5;
    const int W = cur.W;
    const int j_lo = swa_jlo(cur.P0, W);
    const int j_hi = swa_jhi(cur.P0, cur.L);
    const int NT = j_hi - j_lo;
    const int qlo = cur.P0 + wid * QBLK, qm = qlo + r32 - 4 * hi;
    char* V_lds = lds; char* K_lds = lds + 2 * SHM_V;
    float* ws = (float*)(lds + LDS_WS) + wid * 64; float* li_l = ws, * al_l = ws + 32; float* kbl = (float*)(lds + LDS_KB); __attribute__((address_space(3))) char* q_lds = (__attribute__((address_space(3))) char*)(lds + LDS_Q + wid * 8192 + lane * 16);
    float m_reg = -1e30f, l_reg = 0; f32x16 o[4] = {};
    const int sr = tid >> 4, sc = (tid & 15) * 8, vst0 = v_st(sr, sc), vst1 = v_st(32 + sr, sc), kws = KSWZ(sr, sc * 2);
    const int vb0 = (int)(uintptr_t)V_lds + v_rd_base(lane);
#define RESC(a) do { if (__any((a) < 1.f)) { if (hi == 0) al_l[r32] = (a); asm volatile("s_waitcnt lgkmcnt(0)" ::: "memory");              \
                     for (int d_ = 0; d_ < 4; ++d_) for (int r = 0; r < 16; ++r) o[d_][r] *= al_l[crow(r, hi)]; } } while (0)
#define KBASE(t) ((j_hi - 1 - (t)) * KVBLK)
#define ACT(t) (KBASE(t) <= qlo + QBLK - 1 && KBASE(t) + KVBLK - 1 >= qlo - W + 1)
#define MASKT(P0_, P1_, t) do { const int kb_ = KBASE(t); if ((!SK || ACT(t)) && (kb_ + KVBLK - 1 > qlo || kb_ <= qlo + QBLK - 1 - W)) mask_tile(P0_, P1_, qm - kb_, (unsigned)W); } while (0)
    f32x16 pA0, pA1, pB0, pB1; float mnA, mnB, alA, alB; bf16x8 pa0, pa1, pa2, pa3;
    SWRITE_V(0); SBAR();
    if (NT > 1) SLOAD(cur, KBASE(1));
    SBAR(); qkt<0, SK>(pA0, pA1, K_lds, kbl, r32, hi, q_lds, ACT(0));
    MASKT(pA0, pA1, 0); partialSM(pA0, pA1, m_reg, mnA, alA);
    if (NT > 1) { VMW(); SWRITE_V(1); SWRITE_K(1, cur); }
    __syncthreads();
#define HALF_STEP(PX0, PX1, mnX, alX, PY0, PY1, alY, t, KB, VB, SB) do {                                                      \
        SBAR(); qkt<KB, SK>(PX0, PX1, K_lds, kbl, r32, hi, q_lds, ACT(t));                                                     \
        finishSM(PY0, PY1, alY, l_reg, pa0, pa1, pa2, pa3); SBAR();                                                           \
        if ((t) + 1 < NT) { SLOAD(cur, KBASE((t) + 1)); SBAR(); }                                                             \
        pv_tile<VB, SK>(o, vb0, pa0, pa1, pa2, pa3, ACT((t) - 1)); MASKT(PX0, PX1, (t)); partialSM(PX0, PX1, m_reg, mnX, alX); \
        __syncthreads();                                                                                                      \
        if ((t) + 1 < NT) { VMW(); SWRITE_V(SB); SWRITE_K(SB, cur); }                                                              \
        RESC(alX); __syncthreads(); } while (0)
    for (int t = 1; t + 1 < NT; t += 2) {
        HALF_STEP(pB0, pB1, mnB, alB, pA0, pA1, alA, t, 1, 0, 0);
        HALF_STEP(pA0, pA1, mnA, alA, pB0, pB1, alB, t + 1, 0, 1, 1);
    }
    const bool even = (NT & 1) == 0;
    if (even) { SBAR(); qkt<1, SK>(pB0, pB1, K_lds, kbl, r32, hi, q_lds, ACT(NT - 1)); SBAR(); }
    if (tid == 0) slot[0] = pend;
    __syncthreads();
    const int ni = __builtin_amdgcn_readfirstlane(slot[0]); const bool last = ni >= nitems;
    nxt = decode(last ? 0 : ni, A);
    if (!last) { const int kbn = (swa_jhi(nxt.P0, nxt.L) - 1) * KVBLK;
        SLOAD(nxt, kbn); SBAR();
        QLOAD(nxt); }
    SBAR();
    finishSM(pA0, pA1, alA, l_reg, pa0, pa1, pa2, pa3); SBAR();
    pv_tile<0, SK>(o, vb0, pa0, pa1, pa2, pa3, ACT(even ? NT - 2 : NT - 1));
    if (even) { MASKT(pB0, pB1, NT - 1); partialSM(pB0, pB1, m_reg, mnB, alB); __syncthreads(); RESC(alB);
        finishSM(pB0, pB1, alB, l_reg, pa0, pa1, pa2, pa3); SBAR(); pv_tile<1, SK>(o, vb0, pa0, pa1, pa2, pa3, ACT(NT - 1)); }
    SBAR(); if (!last) SWRITE_K(0, nxt); SBAR();
    int lne_ = (int)(threadIdx.x & 63u); asm volatile("" : "+v"(lne_)); const int r32e = lne_ & 31, hie = lne_ >> 5;
    if (hie == 0) li_l[r32e] = l_reg; asm volatile("s_waitcnt lgkmcnt(0)" ::: "memory");
    float rli[16];
#pragma unroll
    for (int r = 0; r < 16; ++r) rli[r] = __builtin_amdgcn_rcpf(li_l[crow(r, hie)]);
    bf16* Ow = cur.O + (size_t)(wid * QBLK) * cur.os;
#pragma unroll
    for (int r = 0; r < 16; ++r) { const int orow = crow(r, hie); const bool ok = (wid * QBLK + orow < cur.nvalid) && ((r32e & 1) == 0);
#pragma unroll
        for (int d0 = 0; d0 < 4; ++d0) { const float v = o[d0][r] * rli[r]; const float vn = __shfl_xor(v, 1);
            if (ok) *(unsigned*)(Ow + (unsigned)(orow * (int)cur.os + d0 * 32 + r32e)) = cvtpk(v, vn); } }
    if (cur.LSE && hie == 0 && wid * QBLK + r32e < cur.nvalid)
        cur.LSE[(unsigned)((wid * QBLK + r32e) * cur.ls)] = m_reg + __builtin_amdgcn_logf(l_reg) - cur.sd2 * (float)(wid * QBLK + r32e);
    __syncthreads();
    return last;
#undef RESC
#undef KBASE
#undef ACT
#undef MASKT
#undef HALF_STEP
}
#undef ROWP
#undef VMW
#undef SLOAD
#undef SWRITE_K
#undef SWRITE_V
#undef QLOAD

constexpr int NITEMS = 256 + 256 + 256 + 512;
__device__ __forceinline__ Blk decode(int i_in, const AttnArgs& A) {
    const int i = __builtin_amdgcn_readfirstlane(i_in);
    Blk b; int bh, qb, res, dil, pat; const bool fox = i < 256;
    if (i < 256) { qb = 7 - (i >> 5); bh = i & 31; res = 0; dil = 1; pat = 0; }
    else if (i < 512) { const int j = i - 256; qb = 7 - (j >> 5); bh = j & 31; res = 0; dil = 1; pat = 0; }
    else if (i < 768) { const int j = i - 512; bh = j & 31; const int rest = j >> 5; res = rest >> 1; qb = rest & 1; dil = 4; pat = 1; }
    else { const int j = i - 768; bh = j & 31; res = j >> 5; qb = 0; dil = 16; pat = 2; }
    const int bb = bh >> 3, h = bh & 7, L = 2048 / dil, P0 = qb * 256;
    const size_t tok0 = (size_t)bb * 2048 + res;
    const int seg = fox ? 0 : 3;
    const bf16* base = A.QKV + tok0 * 6144 + h * 128;
    const int opitch = fox ? 2048 : 1024;
    b.rs = (long)dil * 6144; b.os = (long)dil * opitch; b.ls = dil * 8;
    b.Q = base + seg * 1024 + (size_t)P0 * b.rs; b.K = base + (seg + 1) * 1024; b.V = base + (seg + 2) * 1024;
    long ooff = A.offOP0 + (long)pat * (16l << 20) + (pat == 2 ? A.offOP2x : 0l); ooff = fox ? A.offOA : ooff;
    bf16* ob = (bf16*)(A.ws + ooff);
    b.O = ob + (tok0 + (size_t)P0 * dil) * opitch + h * 128;
    float* lb = A.LSE + (size_t)pat * (8192 * 8);
    b.LSE = fox ? nullptr : lb + (tok0 + (size_t)P0 * dil) * 8 + h;
    b.CUM = fox ? A.CUM + (size_t)bh * 2048 : nullptr;
    b.cref = 0.f;
    b.P0 = P0; b.L = L; b.W = fox ? (1 << 30) : 129; b.nvalid = (L - P0) < QB ? (L - P0) : QB;
    b.sd2 = fox ? 0.f : __builtin_amdgcn_exp2f(-(float)(h + 1)) * (float)dil * LOG2E;
    return b;
}
__device__ __forceinline__ void attn_phase(char* lds, const AttnArgs& A, unsigned* ctr, int first = 0) {
    volatile int* slot = (volatile int*)(lds + LDS_SLOT);
    const int G = (int)gridDim.x, ci = first + (int)blockIdx.x;
    if (ci >= NITEMS) return;
    Blk cur = decode(ci, A); Seam S;
    prime(cur, lds, S);
    for (;;) {
        int pend = NITEMS; if (threadIdx.x == 0) pend = first + G + (int)atomicAdd(ctr, 1u);
        Blk nxt; bool last;
        if (cur.CUM) last = block<false>(cur, nxt, pend, NITEMS, slot, A, lds, S);
        else last = block<true>(cur, nxt, pend, NITEMS, slot, A, lds, S);
        if (last) break;
        cur = nxt;
    }
}
#undef SBAR
}

#define GAS __attribute__((address_space(1)))
#define LAS __attribute__((address_space(3)))
typedef unsigned short bf16;
typedef unsigned v4u __attribute__((ext_vector_type(4)));
typedef float f32x4 __attribute__((ext_vector_type(4)));
constexpr int NWAVES = 8;
constexpr int NB = 4, SEQ = 2048, DM = 2048, M = NB * SEQ, NH = 8, HD = 128, DFF = 5632, NUP = 2 * DFF, INC = 10248, NPROJ = 10240;
constexpr float EPS = 1e-6f;
constexpr float LOG2E_F = 1.4426950408889634f;
constexpr size_t MiB = 1u << 20;
constexpr size_t WS_CTL = 0, WS_BAR = 64 * 1024;
constexpr size_t WS_GAIN = 2 * MiB, WS_RSTD = 3 * MiB;
constexpr size_t WS_SSQ = 256 * 1024, WS_CUM = 512 * 1024, WS_LOGF = 768 * 1024, WS_LSE = 1 * MiB;
constexpr size_t WS_WIN = 4 * MiB, WS_WBRF = 44 * MiB, WS_WBRD = 48 * MiB, WS_WOUT = 52 * MiB, WS_WUP = 60 * MiB, WS_WDN = 104 * MiB;
constexpr size_t WS_XN = 126 * MiB;
constexpr size_t WS_QKV = 158 * MiB;
constexpr size_t WS_GATES = 254 * MiB;
constexpr size_t WS_OA = 4 * MiB, WS_OB = 20 * MiB;
constexpr size_t WS_OP0 = 126 * MiB, WS_OP1 = 142 * MiB, WS_OP2 = 318 * MiB;
constexpr size_t WS_T = 158 * MiB, WS_MG = 222 * MiB;
constexpr size_t WS_XB = 126 * MiB;
#ifndef CONV_ALIGN
#define CONV_ALIGN false
#endif
#ifndef FUSED_CONV
#define FUSED_CONV 0
#endif
constexpr size_t WS_U = 158 * MiB;
constexpr size_t WS_ACT = FUSED_CONV ? 158 * MiB : 4 * MiB, WS_US = 254 * MiB;
constexpr size_t WS_END = 334 * MiB;
constexpr int RING_BYTES = 131072, XL_OFF = RING_BYTES, BARST_OFF = 143360, LDS_BYTES = 147456;
static_assert(att::LDS_END <= LDS_BYTES, "attention LDS");

__device__ __forceinline__ unsigned f2bf(float f) { unsigned u = __builtin_bit_cast(unsigned, f); return (u + 0x7fffu + ((u >> 16) & 1u)) >> 16; }
__device__ __forceinline__ unsigned pk2(float lo, float hi) { return f2bf(lo) | (f2bf(hi) << 16); }
__device__ __forceinline__ float wave_sum(float v) {
#pragma unroll
    for (int o = 1; o < 64; o <<= 1) v += __shfl_xor(v, o);
    return v;
}
template <int MODE, bool NTST>
__device__ __forceinline__ void transpose_matrix(const float* W, int K, int Nsrc, int Ndst, bf16* WT, int Kdst, int koff, const float* kscale, int rot, int gw, int NGW, LAS float* scr, int lane) {
    const int nblk = Ndst / 32, nitems = (K / 64) * nblk, rr = lane >> 3, c4 = (lane & 7) * 4, c = lane & 7;
    int it = gw - rot; if (it < 0) it += NGW;
    f32x4 v[8]; int k0 = 0, n0 = 0;
#define TM_LOAD(dst, IT, K0, N0) do { const int kb_ = (IT) / nblk; N0 = 32 * ((IT) - kb_ * nblk); K0 = 64 * kb_;                                   \
        const int sc_ = MODE == 0 ? N0 : (MODE == 1 ? (N0 < 3072 ? N0 : N0 + 8) : (((N0 >> 7) & 1) * 5632 + 128 * (N0 >> 8) + (N0 & 127)));       \
        _Pragma("unroll") for (int i = 0; i < 8; ++i) dst[i] = __builtin_nontemporal_load((const f32x4*)(W + (size_t)(K0 + 8 * i + rr) * Nsrc + sc_ + c4)); } while (0)
    if (it < nitems) TM_LOAD(v, it, k0, n0);
    while (it < nitems) {
        const int itn = it + NGW; f32x4 vn[8]; int k0n = 0, n0n = 0;
        if (itn < nitems) TM_LOAD(vn, itn, k0n, n0n);
        if (kscale) {
#pragma unroll
            for (int i = 0; i < 8; ++i) v[i] = v[i] * kscale[k0 + 8 * i + rr]; }
#pragma unroll
        for (int i = 0; i < 8; ++i) { LAS float* d = scr + (8 * i + rr) * 33 + c4; d[0] = v[i][0]; d[1] = v[i][1]; d[2] = v[i][2]; d[3] = v[i][3]; }
        asm volatile("s_waitcnt lgkmcnt(0)" ::: "memory");
#pragma unroll
        for (int j = 0; j < 4; ++j) { const int n = (lane >> 3) + 8 * j; const LAS float* sp = scr + (8 * c) * 33 + n;
            v4u o; o.x = pk2(sp[0 * 33], sp[1 * 33]); o.y = pk2(sp[2 * 33], sp[3 * 33]); o.z = pk2(sp[4 * 33], sp[5 * 33]); o.w = pk2(sp[6 * 33], sp[7 * 33]);
            if constexpr (NTST) __builtin_nontemporal_store(o, (v4u*)(WT + (size_t)(n0 + n) * Kdst + koff + k0 + 8 * c)); else *(v4u*)(WT + (size_t)(n0 + n) * Kdst + koff + k0 + 8 * c) = o; }
        asm volatile("s_waitcnt lgkmcnt(0)" ::: "memory");
        it = itn; k0 = k0n; n0 = n0n;
#pragma unroll
        for (int i = 0; i < 8; ++i) v[i] = vn[i];
    }
#undef TM_LOAD
}

typedef GAS unsigned gu32;
#define RLX_AGENT __ATOMIC_RELAXED, __HIP_MEMORY_SCOPE_AGENT
#define XB_TMO      128
#define XB_XCNT(j)  (256  + 64 * (j))
#define XB_XSUB(j)  (1280 + 64 * (j))
#define XB_XGEN(j)  (2304 + 64 * (j))
#define XB_TOP      3328
#define XB_TOPGEN   3392
#define XCD_BAR_WORDS 3456
#define XB_SPIN_CAP (1u << 18)

__device__ __forceinline__ unsigned xb_ld(unsigned* p)              { return __hip_atomic_load(p, __ATOMIC_RELAXED, __HIP_MEMORY_SCOPE_AGENT); }
__device__ __forceinline__ unsigned xb_add(unsigned* p, unsigned v) { return __hip_atomic_fetch_add(p, v, __ATOMIC_RELAXED, __HIP_MEMORY_SCOPE_AGENT); }
__device__ __forceinline__ unsigned xb_xcc_id() { return (unsigned)__builtin_amdgcn_s_getreg((3 << 11) | 20) & 0xFu; }
#define XB_SPIN(cond, bar) do { unsigned _sp = 0; while (cond) { __builtin_amdgcn_s_sleep(1); \
    if ((++_sp & 255u) == 0u) { if (xb_ld(&(bar)[XB_TMO])) break; if (_sp > XB_SPIN_CAP) { atomicAdd(&(bar)[XB_TMO], 1u); break; } } } } while (0)

struct XcdBarrier {
    unsigned* bar; unsigned x;
    volatile LAS unsigned* st;
};

__device__ __forceinline__ XcdBarrier xcd_barrier_post(unsigned* bar, volatile LAS unsigned* st) {
    XcdBarrier b; b.bar = bar; b.x = xb_xcc_id(); b.st = st;
    if (threadIdx.x == 0) (void)xb_add(&bar[XB_XCNT(b.x)], 1u);
    return b;
}
__device__ __forceinline__ void xcd_barrier_complete(unsigned* bar, unsigned x, unsigned& nloc, unsigned& nx) {
    const unsigned G = gridDim.x * gridDim.y * gridDim.z;
    unsigned sum, cnt, mine, sp = 0u;
    for (;;) {
        sum = 0u; cnt = 0u; mine = 0u;
#pragma unroll
        for (unsigned j = 0; j < 16; ++j) { const unsigned c = xb_ld(&bar[XB_XCNT(j)]); sum += c; cnt += (c > 0u) ? 1u : 0u; mine = (j == x) ? c : mine; }
        if (sum == G) break;
        __builtin_amdgcn_s_sleep(1);
        if ((++sp & 255u) == 0u) { if (xb_ld(&bar[XB_TMO])) break; if (sp > XB_SPIN_CAP) { atomicAdd(&bar[XB_TMO], 1u); break; } }
    }
    nloc = mine > 0u ? mine : 1u; nx = cnt > 0u ? cnt : 1u;
}

__device__ __forceinline__ void xcd_barrier(const XcdBarrier& b) {
    asm volatile("s_waitcnt vmcnt(0)" ::: "memory");
    __syncthreads();
    if (threadIdx.x == 0) {
        unsigned* bar = b.bar;
        __builtin_amdgcn_s_waitcnt(0);
        unsigned nloc = b.st[0], nx = b.st[1];
        if (nloc == 0u) { xcd_barrier_complete(bar, b.x, nloc, nx); b.st[0] = nloc; b.st[1] = nx; }
        const unsigned old = xb_add(&bar[XB_XSUB(b.x)], 1u);
        const unsigned gen = old / nloc;
        if (old + 1u == (gen + 1u) * nloc) {
            __builtin_amdgcn_fence(__ATOMIC_RELEASE, "agent");
            asm volatile("s_waitcnt vmcnt(0)" ::: "memory");
            const unsigned og = xb_add(&bar[XB_TOP], 1u);
            const unsigned tg = og / nx;
            if (og + 1u == (tg + 1u) * nx) xb_add(&bar[XB_TOPGEN], 1u);
            else XB_SPIN(xb_ld(&bar[XB_TOPGEN]) == tg, bar);
            __builtin_amdgcn_fence(__ATOMIC_ACQUIRE, "agent");
            xb_add(&bar[XB_XGEN(b.x)], 1u);
            asm volatile("s_waitcnt vmcnt(0)" ::: "memory");
        } else {
            XB_SPIN(xb_ld(&bar[XB_XGEN(b.x)]) == gen, bar);
            __builtin_amdgcn_fence(__ATOMIC_ACQUIRE, "agent");
            asm volatile("s_waitcnt vmcnt(0)" ::: "memory");
        }
    }
    __syncthreads();
}
#ifndef PROBE_REPEAT
#define PROBE_REPEAT -1
#endif
#ifndef PROBE_FIRST
#define PROBE_FIRST 0
#endif
#define REPS(k) ((PROBE_REPEAT == (k)) ? 2 : 1)
struct Args { const float* in[16]; float* out; unsigned char* ws; unsigned long long flags; };
#define IDS() int tid_o = threadIdx.x; asm volatile("" : "+v"(tid_o)); const int tid = tid_o, lane = tid & 63, wave = __builtin_amdgcn_readfirstlane(tid >> 6); (void)lane; (void)wave
#define OPQ() int z_ = 0; asm volatile("" : "+s"(z_))
#define INP(k) (args.in[z_ + (k)])

__global__ void __launch_bounds__(NWAVES * 64, 2) fwd_mega(Args args) {
    extern __shared__ __attribute__((aligned(16))) unsigned char lds[];
    cg::grid_group grid = cg::this_grid();
    LAS unsigned char* lds3 = (LAS unsigned char*)lds;
    const int G = gridDim.x, bx = blockIdx.x;
    if (threadIdx.x < 2) ((volatile LAS unsigned*)(lds3 + BARST_OFF))[threadIdx.x] = 0u;
    __syncthreads();
    unsigned char* ws = args.ws;
    const XcdBarrier xbar = xcd_barrier_post((unsigned*)(ws + WS_BAR), (volatile LAS unsigned*)(lds3 + BARST_OFF));
    float* out = args.out;
    bf16* Win_t = (bf16*)(ws + WS_WIN); bf16* Wbrf_t = (bf16*)(ws + WS_WBRF); bf16* Wbrd_t = (bf16*)(ws + WS_WBRD); bf16* Wout_t = (bf16*)(ws + WS_WOUT);
    bf16* Wup_t = (bf16*)(ws + WS_WUP); bf16* Wdn_t = (bf16*)(ws + WS_WDN);
    bf16* XN = (bf16*)(ws + WS_XN); bf16* QKV = (bf16*)(ws + WS_QKV); bf16* GATES = (bf16*)(ws + WS_GATES);
    bf16* OA = (bf16*)(ws + WS_OA); bf16* OB = (bf16*)(ws + WS_OB); bf16* OP0 = (bf16*)(ws + WS_OP0); bf16* OP1 = (bf16*)(ws + WS_OP1); bf16* OP2 = (bf16*)(ws + WS_OP2);
    float* T = (float*)(ws + WS_T); bf16* MG = (bf16*)(ws + WS_MG); bf16* XB = (bf16*)(ws + WS_XB); bf16* ACT = (bf16*)(ws + WS_ACT); bf16* U = (bf16*)(ws + WS_U); float* US = (float*)(ws + WS_US); (void)U; (void)US;
    float* SSQ = (float*)(ws + WS_SSQ); float* CUM = (float*)(ws + WS_CUM); float* LOGF = (float*)(ws + WS_LOGF); float* LSE = (float*)(ws + WS_LSE);
    unsigned* ctl = (unsigned*)(ws + WS_CTL); float* GAIN = (float*)(ws + WS_GAIN); float* RSTD = (float*)(ws + WS_RSTD);

#if !defined(ONLY) || ONLY == 0
    _Pragma("unroll 1") for (int rep_ = 0; rep_ < REPS(0); ++rep_) {
        IDS();
        OPQ(); const float* x = INP(0); const float* g_attn = INP(1); const float* w_in = INP(2); const float* b_forget = INP(3); const float* gq_fox = INP(4); const float* gk_fox = INP(5); const float* gq_dil = INP(6); const float* gk_dil = INP(7);
        const float* w_br_fox = INP(8); const float* w_br_dil = INP(9); const float* w_out = INP(10); const float* g_ffn = INP(11); const float* w_up = INP(12); const float* w_down = INP(15);
        if (bx == 1) for (int i = tid; i < 1024; i += NWAVES * 64) { GAIN[i] = gq_fox[i]; GAIN[1024 + i] = gk_fox[i]; GAIN[2048 + i] = gq_dil[i]; GAIN[3072 + i] = gk_dil[i]; }
        LAS float* scr = (LAS float*)(lds3 + wave * 16384);
        const int gw = bx * NWAVES + wave, NGW = G * NWAVES;
        constexpr int I_IN = (DM / 64) * (NPROJ / 32), I_BR = (1024 / 64) * (DM / 32), I_OUT = (DM / 64) * (DM / 32), I_UP = (DM / 64) * (NUP / 32);
        transpose_matrix<1, false>(w_in, DM, INC, NPROJ, Win_t, DM, 0, nullptr, 0, gw, NGW, scr, lane);
        transpose_matrix<0, true>(w_br_fox, 1024, DM, DM, Wbrf_t, 2048, 0, nullptr, I_IN % NGW, gw, NGW, scr, lane);
        transpose_matrix<0, true>(w_br_dil, 1024, DM, DM, Wbrf_t, 2048, 1024, nullptr, (I_IN + I_BR) % NGW, gw, NGW, scr, lane);
        transpose_matrix<0, true>(w_out, DM, DM, DM, Wout_t, DM, 0, nullptr, (I_IN + 2 * I_BR) % NGW, gw, NGW, scr, lane);
        transpose_matrix<2, true>(w_up, DM, NUP, NUP, Wup_t, DM, 0, g_ffn, (I_IN + 2 * I_BR + I_OUT) % NGW, gw, NGW, scr, lane);
        transpose_matrix<0, true>(w_down, DFF, DM, DM, Wdn_t, DFF, 0, nullptr, (I_IN + 2 * I_BR + I_OUT + I_UP) % NGW, gw, NGW, scr, lane);
        __syncthreads();
        LAS float* wf = (LAS float*)lds3;
        {
            const float* wsrc = w_in + 3072 + (tid & 7);
#pragma unroll 1
            for (int b0 = 0; b0 < 32; b0 += 8) { float tv[8];
#pragma unroll
                for (int q = 0; q < 8; ++q) tv[q] = wsrc[(size_t)((tid + (b0 + q) * NWAVES * 64) >> 3) * INC];
#pragma unroll
                for (int q = 0; q < 8; ++q) wf[tid + (b0 + q) * NWAVES * 64] = tv[q]; }
        }
        __syncthreads();
        for (int m = gw; m < M; m += NGW) {
            const f32x4* xr = (const f32x4*)(x + (size_t)m * DM) + lane; const f32x4* gr = (const f32x4*)g_attn + lane;
            f32x4 v[8]; float s = 0.f;
#pragma unroll
            for (int j = 0; j < 8; ++j) { v[j] = __builtin_nontemporal_load(xr + 64 * j); s += (v[j][0] * v[j][0] + v[j][1] * v[j][1]) + (v[j][2] * v[j][2] + v[j][3] * v[j][3]); }
            const float rstd = 1.f / sqrtf(wave_sum(s) * (1.f / DM) + EPS);
            float fa[8] = {0.f, 0.f, 0.f, 0.f, 0.f, 0.f, 0.f, 0.f};
            unsigned long long* o8 = (unsigned long long*)(XN + (size_t)m * DM) + lane;
#pragma unroll
            for (int j = 0; j < 8; ++j) { const f32x4 h = v[j] * rstd * gr[64 * j];
                o8[64 * j] = (unsigned long long)pk2(h[0], h[1]) | ((unsigned long long)pk2(h[2], h[3]) << 32);
#pragma unroll
                for (int c = 0; c < 4; ++c) { const LAS f32x4* wp = (const LAS f32x4*)(wf + (size_t)(256 * j + 4 * lane + c) * 8); const f32x4 wa = wp[0], wb = wp[1];
                    fa[0] = fmaf(h[c], wa[0], fa[0]); fa[1] = fmaf(h[c], wa[1], fa[1]); fa[2] = fmaf(h[c], wa[2], fa[2]); fa[3] = fmaf(h[c], wa[3], fa[3]);
                    fa[4] = fmaf(h[c], wb[0], fa[4]); fa[5] = fmaf(h[c], wb[1], fa[5]); fa[6] = fmaf(h[c], wb[2], fa[6]); fa[7] = fmaf(h[c], wb[3], fa[7]); }
                asm volatile("" ::: "memory"); }
#pragma unroll
            for (int hh = 0; hh < 8; ++hh) fa[hh] = wave_sum(fa[hh]);
            if (lane < 8) { float z = fa[0];
#pragma unroll
                for (int hh = 1; hh < 8; ++hh) z = (lane == hh) ? fa[hh] : z;
                z += b_forget[lane];
                LOGF[(size_t)m * 8 + lane] = fminf(z, 0.f) - log1pf(expf(-fabsf(z))); }
        }
        __syncthreads();
    }
#endif
    if (args.flags & 1ull) grid.sync();
    xcd_barrier(xbar);

#if !defined(ONLY) || ONLY == 1
    _Pragma("unroll 1") for (int rep_ = 0; rep_ < REPS(1); ++rep_) {
        if (rep_ > 0) xcd_barrier(xbar);
        IDS();
        if (bx < NB * NH) { const int bb = bx >> 3, h = bx & 7; LAS float* wt = (LAS float*)lds3;
            float v[4]; float s = 0.f;
#pragma unroll
            for (int j = 0; j < 4; ++j) { v[j] = LOGF[((size_t)bb * SEQ + 4 * tid + j) * 8 + h]; s += v[j]; v[j] = s; }
            float inc = s;
#pragma unroll
            for (int o = 1; o < 64; o <<= 1) { const float t = __shfl_up(inc, o); if (lane >= o) inc += t; }
            if (lane == 63) wt[wave] = inc;
            __syncthreads();
            float off = inc - s;
            for (int w = 0; w < wave; ++w) off += wt[w];
#pragma unroll
            for (int j = 0; j < 4; ++j) CUM[(size_t)bx * SEQ + 4 * tid + j] = off + v[j];
            __syncthreads();
        }
        pg8::Gemm g{XN, Win_t, M, NPROJ, DM}; pg8::StaticOrder S; S.init(M, NPROJ, G, bx);
        pg8::EpiProj E{QKV, GATES, GAIN, (LAS float*)(lds3 + XL_OFF)};
        pg8::gemm_phase<pg8::EpiProj, pg8::StaticOrder, true, true>(lds3, g, S, E);
    }
#endif
    xcd_barrier(xbar);

#if !defined(ONLY) || ONLY == 2
    _Pragma("unroll 1") for (int rep_ = 0; rep_ < REPS(2); ++rep_) {
        if (rep_ > 0) xcd_barrier(xbar);
        IDS();
        const att::AttnArgs A{QKV, ws, (long)WS_OA, (long)WS_OP0, (long)WS_OP2 - (long)WS_OP0 - 32 * (long)MiB, LSE, CUM};
        att::attn_phase((char*)lds, A, ctl + 16 * rep_, rep_ ? PROBE_FIRST : 0);
    }
#endif
    xcd_barrier(xbar);

#if !defined(ONLY) || ONLY == 3
    _Pragma("unroll 1") for (int rep_ = 0; rep_ < REPS(3); ++rep_) {
        if (rep_ > 0) xcd_barrier(xbar);
        IDS();
        const int gt = bx * (NWAVES * 64) + tid, NT = G * NWAVES * 64;
        for (int i = gt; i < M * 128; i += NT) { const int m = i >> 7, c8 = (i & 127) * 8, h = c8 >> 7;
            const float l0 = LSE[(size_t)m * 8 + h], l1 = LSE[(size_t)(M + m) * 8 + h], l2 = LSE[(size_t)(2 * M + m) * 8 + h];
            const float mx = fmaxf(l0, fmaxf(l1, l2));
            float w0 = __builtin_amdgcn_exp2f(l0 - mx), w1 = __builtin_amdgcn_exp2f(l1 - mx), w2 = __builtin_amdgcn_exp2f(l2 - mx);
            const float inv = 1.f / (w0 + w1 + w2); w0 *= inv; w1 *= inv; w2 *= inv;
            const v4u a = __builtin_nontemporal_load((const v4u*)(OP0 + (size_t)m * 1024 + c8)), b = __builtin_nontemporal_load((const v4u*)(OP1 + (size_t)m * 1024 + c8)), c = __builtin_nontemporal_load((const v4u*)(OP2 + (size_t)m * 1024 + c8));
            v4u o;
#pragma unroll
            for (int k = 0; k < 4; ++k) { const float lo = w0 * pg8::bflo(a[k]) + w1 * pg8::bflo(b[k]) + w2 * pg8::bflo(c[k]), hi = w0 * pg8::bfhi(a[k]) + w1 * pg8::bfhi(b[k]) + w2 * pg8::bfhi(c[k]); o[k] = pk2(lo, hi); }
            *(v4u*)(OA + (size_t)m * 2048 + 1024 + c8) = o; }
    }
#endif
    xcd_barrier(xbar);

#if !defined(ONLY) || ONLY == 4
    _Pragma("unroll 1") for (int rep_ = 0; rep_ < REPS(4); ++rep_) {
        if (rep_ > 0) xcd_barrier(xbar);
        IDS();
        pg8::StaticOrder S; S.init(M, DM, G, bx);
        pg8::Gemm g{OA, Wbrf_t, M, DM, 2048}; pg8::EpiBr E{GATES, MG};
        pg8::gemm_phase<pg8::EpiBr, pg8::StaticOrder, true, true>(lds3, g, S, E);
    }
#endif
    xcd_barrier(xbar);

#if !defined(ONLY) || ONLY == 5
    _Pragma("unroll 1") for (int rep_ = 0; rep_ < REPS(5); ++rep_) {
        if (rep_ > 0) xcd_barrier(xbar);
        IDS();
        pg8::Gemm g{MG, Wout_t, M, DM, DM}; pg8::StaticOrder S; S.init(M, DM, G, bx);
        OPQ(); pg8::EpiOut E{INP(0), XB, SSQ};
        pg8::gemm_phase<pg8::EpiOut, pg8::StaticOrder, false, true>(lds3, g, S, E);
    }
#endif
    xcd_barrier(xbar);

#if !defined(ONLY) || ONLY == 6
    _Pragma("unroll 1") for (int rep_ = 0; rep_ < REPS(6); ++rep_) {
        if (rep_ > 0) xcd_barrier(xbar);
        IDS();
#pragma unroll 1
        for (int r0 = tid; r0 < M; r0 += 8 * NWAVES * 64) { f32x4 sa[8], sb[8];
#pragma unroll
            for (int q = 0; q < 8; ++q) { const size_t r = (size_t)(r0 + q * NWAVES * 64); sa[q] = *(const f32x4*)(SSQ + r * 8); sb[q] = *(const f32x4*)(SSQ + r * 8 + 4); }
#pragma unroll
            for (int q = 0; q < 8; ++q) RSTD[r0 + q * NWAVES * 64] = 1.f / sqrtf((((sa[q][0] + sa[q][1]) + (sa[q][2] + sa[q][3])) + ((sb[q][0] + sb[q][1]) + (sb[q][2] + sb[q][3]))) * (1.f / DM) + EPS); }
        asm volatile("s_waitcnt vmcnt(0)" ::: "memory"); __syncthreads();
        pg8::Gemm g{XB, Wup_t, M, NUP, DM}; pg8::StaticOrder S; S.init(M, NUP, G, bx);
#if FUSED_CONV
        OPQ(); pg8::EpiUpConv E{RSTD, INP(13), INP(14), ACT, US, (LAS float*)(lds3 + XL_OFF)};
        pg8::gemm_phase<pg8::EpiUpConv, pg8::StaticOrder, CONV_ALIGN, true>(lds3, g, S, E);
#else
        pg8::EpiUp E{RSTD, U};
        pg8::gemm_phase<pg8::EpiUp, pg8::StaticOrder, true, true>(lds3, g, S, E);
#endif
    }
#endif
    xcd_barrier(xbar);

#if (!defined(ONLY) || ONLY == 8) && !FUSED_CONV
    _Pragma("unroll 1") for (int rep_ = 0; rep_ < REPS(8); ++rep_) {
        if (rep_ > 0) xcd_barrier(xbar);
        IDS();
        OPQ(); const float* w_conv = INP(13); const float* b_conv = INP(14);
        const int gt = bx * (NWAVES * 64) + tid, NTH = G * NWAVES * 64;
        for (int it = gt; it < 704 * 512; it += NTH) { const int r = it / 704, k = it - r * 704, t0 = r * 16, pn = k >> 4, j8 = (k & 15) * 8;
            const unsigned ug = 256 * pn + j8, c = 8 * k;
            float wg[3][8], wv[3][8], bg[8], bv[8];
#pragma unroll
            for (int tp = 0; tp < 3; ++tp)
#pragma unroll
                for (int q = 0; q < 2; ++q) { const f32x4 a = *(const f32x4*)(w_conv + tp * NUP + c + 4 * q), b = *(const f32x4*)(w_conv + tp * NUP + DFF + c + 4 * q);
#pragma unroll
                    for (int j = 0; j < 4; ++j) { wg[tp][4 * q + j] = a[j]; wv[tp][4 * q + j] = b[j]; } }
#pragma unroll
            for (int q = 0; q < 2; ++q) { const f32x4 a = *(const f32x4*)(b_conv + c + 4 * q), b = *(const f32x4*)(b_conv + DFF + c + 4 * q);
#pragma unroll
                for (int j = 0; j < 4; ++j) { bg[4 * q + j] = a[j]; bv[4 * q + j] = b[j]; } }
            float g2[8], g1[8], v2[8], v1[8];
            if ((t0 & (SEQ - 1)) == 0) {
#pragma unroll
                for (int j = 0; j < 8; ++j) { g2[j] = 0.f; g1[j] = 0.f; v2[j] = 0.f; v1[j] = 0.f; }
            } else {
                const v4u a2 = *(const v4u*)(U + (size_t)(t0 - 2) * NUP + ug), b2 = *(const v4u*)(U + (size_t)(t0 - 2) * NUP + ug + 128);
                const v4u a1 = *(const v4u*)(U + (size_t)(t0 - 1) * NUP + ug), b1 = *(const v4u*)(U + (size_t)(t0 - 1) * NUP + ug + 128);
#pragma unroll
                for (int q = 0; q < 4; ++q) { g2[2 * q] = pg8::bflo(a2[q]); g2[2 * q + 1] = pg8::bfhi(a2[q]); v2[2 * q] = pg8::bflo(b2[q]); v2[2 * q + 1] = pg8::bfhi(b2[q]);
                    g1[2 * q] = pg8::bflo(a1[q]); g1[2 * q + 1] = pg8::bfhi(a1[q]); v1[2 * q] = pg8::bflo(b1[q]); v1[2 * q + 1] = pg8::bfhi(b1[q]); }
            }
            for (int i4 = 0; i4 < 16; i4 += 4) {
                v4u a0[4], b0[4];
#pragma unroll
                for (int i = 0; i < 4; ++i) { const size_t t = (size_t)(t0 + i4 + i);
                    a0[i] = __builtin_nontemporal_load((const v4u*)(U + t * NUP + ug)); b0[i] = __builtin_nontemporal_load((const v4u*)(U + t * NUP + ug + 128)); }
#pragma unroll
                for (int i = 0; i < 4; ++i) { const size_t t = (size_t)(t0 + i4 + i);
                    float g0[8], v0[8], o[8];
#pragma unroll
                    for (int q = 0; q < 4; ++q) { g0[2 * q] = pg8::bflo(a0[i][q]); g0[2 * q + 1] = pg8::bfhi(a0[i][q]); v0[2 * q] = pg8::bflo(b0[i][q]); v0[2 * q + 1] = pg8::bfhi(b0[i][q]); }
#pragma unroll
                    for (int j = 0; j < 8; ++j) { const float gt_ = fmaf(wg[0][j], g2[j], fmaf(wg[1][j], g1[j], fmaf(wg[2][j], g0[j], bg[j])));
                        const float vl = fmaf(wv[0][j], v2[j], fmaf(wv[1][j], v1[j], fmaf(wv[2][j], v0[j], bv[j])));
                        o[j] = gt_ * pg8::sigm(gt_) * vl; g2[j] = g1[j]; g1[j] = g0[j]; v2[j] = v1[j]; v1[j] = v0[j]; }
                    v4u w; w.x = pk2(o[0], o[1]); w.y = pk2(o[2], o[3]); w.z = pk2(o[4], o[5]); w.w = pk2(o[6], o[7]);
                    *(v4u*)(ACT + t * DFF + c) = w; } }
        }
    }
#endif
    #if !FUSED_CONV
    xcd_barrier(xbar);
#endif

#if !defined(ONLY) || ONLY == 7
    _Pragma("unroll 1") for (int rep_ = 0; rep_ < REPS(7); ++rep_) {
        if (rep_ > 0) xcd_barrier(xbar);
        IDS();
        pg8::StaticOrder S; S.init(M, DM, G, bx);
#if FUSED_CONV
        {
            OPQ(); const float* w_conv = INP(13); const float* b_conv = INP(14); pg8::Unit u0;
            if (S.next(0, u0)) {
                for (int i = tid; i < 4 * DFF; i += NWAVES * 64) { const int gq = i / DFF, c = i - gq * DFF, Gi = 4 * u0.pm + gq; const bool first = (Gi & 31) == 0;
                    const float* up = US + (size_t)Gi * 4 * NUP;
                    float cv[2][2];
#pragma unroll
                    for (int bj = 0; bj < 2; ++bj) { const int uc = bj * DFF + c; const float u0v = first ? 0.f : up[uc], u1v = first ? 0.f : up[NUP + uc], u2v = up[2 * NUP + uc], u3v = up[3 * NUP + uc];
                        const float w0 = w_conv[uc], w1 = w_conv[NUP + uc], w2 = w_conv[2 * NUP + uc], bb = b_conv[uc];
                        cv[bj][0] = fmaf(w0, u0v, fmaf(w1, u1v, fmaf(w2, u2v, bb))); cv[bj][1] = fmaf(w0, u1v, fmaf(w1, u2v, fmaf(w2, u3v, bb))); }
#pragma unroll
                    for (int t = 0; t < 2; ++t) { const float gte = cv[0][t]; ACT[(size_t)(64 * Gi + t) * DFF + c] = (bf16)f2bf(gte * pg8::sigm(gte) * cv[1][t]); } }
            }
            asm volatile("s_waitcnt vmcnt(0)" ::: "memory"); __threadfence(); __syncthreads();
        }
#endif
        pg8::Gemm g{ACT, Wdn_t, M, DM, DFF};
        pg8::EpiFinal E{XB, out};
        pg8::gemm_phase<pg8::EpiFinal, pg8::StaticOrder, true, true>(lds3, g, S, E);
    }
#endif
}

extern "C" void kernel_launch(void* const* d_in, const int* in_sizes, int n_in, void* d_out, int out_size, void* d_ws, size_t ws_size, hipStream_t stream) {
    static int grid = 0;
    if (grid == 0) {
        if (n_in != 16 || in_sizes[0] != M * DM || out_size != M * DM || ws_size < WS_END) { fprintf(stderr, "kernel_launch: unexpected shapes (n_in %d, in0 %d, out %d, ws %zu)\n", n_in, n_in > 0 ? in_sizes[0] : -1, out_size, ws_size); grid = -1; return; }
        int dev = 0, cus = 0, per_cu = 0;
        (void)hipGetDevice(&dev); (void)hipDeviceGetAttribute(&cus, hipDeviceAttributeMultiprocessorCount, dev);
        if (hipFuncSetAttribute((const void*)fwd_mega, hipFuncAttributeMaxDynamicSharedMemorySize, LDS_BYTES) != hipSuccess) { fprintf(stderr, "kernel_launch: hipFuncSetAttribute failed\n"); grid = -1; return; }
        if (hipOccupancyMaxActiveBlocksPerMultiprocessor(&per_cu, (const void*)fwd_mega, NWAVES * 64, LDS_BYTES) != hipSuccess || per_cu < 1) { fprintf(stderr, "kernel_launch: occupancy query says %d\n", per_cu); per_cu = 1; }
        (void)hipGetLastError();
        grid = cus * 1;
        if (grid != 256) fprintf(stderr, "kernel_launch: %d CUs; the single-unit GEMM phases assume 256\n", grid);
    }
    if (grid < 0) return;
    if (hipMemsetAsync(d_ws, 0, 128 * 1024, stream) != hipSuccess) { fprintf(stderr, "kernel_launch: hipMemsetAsync failed\n"); return; }
    Args a{};
    for (int i = 0; i < 16; ++i) a.in[i] = (const float*)d_in[i];
    a.out = (float*)d_out; a.ws = (unsigned char*)d_ws;
    void* kargs[] = {&a};
    hipError_t e = hipLaunchCooperativeKernel((const void*)fwd_mega, dim3(grid), dim3(NWAVES * 64), kargs, LDS_BYTES, stream);
    if (e != hipSuccess) fprintf(stderr, "cooperative launch failed: %s (grid %d)\n", hipGetErrorString(e), grid);
}
```

```cpp
#include <hip/hip_runtime.h>
#include <hip/hip_cooperative_groups.h>
#include <cstdio>
#include <cstdint>
namespace cg = cooperative_groups;
namespace pg8 {
#define PG8_LAS __attribute__((address_space(3)))
typedef unsigned short bf16_t;
typedef short bf16x8 __attribute__((ext_vector_type(8)));
typedef float f32x4 __attribute__((ext_vector_type(4)));
typedef unsigned u32x4 __attribute__((ext_vector_type(4)));
constexpr int BM = 256, BK = 64, HALF = 128, HTB = HALF * BK * 2  , STAGE_BYTES = 8 * HTB, NXCD = 8, WGM = 4;

__host__ __device__ __forceinline__ int lds_byte(int r, int c) { const int st = (r >> 4) * 2 + (c >> 5), rr = r & 15, cc = c & 31, ob = rr * 64 + cc * 2; return st * 1024 + (ob ^ (((ob >> 9) & 1) << 5)); }
__host__ __device__ __forceinline__ void stage_rc(int b, int& R, int& C) { const int st = b / 1024, sb = b % 1024, swz = sb ^ (((sb >> 9) & 1) << 5); R = (st >> 1) * 16 + swz / 64; C = (st & 1) * 32 + (swz % 64) / 2; }
__host__ __device__ __forceinline__ int perm32(int rho) { const int n = rho >> 4, i = rho & 15; return 8 * (i >> 2) + 4 * n + (i & 3); }

struct Unit { int pm, pn; };
struct Gemm { const bf16_t* A; const bf16_t* Bt; int M, N, K; };

struct StaticOrder {
    int nM, nN, nwg, G, c;
    __host__ __device__ void init(int M, int N, int G_, int c_) { nM = M / BM; nN = N / BM; nwg = nM * nN; G = G_; c = c_; }
    __host__ __device__ bool next(int i, Unit& u) const {
        const long L = (long)i * G + c; if (L >= nwg) return false;
        int wgid = (int)L; { const int q = nwg / NXCD, r = nwg % NXCD, xcd = wgid % NXCD, off = wgid / NXCD; wgid = (xcd < r ? xcd * (q + 1) : r * (q + 1) + (xcd - r) * q) + off; }
        const int nig = WGM * nN, gid = wgid / nig, fm = gid * WGM, gsz = (nM - fm) < WGM ? (nM - fm) : WGM;
        u.pm = fm + ((wgid % nig) % gsz); u.pn = (wgid % nig) / gsz; return true;
    }
    __device__ __forceinline__ void a_ready(const Unit&) const {}
    __device__ __forceinline__ void done(const Unit&) const {}
};

__device__ __forceinline__ unsigned cvt_pk_bf16(float lo, float hi) { unsigned r; asm volatile("v_cvt_pk_bf16_f32 %0, %1, %2" : "=v"(r) : "v"(lo), "v"(hi)); return r; }
typedef unsigned u32x4e __attribute__((ext_vector_type(4)));
constexpr float LOG2E = 1.4426950408889634f;
constexpr float EPSN = 1e-6f;
constexpr float QSCALE = 0.08838834764831845f * 1.4426950408889634f;
__device__ __forceinline__ float sigm(float x) { return __builtin_amdgcn_rcpf(1.f + __builtin_amdgcn_exp2f(-x * LOG2E)); }
__device__ __forceinline__ float bflo(unsigned w) { return __uint_as_float(w << 16); }
__device__ __forceinline__ float bfhi(unsigned w) { return __uint_as_float(w & 0xffff0000u); }
__device__ __forceinline__ u32x4e pack8f(const f32x4 a, const f32x4 b) { u32x4e w; w.x = cvt_pk_bf16(a[0], a[1]); w.y = cvt_pk_bf16(a[2], a[3]); w.z = cvt_pk_bf16(b[0], b[1]); w.w = cvt_pk_bf16(b[2], b[3]); return w; }
#define EPI_LDSBAR() do { asm volatile("s_waitcnt lgkmcnt(0)" ::: "memory"); __builtin_amdgcn_s_barrier(); asm volatile("" ::: "memory"); } while (0)

struct EpiProj {
    static constexpr bool PERM = true, AFTER_DRAIN = false, HAS_MID = false;
    bf16_t* QKV; bf16_t* GATES; const float* gains; PG8_LAS float* xl;
    __device__ __forceinline__ void operator()(f32x4 (&acc)[2][2][4][2], const Unit& u, int wr, int wc, int fr, int fq) const {
        const int colt = u.pn * BM, row0 = u.pm * BM + wr * 64 + fr, seg = colt >> 10;
        const bool norm = (seg == 0) | (seg == 1) | (seg == 3) | (seg == 4);
        if (!norm) {
            bf16_t* base; int ldc, col0;
            if (colt >= 6144) { base = GATES; ldc = 4096; col0 = colt - 6144; } else { base = QKV; ldc = 6144; col0 = colt; }
            col0 += wc * 32 + 8 * fq;
#pragma unroll
            for (int ai = 0; ai < 2; ++ai)
#pragma unroll
                for (int m = 0; m < 4; ++m) { bf16_t* rowp = base + (size_t)(row0 + ai * HALF + m * 16) * ldc + col0;
#pragma unroll
                    for (int bj = 0; bj < 2; ++bj) *(u32x4e*)(rowp + bj * HALF) = pack8f(acc[ai][bj][m][0], acc[ai][bj][m][1]); }
        } else {
#pragma unroll
            for (int ai = 0; ai < 2; ++ai)
#pragma unroll
                for (int m = 0; m < 4; ++m)
#pragma unroll
                    for (int bj = 0; bj < 2; ++bj) { const f32x4 a = acc[ai][bj][m][0], b = acc[ai][bj][m][1];
                        float s = (a[0] * a[0] + a[1] * a[1]) + (a[2] * a[2] + a[3] * a[3]) + (b[0] * b[0] + b[1] * b[1]) + (b[2] * b[2] + b[3] * b[3]);
                        s += __shfl_xor(s, 16); s += __shfl_xor(s, 32);
                        if (fq == 0) xl[((ai * HALF + wr * 64 + m * 16 + fr) * 2 + bj) * 4 + wc] = s; }
            EPI_LDSBAR();
            const float* gp = gains + (seg - (seg >= 3 ? 1 : 0)) * 1024 + (colt & 1023) + wc * 32 + 8 * fq;
            const float qs = (seg == 0 || seg == 3) ? QSCALE : 1.f;
            f32x4 g[2][2];
#pragma unroll
            for (int bj = 0; bj < 2; ++bj)
#pragma unroll
                for (int n = 0; n < 2; ++n) g[bj][n] = *(const f32x4*)(gp + bj * HALF + 4 * n) * qs;
            bf16_t* base = QKV + colt + wc * 32 + 8 * fq;
#pragma unroll
            for (int ai = 0; ai < 2; ++ai)
#pragma unroll
                for (int m = 0; m < 4; ++m) { bf16_t* rowp = base + (size_t)(row0 + ai * HALF + m * 16) * 6144;
#pragma unroll
                    for (int bj = 0; bj < 2; ++bj) { const f32x4 p = *(const PG8_LAS f32x4*)(xl + ((ai * HALF + wr * 64 + m * 16 + fr) * 2 + bj) * 4);
                        const float rs = __builtin_amdgcn_rsqf(((p[0] + p[1]) + (p[2] + p[3])) * (1.f / 128.f) + EPSN);
                        *(u32x4e*)(rowp + bj * HALF) = pack8f(acc[ai][bj][m][0] * rs * g[bj][0], acc[ai][bj][m][1] * rs * g[bj][1]); } }
        }
    }
};

__device__ __forceinline__ void gate8(const bf16_t* p, f32x4& s0, f32x4& s1) {
    const u32x4e w = *(const u32x4e*)p;
    s0[0] = sigm(bflo(w.x)); s0[1] = sigm(bfhi(w.x)); s0[2] = sigm(bflo(w.y)); s0[3] = sigm(bfhi(w.y));
    s1[0] = sigm(bflo(w.z)); s1[1] = sigm(bfhi(w.z)); s1[2] = sigm(bflo(w.w)); s1[3] = sigm(bfhi(w.w));
}
struct EpiBr {
    static constexpr bool PERM = true, AFTER_DRAIN = false, HAS_MID = true;
    const bf16_t* G; bf16_t* MG;
    __device__ __forceinline__ void mid(f32x4 (&acc)[2][2][4][2], const Unit& u, int wr, int wc, int fr_in, int fq_in) const {
        (void)fr_in; (void)fq_in; int ln_ = (int)(threadIdx.x & 63u); asm volatile("" : "+v"(ln_)); const int fr = ln_ & 15, fq = ln_ >> 4;
        const int row0 = u.pm * BM + wr * 64 + fr, col0 = u.pn * BM + wc * 32 + 8 * fq;
#define RAT(x, y) ((1.f + __builtin_amdgcn_exp2f(-(y) * LOG2E)) * __builtin_amdgcn_rcpf(1.f + __builtin_amdgcn_exp2f(-(x) * LOG2E)))
#pragma unroll
        for (int ai = 0; ai < 2; ++ai) {
            u32x4e ga[4][2], gb[4][2];
#pragma unroll
            for (int m = 0; m < 4; ++m)
#pragma unroll
                for (int bj = 0; bj < 2; ++bj) { const bf16_t* gp = G + (size_t)(row0 + ai * HALF + m * 16) * 4096 + col0 + bj * HALF; ga[m][bj] = *(const u32x4e*)gp; gb[m][bj] = *(const u32x4e*)(gp + 2048); }
#pragma unroll
            for (int m = 0; m < 4; ++m)
#pragma unroll
                for (int bj = 0; bj < 2; ++bj) { const u32x4e a = ga[m][bj], b = gb[m][bj]; f32x4 r0, r1;
                    r0[0] = RAT(bflo(a.x), bflo(b.x)); r0[1] = RAT(bfhi(a.x), bfhi(b.x)); r0[2] = RAT(bflo(a.y), bflo(b.y)); r0[3] = RAT(bfhi(a.y), bfhi(b.y));
                    r1[0] = RAT(bflo(a.z), bflo(b.z)); r1[1] = RAT(bfhi(a.z), bfhi(b.z)); r1[2] = RAT(bflo(a.w), bflo(b.w)); r1[3] = RAT(bfhi(a.w), bfhi(b.w));
                    acc[ai][bj][m][0] = acc[ai][bj][m][0] * r0; acc[ai][bj][m][1] = acc[ai][bj][m][1] * r1; }
            asm volatile("" ::: "memory"); __builtin_amdgcn_sched_barrier(0); }
#undef RAT
    }
    __device__ __forceinline__ void operator()(f32x4 (&acc)[2][2][4][2], const Unit& u, int wr, int wc, int fr, int fq) const {
        const int row0 = u.pm * BM + wr * 64 + fr, col0 = u.pn * BM + wc * 32 + 8 * fq;
#pragma unroll
        for (int ai = 0; ai < 2; ++ai)
#pragma unroll
            for (int m = 0; m < 4; ++m) { const size_t row = (size_t)(row0 + ai * HALF + m * 16);
#pragma unroll
                for (int bj = 0; bj < 2; ++bj) { const int col = col0 + bj * HALF; f32x4 s0, s1; gate8(G + row * 4096 + 2048 + col, s0, s1);
                    *(u32x4e*)(MG + row * 2048 + col) = pack8f(acc[ai][bj][m][0] * s0, acc[ai][bj][m][1] * s1); } }
    }
};
struct EpiOut {
    static constexpr bool PERM = true, AFTER_DRAIN = true, HAS_MID = false;
    const float* X; bf16_t* XB; float* SSQ;
    __device__ __forceinline__ void fused(f32x4 (&acc)[2][2][4][2], const Unit& u, int wr, int wc, int fr, int fq, PG8_LAS unsigned char* lds, int wid, int lane) const {
        PG8_LAS float* P = (PG8_LAS float*)lds;
        const int row0 = u.pm * BM + wr * 64 + fr, col0 = u.pn * BM + wc * 32 + 8 * fq;
#pragma unroll
        for (int ai = 0; ai < 2; ++ai)
#pragma unroll
            for (int m = 0; m < 4; ++m) { const size_t row = (size_t)(row0 + ai * HALF + m * 16); float ss = 0.f;
#pragma unroll
                for (int bj = 0; bj < 2; ++bj) { const size_t off = row * 2048 + col0 + bj * HALF;
                    const f32x4 v0 = acc[ai][bj][m][0] + __builtin_nontemporal_load((const f32x4*)(X + off)), v1 = acc[ai][bj][m][1] + __builtin_nontemporal_load((const f32x4*)(X + off + 4));
                    *(u32x4e*)(XB + off) = pack8f(v0, v1);
                    ss += (v0[0] * v0[0] + v0[1] * v0[1]) + (v0[2] * v0[2] + v0[3] * v0[3]) + (v1[0] * v1[0] + v1[1] * v1[1]) + (v1[2] * v1[2] + v1[3] * v1[3]); }
                ss += __shfl_xor(ss, 16); ss += __shfl_xor(ss, 32);
                if (fq == 0) P[(ai * HALF + wr * 64 + m * 16 + fr) * 4 + wc] = ss; }
        EPI_LDSBAR();
        const int tid = wid * 64 + lane;
        if (tid < 256) { const f32x4 p = *(const PG8_LAS f32x4*)(P + tid * 4); SSQ[(size_t)(u.pm * BM + tid) * 8 + u.pn] = (p[0] + p[1]) + (p[2] + p[3]); }
    }
};
#ifndef CONV_LDSW
#define CONV_LDSW 0
#endif
__device__ __forceinline__ float ror1f(float v) { return __builtin_bit_cast(float, __builtin_amdgcn_update_dpp(0, __builtin_bit_cast(int, v), 0x121, 0xf, 0xf, false)); }
__device__ __forceinline__ float ror2f(float v) { return __builtin_bit_cast(float, __builtin_amdgcn_update_dpp(0, __builtin_bit_cast(int, v), 0x122, 0xf, 0xf, false)); }
struct EpiUpConv {
    static constexpr bool PERM = true, AFTER_DRAIN = false, HAS_MID = false;
    const float* RSTD; const float* wconv; const float* bconv; bf16_t* ACT; float* US; PG8_LAS float* xl;
    __device__ __forceinline__ void operator()(f32x4 (&acc)[2][2][4][2], const Unit& u, int wr, int wc, int fr_in, int fq_in) const {
        typedef unsigned u32x2e __attribute__((ext_vector_type(2)));
        PG8_LAS float* wl = xl + (unsigned)(wr * 4 + wc) * 256u;
        { const unsigned L_ = threadIdx.x & 63u, ucol_ = (L_ >> 5) * 5632u + (unsigned)u.pn * 128u + (unsigned)wc * 32u + (L_ & 31u);
          const float t0_ = wconv[ucol_], t1_ = wconv[11264u + ucol_], t2_ = wconv[22528u + ucol_], t3_ = bconv[ucol_];
          wl[L_] = t0_; wl[64u + L_] = t1_; wl[128u + L_] = t2_; wl[192u + L_] = t3_;
          asm volatile("s_waitcnt lgkmcnt(0)" ::: "memory"); }
        (void)fr_in; (void)fq_in; int ln_ = (int)(threadIdx.x & 63u); asm volatile("" : "+v"(ln_)); const int fr = ln_ & 15, fq = ln_ >> 4;
        const unsigned cw = (unsigned)(u.pn * 128 + wc * 32 + 8 * fq), row0 = (unsigned)(u.pm * BM + wr * 64 + fr);
        const bool lo = fr < 2, hi14 = fr >= 14, f1 = fr >= 1, f2 = fr >= 2;
#pragma unroll
        for (int ai = 0; ai < 2; ++ai) { const unsigned G = (unsigned)(4 * u.pm + 2 * ai + wr);
            float rs[4];
#pragma unroll
            for (int m = 0; m < 4; ++m) rs[m] = RSTD[row0 + ai * HALF + m * 16];
            const unsigned aoff = (row0 + ai * HALF) * 5632u + cw;
            const unsigned us_lo = (G * 4 + 2 + (fr & 1)) * 11264u; const bool sthi = hi14 && (G + 1 < 128);
#pragma unroll
            for (int n = 0; n < 2; ++n) {
#pragma unroll
                for (int j = 0; j < 4; ++j) { unsigned col = cw + 4 * n + j; asm volatile("" : "+v"(col));
#pragma unroll
                    for (int bj = 0; bj < 2; ++bj) { const unsigned ucol = bj * 5632 + col;
                        const unsigned lc = (unsigned)bj * 32u + (col - (unsigned)u.pn * 128u - (unsigned)wc * 32u);
                        const float w0 = wl[lc], w1 = wl[64u + lc], w2 = wl[128u + lc], bb = wl[192u + lc];
                        float pa1 = 0.f, pa2 = 0.f;
#pragma unroll
                        for (int m = 0; m < 4; ++m) { const float uu = acc[ai][bj][m][n][j] * rs[m];
                            if (m == 0) { if (lo) US[us_lo + ucol] = uu; }
                            if (m == 3) { if (sthi) US[us_lo + 22528u + ucol] = uu; }
                            const float a1 = ror1f(uu), a2 = ror2f(uu);
                            const float p1 = f1 ? a1 : pa1, p2 = f2 ? a2 : pa2;
                            acc[ai][bj][m][n][j] = fmaf(w0, p2, fmaf(w1, p1, fmaf(w2, uu, bb)));
                            pa1 = a1; pa2 = a2; }
                        }
#pragma unroll
                    for (int m = 0; m < 4; ++m) { const float g0 = acc[ai][0][m][n][j]; acc[ai][0][m][n][j] = g0 * sigm(g0) * acc[ai][1][m][n][j]; }
                    asm volatile("" ::: "memory"); }
#pragma unroll
                for (int m = 0; m < 4; ++m) { u32x2e w; w.x = cvt_pk_bf16(acc[ai][0][m][n][0], acc[ai][0][m][n][1]); w.y = cvt_pk_bf16(acc[ai][0][m][n][2], acc[ai][0][m][n][3]);
                    if (!(m == 0 && lo)) *(u32x2e*)(ACT + (aoff + (unsigned)(m * 16 * 5632 + 4 * n))) = w; }
                asm volatile("" ::: "memory"); __builtin_amdgcn_sched_barrier(0); } }
    }
};
struct EpiUp {
    static constexpr bool PERM = true, AFTER_DRAIN = false, HAS_MID = false;
    const float* RSTD; bf16_t* U;
    __device__ __forceinline__ void operator()(f32x4 (&acc)[2][2][4][2], const Unit& u, int wr, int wc, int fr, int fq) const {
        const int row0 = u.pm * BM + wr * 64 + fr, col0 = u.pn * BM + wc * 32 + 8 * fq;
#pragma unroll
        for (int ai = 0; ai < 2; ++ai)
#pragma unroll
            for (int m = 0; m < 4; ++m) { const int row = row0 + ai * HALF + m * 16; const float rs = RSTD[row]; bf16_t* rowp = U + (size_t)row * 11264 + col0;
#pragma unroll
                for (int bj = 0; bj < 2; ++bj) *(u32x4e*)(rowp + bj * HALF) = pack8f(acc[ai][bj][m][0] * rs, acc[ai][bj][m][1] * rs); }
    }
};
struct EpiFinal {
    static constexpr bool PERM = true, AFTER_DRAIN = false, HAS_MID = false;
    const bf16_t* XB; float* OUT;
    __device__ __forceinline__ void operator()(f32x4 (&acc)[2][2][4][2], const Unit& u, int wr, int wc, int fr, int fq) const {
        const int row0 = u.pm * BM + wr * 64 + fr, col0 = u.pn * BM + wc * 32 + 8 * fq;
#pragma unroll
        for (int ai = 0; ai < 2; ++ai)
#pragma unroll
            for (int m = 0; m < 4; ++m)
#pragma unroll
                for (int bj = 0; bj < 2; ++bj) { const size_t off = (size_t)(row0 + ai * HALF + m * 16) * 2048 + col0 + bj * HALF;
                    const u32x4e w = __builtin_nontemporal_load((const u32x4e*)(XB + off));
                    const f32x4 a = {bflo(w.x), bfhi(w.x), bflo(w.y), bfhi(w.y)}, b = {bflo(w.z), bfhi(w.z), bflo(w.w), bfhi(w.w)};
                    __builtin_nontemporal_store(a + acc[ai][bj][m][0], (f32x4*)(OUT + off)); __builtin_nontemporal_store(b + acc[ai][bj][m][1], (f32x4*)(OUT + off + 4)); }
    }
};

template <class Epi, class Sched, bool ALIGN_EPI = false, bool SP2 = false>
__device__ __forceinline__ void gemm_phase(PG8_LAS unsigned char* lds, const Gemm g, const Sched& S, const Epi& E) {
    int tid_o = threadIdx.x; asm volatile("" : "+v"(tid_o));
    const int tid = tid_o, wid = __builtin_amdgcn_readfirstlane(tid >> 6), lane = tid & 63, wr = wid >> 2, wc = wid & 3, fr = lane & 15, fq = lane >> 4;
    const int K = g.K, nt = K / BK;
    unsigned voffA[1], voffB[1];
#pragma unroll
    for (int i = 0; i < 1; ++i) { int R, C; stage_rc(tid * 16 + i * 8192, R, C); const int Rb = Epi::PERM ? ((R & ~31) + perm32(R & 31)) : R;
        voffA[i] = (unsigned)(R * K + C) * 2u; voffB[i] = (unsigned)(Rb * K + C) * 2u; }
    const size_t vstep = (size_t)K * 128;
    const size_t kstep = (size_t)(BK * 2);
    const size_t hstep = (size_t)HALF * K * 2;
    const size_t tstep = 2 * hstep;
    const unsigned ldsw = (unsigned)wid * 1024u;
    const int aoff = lds_byte(wr * 64 + fr, fq * 8), boff = lds_byte(wc * 32 + fr, fq * 8);
#define PG8_SA(b, h) (((b) * 2 + (h)) * HTB)
#define PG8_SB(b, h) ((4 + (b) * 2 + (h)) * HTB)
#define PG8_STAGE(bufoff, gbase, voff) do { _Pragma("unroll") for (int _i = 0; _i < 2; ++_i) \
        __builtin_amdgcn_global_load_lds((const unsigned*)((const char*)(gbase) + (size_t)_i * vstep + (voff)[0]), (PG8_LAS unsigned*)(lds + (bufoff) + ldsw + _i * 8192), 16, 0, 0); } while (0)
#define PG8_LDA(dst, b, h) do { _Pragma("unroll") for (int m = 0; m < 4; ++m) _Pragma("unroll") for (int k = 0; k < 2; ++k) dst[m][k] = *(const PG8_LAS bf16x8*)(lds + PG8_SA(b, h) + aoff + m * 2048 + k * 1024); } while (0)
#define PG8_LDB(dst, b, h) do { _Pragma("unroll") for (int n = 0; n < 2; ++n) _Pragma("unroll") for (int k = 0; k < 2; ++k) dst[n][k] = *(const PG8_LAS bf16x8*)(lds + PG8_SB(b, h) + boff + n * 2048 + k * 1024); } while (0)
#define PG8_MMA(ai, bj, At, Bt) do { __builtin_amdgcn_s_setprio(1); _Pragma("unroll") for (int m = 0; m < 4; ++m) _Pragma("unroll") for (int n = 0; n < 2; ++n) _Pragma("unroll") for (int k = 0; k < 2; ++k) \
        acc[ai][bj][m][n] = __builtin_amdgcn_mfma_f32_16x16x32_bf16(Bt[n][k], At[m][k], acc[ai][bj][m][n], 0, 0, 0); __builtin_amdgcn_s_setprio(0); } while (0)
#define PG8_WAIT_V(n) asm volatile("s_waitcnt vmcnt(" #n ")" ::: "memory")
#define PG8_WAIT_L(n) asm volatile("s_waitcnt lgkmcnt(" #n ")" ::: "memory")
#define PG8_BAR __builtin_amdgcn_s_barrier()
#define PG8_SCHED __builtin_amdgcn_sched_barrier(0)
    Unit cur, nxt; int ui = 0;
    if (!S.next(0, cur)) return;
    f32x4 acc[2][2][4][2];
#pragma unroll
    for (int a = 0; a < 2; ++a)
#pragma unroll
        for (int b = 0; b < 2; ++b)
#pragma unroll
            for (int m = 0; m < 4; ++m)
#pragma unroll
                for (int n = 0; n < 2; ++n) acc[a][b][m][n] = (f32x4){0.f, 0.f, 0.f, 0.f};
    bf16x8 At[4][2], B0[2][2], B1[2][2];
    const char* cA = (const char*)g.A + (size_t)cur.pm * tstep; const char* cB = (const char*)g.Bt + (size_t)cur.pn * tstep;
    S.a_ready(cur);
    if constexpr (SP2) {
        PG8_STAGE(PG8_SB(0, 0), cB, voffB); PG8_STAGE(PG8_SB(0, 1), cB + hstep, voffB); PG8_STAGE(PG8_SA(0, 0), cA, voffA); PG8_STAGE(PG8_SA(0, 1), cA + hstep, voffA);
        if (wr == 1) PG8_BAR;
        PG8_WAIT_V(2); PG8_BAR;
        PG8_STAGE(PG8_SB(1, 0), cB + kstep, voffB); PG8_STAGE(PG8_SA(1, 0), cA + kstep, voffA); PG8_STAGE(PG8_SB(1, 1), cB + hstep + kstep, voffB);
        PG8_WAIT_V(6); PG8_BAR;
    } else {
        PG8_STAGE(PG8_SB(0, 0), cB, voffB); PG8_STAGE(PG8_SA(0, 0), cA, voffA); PG8_STAGE(PG8_SB(0, 1), cB + hstep, voffB); PG8_STAGE(PG8_SA(0, 1), cA + hstep, voffA);
        if (wr == 1) PG8_BAR;
        PG8_WAIT_V(4); PG8_BAR;
        PG8_STAGE(PG8_SB(1, 0), cB + kstep, voffB); PG8_STAGE(PG8_SA(1, 0), cA + kstep, voffA); PG8_STAGE(PG8_SB(1, 1), cB + hstep + kstep, voffB);
        PG8_WAIT_V(6); PG8_BAR;
    }
    for (;;) {
        const bool has_next = S.next(ui + 1, nxt);
        const char* nA = has_next ? (const char*)g.A + (size_t)nxt.pm * tstep : cA; const char* nB = has_next ? (const char*)g.Bt + (size_t)nxt.pn * tstep : cB;
        for (int t = 0; t < nt; t += 2) {
            if constexpr (Epi::HAS_MID) { if (t == (nt >> 1)) E.mid(acc, cur, wr, wc, fr, fq); }
            const bool last = (t == nt - 2);
            const char* a1 = cA + (size_t)(t + 1) * kstep;
            const char* a2 = last ? nA : cA + (size_t)(t + 2) * kstep; const char* b2 = last ? nB : cB + (size_t)(t + 2) * kstep;
            const char* a3 = a2 + kstep; const char* b3 = b2 + kstep;
            if (last && has_next) S.a_ready(nxt);
            if constexpr (SP2) {
            PG8_LDB(B0, 0, 0); PG8_LDB(B1, 0, 1); PG8_SCHED; PG8_LDA(At, 0, 0); PG8_STAGE(PG8_SA(1, 1), a1 + hstep, voffA);
            PG8_WAIT_V(8); PG8_WAIT_L(0); PG8_BAR; PG8_MMA(0, 0, At, B0); PG8_MMA(0, 1, At, B1); PG8_BAR; PG8_SCHED;
            PG8_LDA(At, 0, 1); PG8_STAGE(PG8_SB(0, 0), b2, voffB); PG8_STAGE(PG8_SB(0, 1), b2 + hstep, voffB); PG8_STAGE(PG8_SA(0, 0), a2, voffA);
            PG8_WAIT_V(8); PG8_WAIT_L(0); PG8_BAR; PG8_MMA(1, 0, At, B0); PG8_MMA(1, 1, At, B1); PG8_BAR; PG8_SCHED;
            PG8_LDB(B0, 1, 0); PG8_LDB(B1, 1, 1); PG8_SCHED; PG8_LDA(At, 1, 0); PG8_STAGE(PG8_SA(0, 1), a2 + hstep, voffA);
            PG8_WAIT_V(8); PG8_WAIT_L(0); PG8_BAR; PG8_MMA(0, 0, At, B0); PG8_MMA(0, 1, At, B1); PG8_BAR; PG8_SCHED;
            PG8_LDA(At, 1, 1); PG8_STAGE(PG8_SB(1, 0), b3, voffB); PG8_STAGE(PG8_SB(1, 1), b3 + hstep, voffB); PG8_STAGE(PG8_SA(1, 0), a3, voffA);
            PG8_WAIT_V(8); PG8_WAIT_L(0); PG8_BAR; PG8_MMA(1, 0, At, B0); PG8_MMA(1, 1, At, B1); PG8_BAR; PG8_SCHED;
            } else {
            PG8_LDB(B0, 0, 0); PG8_SCHED; PG8_LDA(At, 0, 0); PG8_STAGE(PG8_SA(1, 1), a1 + hstep, voffA);
            PG8_WAIT_L(8); PG8_BAR; PG8_WAIT_L(0); PG8_MMA(0, 0, At, B0); PG8_BAR; PG8_SCHED;
            PG8_LDB(B1, 0, 1); PG8_STAGE(PG8_SB(0, 0), b2, voffB);
            PG8_BAR; PG8_WAIT_L(0); PG8_MMA(0, 1, At, B1); PG8_BAR;
            PG8_LDA(At, 0, 1); PG8_STAGE(PG8_SA(0, 0), a2, voffA);
            PG8_BAR; PG8_WAIT_L(0); PG8_MMA(1, 0, At, B0); PG8_BAR; PG8_SCHED;
            PG8_STAGE(PG8_SB(0, 1), b2 + hstep, voffB);
            PG8_WAIT_V(6); PG8_BAR; PG8_MMA(1, 1, At, B1); PG8_BAR;
            PG8_LDB(B0, 1, 0); PG8_SCHED; PG8_LDA(At, 1, 0); PG8_STAGE(PG8_SA(0, 1), a2 + hstep, voffA);
            PG8_WAIT_L(8); PG8_BAR; PG8_WAIT_L(0); PG8_MMA(0, 0, At, B0); PG8_BAR; PG8_SCHED;
            PG8_LDB(B1, 1, 1); PG8_STAGE(PG8_SB(1, 0), b3, voffB);
            PG8_BAR; PG8_WAIT_L(0); PG8_MMA(0, 1, At, B1); PG8_BAR;
            PG8_LDA(At, 1, 1); PG8_STAGE(PG8_SA(1, 0), a3, voffA);
            PG8_BAR; PG8_WAIT_L(0); PG8_MMA(1, 0, At, B0); PG8_BAR; PG8_SCHED;
            PG8_STAGE(PG8_SB(1, 1), b3 + hstep, voffB);
            PG8_WAIT_V(6); PG8_BAR; PG8_MMA(1, 1, At, B1); PG8_BAR;
            }
        }
        if constexpr (ALIGN_EPI) { if (wr == 0) PG8_BAR; }
        if constexpr (!Epi::AFTER_DRAIN) { E(acc, cur, wr, wc, fr, fq); S.done(cur); }
        if (!has_next) break;
#pragma unroll
        for (int a = 0; a < 2; ++a)
#pragma unroll
            for (int b = 0; b < 2; ++b)
#pragma unroll
                for (int m = 0; m < 4; ++m)
#pragma unroll
                    for (int n = 0; n < 2; ++n) acc[a][b][m][n] = (f32x4){0.f, 0.f, 0.f, 0.f};
        cur = nxt; cA = nA; cB = nB; ++ui;
        if constexpr (ALIGN_EPI) { if (wr == 1) PG8_BAR; }
    }
    PG8_WAIT_V(0);
    if constexpr (!ALIGN_EPI) { if (wr == 0) PG8_BAR; }
    PG8_BAR;
    if constexpr (Epi::AFTER_DRAIN) { E.fused(acc, cur, wr, wc, fr, fq, lds, wid, lane); S.done(cur); }
#undef PG8_SA
#undef PG8_SB
#undef PG8_STAGE
#undef PG8_LDA
#undef PG8_LDB
#undef PG8_MMA
#undef PG8_WAIT_V
#undef PG8_WAIT_L
#undef PG8_BAR
#undef PG8_SCHED
}
}

namespace att {
typedef unsigned short bf16;
constexpr int D = 128, NW = 8, QBLK = 32, KVBLK = 64, QB = NW * QBLK;
constexpr int SHM_V = KVBLK * D * 2, SHM_K = KVBLK * D * 2;
constexpr int LDS_WS = 2 * SHM_V + 2 * SHM_K, LDS_KB = LDS_WS + NW * 64 * 4, LDS_SLOT = LDS_KB + 2 * 64 * 4, LDS_Q = LDS_SLOT + 256, LDS_END = LDS_Q + NW * 8192;
constexpr float SCALE = 1.f, THR = 8.f;
typedef short bf16x8 __attribute__((ext_vector_type(8)));
typedef short s16x4 __attribute__((ext_vector_type(4)));
typedef float f32x16 __attribute__((ext_vector_type(16)));
typedef float f32x4 __attribute__((ext_vector_type(4)));
typedef unsigned u32x4 __attribute__((ext_vector_type(4)));
template <class A, class Bt> struct same_t { static constexpr bool v = false; };
template <class A> struct same_t<A, A> { static constexpr bool v = true; };

#define KSWZ(row, colB) ((row) * 256 + ((colB) ^ (((row) & 7) << 4)))
#define SBAR() __builtin_amdgcn_sched_barrier(0)
__device__ __forceinline__ int v_st(int k, int c) { const int kk = (k & ~0xC) | ((k & 4) << 1) | ((k & 8) >> 1); return ((kk >> 3) * 4 + (c >> 5)) * 512 + ((kk & 7) * 32 + (c & 31)) * 2; }
__device__ __forceinline__ int v_rd_base(int lane) { return ((lane & 3) << 3) | (((lane >> 2) & 3) << 6) | (((lane >> 4) & 1) << 5) | (((lane >> 5) & 1) << 8); }
constexpr int v_rd_off(int d0, int ks, int half) { return d0 * 512 + ks * 4096 + half * 2048; }
__device__ __forceinline__ int crow(int r, int hi) { return (r & 3) + 8 * (r >> 2) + 4 * hi; }
__device__ __forceinline__ unsigned cvtpk(float lo, float hi) {
    unsigned r; asm volatile("v_cvt_pk_bf16_f32 %0, %1, %2" : "=v"(r) : "v"(lo), "v"(hi)); return r;
}
__device__ __forceinline__ bf16x8 pack8(f32x4 a, f32x4 b) {
    u32x4 w = {cvtpk(a[0], a[1]), cvtpk(a[2], a[3]), cvtpk(b[0], b[1]), cvtpk(b[2], b[3])};
    return *reinterpret_cast<bf16x8*>(&w);
}
template <class T> __device__ __forceinline__ bf16x8 load8(const T* p) {
    if constexpr (same_t<T, float>::v) { return pack8(*(const f32x4*)p, *(const f32x4*)(p + 4)); }
    else { return *reinterpret_cast<const bf16x8*>(p); }
}
__device__ __forceinline__ void mask_tile(f32x16& p0, f32x16& p1, int dq, unsigned W) {
    const float NEG = -__builtin_inff();
#pragma unroll
    for (int r = 0; r < 16; ++r) {
        const int c = (r & 3) + 8 * (r >> 2);
        if ((unsigned)(dq - c) >= W) p0[r] = NEG;
        if ((unsigned)(dq - c - 32) >= W) p1[r] = NEG;
    }
}
__device__ __forceinline__ void partialSM(f32x16& p0, f32x16& p1, float& m_reg, float& mn, float& alpha) {
    float pmax = p0[0]; for (int r = 1; r < 16; ++r) pmax = fmaxf(pmax, p0[r]); for (int r = 0; r < 16; ++r) pmax = fmaxf(pmax, p1[r]);
    { auto rr = __builtin_amdgcn_permlane32_swap(__float_as_uint(pmax), __float_as_uint(pmax), false, false);
      pmax = fmaxf(__uint_as_float(rr[0]), __uint_as_float(rr[1])); }
    constexpr float C2 = 1.f;
    if (__builtin_expect(__all((pmax - m_reg) * SCALE <= THR), 1)) { mn = m_reg; alpha = 1.f; }
    else { mn = fmaxf(m_reg, pmax); alpha = __builtin_amdgcn_exp2f((m_reg - mn) * C2); m_reg = mn; }
    const float mnL = -mn * C2;
    for (int r = 0; r < 16; ++r) p0[r] = fmaf(p0[r], C2, mnL); for (int r = 0; r < 16; ++r) p1[r] = fmaf(p1[r], C2, mnL);
    for (int r = 0; r < 16; ++r) p0[r] = __builtin_amdgcn_exp2f(p0[r]);
}
__device__ __forceinline__ void finishSM(f32x16& p0, f32x16& p1, float alpha, float& l_reg, bf16x8& pa0, bf16x8& pa1, bf16x8& pa2, bf16x8& pa3) {
    for (int r = 0; r < 16; ++r) p1[r] = __builtin_amdgcn_exp2f(p1[r]);
    float ps = 0; for (int r = 0; r < 16; ++r) ps += p0[r]; for (int r = 0; r < 16; ++r) ps += p1[r];
    { auto rr = __builtin_amdgcn_permlane32_swap(__float_as_uint(ps), __float_as_uint(ps), false, false);
      ps = __uint_as_float(rr[0]) + __uint_as_float(rr[1]); }
    l_reg = l_reg * alpha + ps;
#define PK4(P, B_, OUT) do { unsigned a0 = cvtpk(P[B_+0], P[B_+1]), a1 = cvtpk(P[B_+2], P[B_+3]);                          \
        unsigned b0 = cvtpk(P[B_+4], P[B_+5]), b1 = cvtpk(P[B_+6], P[B_+7]);                                             \
        auto r0 = __builtin_amdgcn_permlane32_swap(a0, b0, false, false); auto r1 = __builtin_amdgcn_permlane32_swap(a1, b1, false, false); \
        u32x4 w = {r0[0], r1[0], r0[1], r1[1]}; OUT = *reinterpret_cast<bf16x8*>(&w); } while (0)
    PK4(p0, 0, pa0); PK4(p0, 8, pa1); PK4(p1, 0, pa2); PK4(p1, 8, pa3);
#undef PK4
}
template <int KB, bool SK>
__device__ __forceinline__ void qkt(f32x16& p0, f32x16& p1, const char* K_lds, const float* kbl, int r32, int hi, const __attribute__((address_space(3))) char* q_lds, bool act) {
    if (SK && !act) { const float NEG = -__builtin_inff();
#pragma unroll
        for (int r = 0; r < 16; ++r) { p0[r] = NEG; p1[r] = NEG; } return; }
    { const float* kb_ = kbl + KB * 64 + 4 * hi;
#pragma unroll
      for (int j = 0; j < 4; ++j) { const f32x4 a = *(const f32x4*)(kb_ + 8 * j), b = *(const f32x4*)(kb_ + 32 + 8 * j);
          p0[4 * j] = a[0]; p0[4 * j + 1] = a[1]; p0[4 * j + 2] = a[2]; p0[4 * j + 3] = a[3];
          p1[4 * j] = b[0]; p1[4 * j + 1] = b[1]; p1[4 * j + 2] = b[2]; p1[4 * j + 3] = b[3]; } }
    const char* kb[4];
#pragma unroll
    for (int dd = 0; dd < 4; ++dd) kb[dd] = K_lds + KB * SHM_K + KSWZ(r32, (dd * 16 + hi * 8) * 2);
#pragma unroll
    for (int d0 = 0; d0 < 8; ++d0) { const char* a = kb[d0 & 3] + (d0 >> 2) * 128;
        bf16x8 b0 = *reinterpret_cast<const bf16x8*>(a);
        bf16x8 b1 = *reinterpret_cast<const bf16x8*>(a + 32 * 256);
        const bf16x8 q_ = *(const __attribute__((address_space(3))) bf16x8*)(q_lds + d0 * 1024);
        p0 = __builtin_amdgcn_mfma_f32_32x32x16_bf16(b0, q_, p0, 0, 0, 0);
        p1 = __builtin_amdgcn_mfma_f32_32x32x16_bf16(b1, q_, p1, 0, 0, 0); }
}
template <int VB, bool SK>
__device__ __forceinline__ void pv_tile(f32x16* o, int vb0, bf16x8 pa0, bf16x8 pa1, bf16x8 pa2, bf16x8 pa3, bool act) {
    if (SK && !act) return;
#define TRRD(dst, off) asm volatile("ds_read_b64_tr_b16 %0, %1 offset:%2" : "=&v"(dst) : "v"(vb0), "i"(off) : "memory")
#define PV_D0(d0) do { s16x4 l0, l1, l2, l3, h0, h1, h2, h3; constexpr int b_ = VB * SHM_V + v_rd_off(d0, 0, 0);     \
        TRRD(l0, b_); TRRD(h0, b_ + 2048); TRRD(l1, b_ + 4096); TRRD(h1, b_ + 6144); TRRD(l2, b_ + 8192); TRRD(h2, b_ + 10240); TRRD(l3, b_ + 12288); TRRD(h3, b_ + 14336); \
        asm volatile("s_waitcnt lgkmcnt(0)" ::: "memory"); SBAR();                 \
        o[d0] = __builtin_amdgcn_mfma_f32_32x32x16_bf16(pa0, (bf16x8){l0[0], l0[1], l0[2], l0[3], h0[0], h0[1], h0[2], h0[3]}, o[d0], 0, 0, 0);   \
        o[d0] = __builtin_amdgcn_mfma_f32_32x32x16_bf16(pa1, (bf16x8){l1[0], l1[1], l1[2], l1[3], h1[0], h1[1], h1[2], h1[3]}, o[d0], 0, 0, 0);   \
        o[d0] = __builtin_amdgcn_mfma_f32_32x32x16_bf16(pa2, (bf16x8){l2[0], l2[1], l2[2], l2[3], h2[0], h2[1], h2[2], h2[3]}, o[d0], 0, 0, 0);   \
        o[d0] = __builtin_amdgcn_mfma_f32_32x32x16_bf16(pa3, (bf16x8){l3[0], l3[1], l3[2], l3[3], h3[0], h3[1], h3[2], h3[3]}, o[d0], 0, 0, 0); } while (0)
    PV_D0(0); PV_D0(1); PV_D0(2); PV_D0(3);
#undef PV_D0
#undef TRRD
}

constexpr float LOG2E = 1.4426950408889634f;
struct Blk {
    const bf16* Q; const bf16* K; const bf16* V; bf16* O; float* LSE; const float* CUM;
    long rs, os; int ls;
    int P0, L, W, nvalid; float sd2, cref;
};
struct Seam { bf16x8 st_v0, st_v1, st_k0, st_k1; float st_b0, st_b1; };
__device__ __forceinline__ float kbias_raw(const Blk& B, int key) { return B.CUM ? B.CUM[key] : B.sd2 * (float)(key - B.P0); }
__device__ __forceinline__ float kbias_fin(const Blk& B, float raw) { return B.CUM ? -raw * LOG2E : raw; }
__device__ __forceinline__ int swa_jlo(int P0, int W) { const int lowk = P0 - W + 1; return lowk > 0 ? lowk / KVBLK : 0; }
__device__ __forceinline__ int swa_jhi(int P0, int L) { int j = (P0 + QB - 1) / KVBLK + 1; const int jm = L / KVBLK; return j > jm ? jm : j; }
__device__ __forceinline__ bf16x8 ld8(const bf16* p) { return *reinterpret_cast<const bf16x8*>(p); }
#define ROWP(p, rs_, k0, rr) ((p) + (size_t)(k0) * (rs_) + (unsigned)(((rr) * (int)(rs_)) + sc))
#define VMW() asm volatile("s_waitcnt vmcnt(0)" ::: "memory")
#define SLOAD(B_, k0) do { const bf16* vb_ = (B_).V + (size_t)(k0) * (B_).rs; const bf16* kb_ = (B_).K + (size_t)(k0) * (B_).rs;     \
                           unsigned o0_ = (unsigned)(sr * (int)(B_).rs + sc), o1_ = o0_ + 32u * (unsigned)(B_).rs; asm volatile("" : "+v"(o0_), "+v"(o1_));       \
                           S.st_v0 = ld8(vb_ + o0_); S.st_v1 = ld8(vb_ + o1_); S.st_k0 = ld8(kb_ + o0_); S.st_k1 = ld8(kb_ + o1_);                                  \
                           if ((tid & 15) == 0) { S.st_b0 = kbias_raw((B_), (k0) + sr); S.st_b1 = kbias_raw((B_), (k0) + 32 + sr); } } while (0)
#define SWRITE_K(bf, B_) do { *(bf16x8*)(K_lds + (bf) * SHM_K + kws) = S.st_k0; *(bf16x8*)(K_lds + (bf) * SHM_K + kws + 32 * 256) = S.st_k1;       \
                          if ((tid & 15) == 0) { kbl[(bf) * 64 + sr] = kbias_fin((B_), S.st_b0); kbl[(bf) * 64 + 32 + sr] = kbias_fin((B_), S.st_b1); } } while (0)
#define SWRITE_V(bf) do { *(bf16x8*)(V_lds + (bf) * SHM_V + vst0) = S.st_v0; *(bf16x8*)(V_lds + (bf) * SHM_V + vst1) = S.st_v1; } while (0)
#define QLOAD(B_) do { const int ri_ = (wid * QBLK + r32 < (B_).nvalid) ? wid * QBLK + r32 : (B_).nvalid - 1;                                    \
        const bf16* qp_ = (B_).Q + (unsigned)(ri_ * (int)(B_).rs + hi * 8);                                                                       \
        _Pragma("unroll") for (int hf_ = 0; hf_ < 2; ++hf_) { bf16x8 t_[4];                                                                      \
            _Pragma("unroll") for (int d0 = 0; d0 < 4; ++d0) t_[d0] = ld8(qp_ + (hf_ * 4 + d0) * 16);                                           \
            _Pragma("unroll") for (int d0 = 0; d0 < 4; ++d0) *(__attribute__((address_space(3))) bf16x8*)(q_lds + (hf_ * 4 + d0) * 1024) = t_[d0]; } } while (0)

__device__ __forceinline__ void prime(const Blk& cur, char* lds, Seam& S) {
    int tid_o = threadIdx.x; asm volatile("" : "+v"(tid_o));
    const int tid = tid_o, wid = __builtin_amdgcn_readfirstlane(tid >> 6), lane = tid & 63, r32 = lane & 31, hi = lane >> 5;
    const int sr = tid >> 4, sc = (tid & 15) * 8, kws = KSWZ(sr, sc * 2); char* K_lds = lds + 2 * SHM_V; float* kbl = (float*)(lds + LDS_KB); __attribute__((address_space(3))) char* q_lds = (__attribute__((address_space(3))) char*)(lds + LDS_Q + wid * 8192 + lane * 16);
    const int kb0 = (swa_jhi(cur.P0, cur.L) - 1) * KVBLK;
    S.st_b0 = 0.f; S.st_b1 = 0.f;
    QLOAD(cur);
    SLOAD(cur, kb0); VMW(); SWRITE_K(0, cur);
    __syncthreads();
}
#ifndef ATT_SK
#define ATT_SK true
#endif
struct AttnArgs { const bf16* QKV; unsigned char* ws; long offOA, offOP0, offOP2x; float* LSE; const float* CUM; };
__device__ __forceinline__ Blk decode(int i, const AttnArgs& A);
template <bool SK>
__device__ __forceinline__ bool block(const Blk& cur, Blk& nxt, int pend, int nitems, volatile int* slot, const AttnArgs& A, char* lds, Seam& S) {
    int tid_o = threadIdx.x; asm volatile("" : "+v"(tid_o));
    const int tid = tid_o, wid = __builtin_amdgcn_readfirstlane(tid >> 6), lane = tid & 63, r32 = lane & 31, hi = lane >> 5;
    const int W = cur.W;
    const int j_lo = swa_jlo(cur.P0, W);
    const int j_hi = swa_jhi(cur.P0, cur.L);
    const int NT = j_hi - j_lo;
    const int qlo = cur.P0 + wid * QBLK, qm = qlo + r32 - 4 * hi;
    char* V_lds = lds; char* K_lds = lds + 2 * SHM_V;
    float* ws = (float*)(lds + LDS_WS) + wid * 64; float* li_l = ws, * al_l = ws + 32; float* kbl = (float*)(lds + LDS_KB); __attribute__((address_space(3))) char* q_lds = (__attribute__((address_space(3))) char*)(lds + LDS_Q + wid * 8192 + lane * 16);
    float m_reg = -1e30f, l_reg = 0; f32x16 o[4] = {};
    const int sr = tid >> 4, sc = (tid & 15) * 8, vst0 = v_st(sr, sc), vst1 = v_st(32 + sr, sc), kws = KSWZ(sr, sc * 2);
    const int vb0 = (int)(uintptr_t)V_lds + v_rd_base(lane);
#define RESC(a) do { if (__any((a) < 1.f)) { if (hi == 0) al_l[r32] = (a); asm volatile("s_waitcnt lgkmcnt(0)" ::: "memory");              \
                     for (int d_ = 0; d_ < 4; ++d_) for (int r = 0; r < 16; ++r) o[d_][r] *= al_l[crow(r, hi)]; } } while (0)
#define KBASE(t) ((j_hi - 1 - (t)) * KVBLK)
#define ACT(t) (KBASE(t) <= qlo + QBLK - 1 && KBASE(t) + KVBLK - 1 >= qlo - W + 1)
#define MASKT(P0_, P1_, t) do { const int kb_ = KBASE(t); if ((!SK || ACT(t)) && (kb_ + KVBLK - 1 > qlo || kb_ <= qlo + QBLK - 1 - W)) mask_tile(P0_, P1_, qm - kb_, (unsigned)W); } while (0)
    f32x16 pA0, pA1, pB0, pB1; float mnA, mnB, alA, alB; bf16x8 pa0, pa1, pa2, pa3;
    SWRITE_V(0); SBAR();
    if (NT > 1) SLOAD(cur, KBASE(1));
    SBAR(); qkt<0, SK>(pA0, pA1, K_lds, kbl, r32, hi, q_lds, ACT(0));
    MASKT(pA0, pA1, 0); partialSM(pA0, pA1, m_reg, mnA, alA);
    if (NT > 1) { VMW(); SWRITE_V(1); SWRITE_K(1, cur); }
    __syncthreads();
#define HALF_STEP(PX0, PX1, mnX, alX, PY0, PY1, alY, t, KB, VB, SB) do {                                                      \
        SBAR(); qkt<KB, SK>(PX0, PX1, K_lds, kbl, r32, hi, q_lds, ACT(t));                                                     \
        finishSM(PY0, PY1, alY, l_reg, pa0, pa1, pa2, pa3); SBAR();                                                           \
        if ((t) + 1 < NT) { SLOAD(cur, KBASE((t) + 1)); SBAR(); }                                                             \
        pv_tile<VB, SK>(o, vb0, pa0, pa1, pa2, pa3, ACT((t) - 1)); MASKT(PX0, PX1, (t)); partialSM(PX0, PX1, m_reg, mnX, alX); \
        __syncthreads();                                                                                                      \
        if ((t) + 1 < NT) { VMW(); SWRITE_V(SB); SWRITE_K(SB, cur); }                                                              \
        RESC(alX); __syncthreads(); } while (0)
    for (int t = 1; t + 1 < NT; t += 2) {
        HALF_STEP(pB0, pB1, mnB, alB, pA0, pA1, alA, t, 1, 0, 0);
        HALF_STEP(pA0, pA1, mnA, alA, pB0, pB1, alB, t + 1, 0, 1, 1);
    }
    const bool even = (NT & 1) == 0;
    if (even) { SBAR(); qkt<1, SK>(pB0, pB1, K_lds, kbl, r32, hi, q_lds, ACT(NT - 1)); SBAR(); }
    if (tid == 0) slot[0] = pend;
    __syncthreads();
    const int ni = __builtin_amdgcn_readfirstlane(slot[0]); const bool last = ni >= nitems;
    nxt = decode(last ? 0 : ni, A);
    if (!last) { const int kbn = (swa_jhi(nxt.P0, nxt.L) - 1) * KVBLK;
        SLOAD(nxt, kbn); SBAR();
        QLOAD(nxt); }
    SBAR();
    finishSM(pA0, pA1, alA, l_reg, pa0, pa1, pa2, pa3); SBAR();
    pv_tile<0, SK>(o, vb0, pa0, pa1, pa2, pa3, ACT(even ? NT - 2 : NT - 1));
    if (even) { MASKT(pB0, pB1, NT - 1); partialSM(pB0, pB1, m_reg, mnB, alB); __syncthreads(); RESC(alB);
        finishSM(pB0, pB1, alB, l_reg, pa0, pa1, pa2, pa3); SBAR(); pv_tile<1, SK>(o, vb0, pa0, pa1, pa2, pa3, ACT(NT - 1)); }
    SBAR(); if (!last) SWRITE_K(0, nxt); SBAR();
    int lne_ = (int)(threadIdx.x & 63u); asm volatile("" : "+v"(lne_)); const int r32e = lne_ & 31, hie = lne_ >> 5;
    if (hie == 0) li_l[r32e] = l_reg; asm volatile("s_waitcnt lgkmcnt(0)" ::: "memory");
    float rli[16];
#pragma unroll
    for (int r = 0; r < 16; ++r) rli[r] = __builtin_amdgcn_rcpf(li_l[crow(r, hie)]);
    bf16* Ow = cur.O + (size_t)(wid * QBLK) * cur.os;
#pragma unroll
    for (int r = 0; r < 16; ++r) { const int orow = crow(r, hie); const bool ok = (wid * QBLK + orow < cur.nvalid) && ((r32e & 1) == 0);
#pragma unroll
        for (int d0 = 0; d0 < 4; ++d0) { const float v = o[d0][r] * rli[r]; const float vn = __shfl_xor(v, 1);
            if (ok) *(unsigned*)(Ow + (unsigned)(orow * (int)cur.os + d0 * 32 + r32e)) = cvtpk(v, vn); } }
    if (cur.LSE && hie == 0 && wid * QBLK + r32e < cur.nvalid)
        cur.LSE[(unsigned)((wid * QBLK + r32e) * cur.ls)] = m_reg + __builtin_amdgcn_logf(l_reg) - cur.sd2 * (float)(wid * QBLK + r32e);
    __syncthreads();
    return last;
#undef RESC
#undef KBASE
#undef ACT
#undef MASKT
#undef HALF_STEP
}
#undef ROWP
#undef VMW
#undef SLOAD
#undef SWRITE_K
#undef SWRITE_V
#undef QLOAD

constexpr int NITEMS = 256 + 256 + 256 + 512;
__device__ __forceinline__ Blk decode(int i_in, const AttnArgs& A) {
    const int i = __builtin_amdgcn_readfirstlane(i_in);
    Blk b; int bh, qb, res, dil, pat; const bool fox = i < 256;
    if (i < 256) { qb = 7 - (i >> 5); bh = i & 31; res = 0; dil = 1; pat = 0; }
    else if (i < 512) { const int j = i - 256; qb = 7 - (j >> 5); bh = j & 31; res = 0; dil = 1; pat = 0; }
    else if (i < 768) { const int j = i - 512; bh = j & 31; const int rest = j >> 5; res = rest >> 1; qb = rest & 1; dil = 4; pat = 1; }
    else { const int j = i - 768; bh = j & 31; res = j >> 5; qb = 0; dil = 16; pat = 2; }
    const int bb = bh >> 3, h = bh & 7, L = 2048 / dil, P0 = qb * 256;
    const size_t tok0 = (size_t)bb * 2048 + res;
    const int seg = fox ? 0 : 3;
    const bf16* base = A.QKV + tok0 * 6144 + h * 128;
    const int opitch = fox ? 2048 : 1024;
    b.rs = (long)dil * 6144; b.os = (long)dil * opitch; b.ls = dil * 8;
    b.Q = base + seg * 1024 + (size_t)P0 * b.rs; b.K = base + (seg + 1) * 1024; b.V = base + (seg + 2) * 1024;
    long ooff = A.offOP0 + (long)pat * (16l << 20) + (pat == 2 ? A.offOP2x : 0l); ooff = fox ? A.offOA : ooff;
    bf16* ob = (bf16*)(A.ws + ooff);
    b.O = ob + (tok0 + (size_t)P0 * dil) * opitch + h * 128;
    float* lb = A.LSE + (size_t)pat * (8192 * 8);
    b.LSE = fox ? nullptr : lb + (tok0 + (size_t)P0 * dil) * 8 + h;
    b.CUM = fox ? A.CUM + (size_t)bh * 2048 : nullptr;
    b.cref = 0.f;
    b.P0 = P0; b.L = L; b.W = fox ? (1 << 30) : 129; b.nvalid = (L - P0) < QB ? (L - P0) : QB;
    b.sd2 = fox ? 0.f : __builtin_amdgcn_exp2f(-(float)(h + 1)) * (float)dil * LOG2E;
    return b;
}
__device__ __forceinline__ void attn_phase(char* lds, const AttnArgs& A, unsigned* ctr, int first = 0) {
    volatile int* slot = (volatile int*)(lds + LDS_SLOT);
    const int G = (int)gridDim.x, ci = first + (int)blockIdx.x;
    if (ci >= NITEMS) return;
    Blk cur = decode(ci, A); Seam S;
    prime(cur, lds, S);
    for (;;) {
        int pend = NITEMS; if (threadIdx.x == 0) pend = first + G + (int)atomicAdd(ctr, 1u);
        Blk nxt; bool last;
        if (cur.CUM) last = block<false>(cur, nxt, pend, NITEMS, slot, A, lds, S);
        else last = block<true>(cur, nxt, pend, NITEMS, slot, A, lds, S);
        if (last) break;
        cur = nxt;
    }
}
#undef SBAR
}

#define GAS __attribute__((address_space(1)))
#define LAS __attribute__((address_space(3)))
typedef unsigned short bf16;
typedef unsigned v4u __attribute__((ext_vector_type(4)));
typedef float f32x4 __attribute__((ext_vector_type(4)));
constexpr int NWAVES = 8;
constexpr int NB = 4, SEQ = 2048, DM = 2048, M = NB * SEQ, NH = 8, HD = 128, DFF = 5632, NUP = 2 * DFF, INC = 10248, NPROJ = 10240;
constexpr float EPS = 1e-6f;
constexpr float LOG2E_F = 1.4426950408889634f;
constexpr size_t MiB = 1u << 20;
constexpr size_t WS_CTL = 0, WS_BAR = 64 * 1024;
constexpr size_t WS_GAIN = 2 * MiB, WS_RSTD = 3 * MiB;
constexpr size_t WS_SSQ = 256 * 1024, WS_CUM = 512 * 1024, WS_LOGF = 768 * 1024, WS_LSE = 1 * MiB;
constexpr size_t WS_WIN = 4 * MiB, WS_WBRF = 44 * MiB, WS_WBRD = 48 * MiB, WS_WOUT = 52 * MiB, WS_WUP = 60 * MiB, WS_WDN = 104 * MiB;
constexpr size_t WS_XN = 126 * MiB;
constexpr size_t WS_QKV = 158 * MiB;
constexpr size_t WS_GATES = 254 * MiB;
constexpr size_t WS_OA = 4 * MiB, WS_OB = 20 * MiB;
constexpr size_t WS_OP0 = 126 * MiB, WS_OP1 = 142 * MiB, WS_OP2 = 318 * MiB;
constexpr size_t WS_T = 158 * MiB, WS_MG = 222 * MiB;
constexpr size_t WS_XB = 126 * MiB;
#ifndef CONV_ALIGN
#define CONV_ALIGN false
#endif
#ifndef FUSED_CONV
#define FUSED_CONV 0
#endif
constexpr size_t WS_U = 158 * MiB;
constexpr size_t WS_ACT = FUSED_CONV ? 158 * MiB : 4 * MiB, WS_US = 254 * MiB;
constexpr size_t WS_END = 334 * MiB;
constexpr int RING_BYTES = 131072, XL_OFF = RING_BYTES, BARST_OFF = 143360, LDS_BYTES = 147456;
static_assert(att::LDS_END <= LDS_BYTES, "attention LDS");

__device__ __forceinline__ unsigned f2bf(float f) { unsigned u = __builtin_bit_cast(unsigned, f); return (u + 0x7fffu + ((u >> 16) & 1u)) >> 16; }
__device__ __forceinline__ unsigned pk2(float lo, float hi) { return f2bf(lo) | (f2bf(hi) << 16); }
__device__ __forceinline__ float wave_sum(float v) {
#pragma unroll
    for (int o = 1; o < 64; o <<= 1) v += __shfl_xor(v, o);
    return v;
}
template <int MODE, bool NTST>
__device__ __forceinline__ void transpose_matrix(const float* W, int K, int Nsrc, int Ndst, bf16* WT, int Kdst, int koff, const float* kscale, int rot, int gw, int NGW, LAS float* scr, int lane) {
    const int nblk = Ndst / 32, nitems = (K / 64) * nblk, rr = lane >> 3, c4 = (lane & 7) * 4, c = lane & 7;
    int it = gw - rot; if (it < 0) it += NGW;
    f32x4 v[8]; int k0 = 0, n0 = 0;
#define TM_LOAD(dst, IT, K0, N0) do { const int kb_ = (IT) / nblk; N0 = 32 * ((IT) - kb_ * nblk); K0 = 64 * kb_;                                   \
        const int sc_ = MODE == 0 ? N0 : (MODE == 1 ? (N0 < 3072 ? N0 : N0 + 8) : (((N0 >> 7) & 1) * 5632 + 128 * (N0 >> 8) + (N0 & 127)));       \
        _Pragma("unroll") for (int i = 0; i < 8; ++i) dst[i] = __builtin_nontemporal_load((const f32x4*)(W + (size_t)(K0 + 8 * i + rr) * Nsrc + sc_ + c4)); } while (0)
    if (it < nitems) TM_LOAD(v, it, k0, n0);
    while (it < nitems) {
        const int itn = it + NGW; f32x4 vn[8]; int k0n = 0, n0n = 0;
        if (itn < nitems) TM_LOAD(vn, itn, k0n, n0n);
        if (kscale) {
#pragma unroll
            for (int i = 0; i < 8; ++i) v[i] = v[i] * kscale[k0 + 8 * i + rr]; }
#pragma unroll
        for (int i = 0; i < 8; ++i) { LAS float* d = scr + (8 * i + rr) * 33 + c4; d[0] = v[i][0]; d[1] = v[i][1]; d[2] = v[i][2]; d[3] = v[i][3]; }
        asm volatile("s_waitcnt lgkmcnt(0)" ::: "memory");
#pragma unroll
        for (int j = 0; j < 4; ++j) { const int n = (lane >> 3) + 8 * j; const LAS float* sp = scr + (8 * c) * 33 + n;
            v4u o; o.x = pk2(sp[0 * 33], sp[1 * 33]); o.y = pk2(sp[2 * 33], sp[3 * 33]); o.z = pk2(sp[4 * 33], sp[5 * 33]); o.w = pk2(sp[6 * 33], sp[7 * 33]);
            if constexpr (NTST) __builtin_nontemporal_store(o, (v4u*)(WT + (size_t)(n0 + n) * Kdst + koff + k0 + 8 * c)); else *(v4u*)(WT + (size_t)(n0 + n) * Kdst + koff + k0 + 8 * c) = o; }
        asm volatile("s_waitcnt lgkmcnt(0)" ::: "memory");
        it = itn; k0 = k0n; n0 = n0n;
#pragma unroll
        for (int i = 0; i < 8; ++i) v[i] = vn[i];
    }
#undef TM_LOAD
}

typedef GAS unsigned gu32;
#define RLX_AGENT __ATOMIC_RELAXED, __HIP_MEMORY_SCOPE_AGENT
#define XB_TMO      128
#define XB_XCNT(j)  (256  + 64 * (j))
#define XB_XSUB(j)  (1280 + 64 * (j))
#define XB_XGEN(j)  (2304 + 64 * (j))
#define XB_TOP      3328
#define XB_TOPGEN   3392
#define XCD_BAR_WORDS 3456
#define XB_SPIN_CAP (1u << 18)

__device__ __forceinline__ unsigned xb_ld(unsigned* p)              { return __hip_atomic_load(p, __ATOMIC_RELAXED, __HIP_MEMORY_SCOPE_AGENT); }
__device__ __forceinline__ unsigned xb_add(unsigned* p, unsigned v) { return __hip_atomic_fetch_add(p, v, __ATOMIC_RELAXED, __HIP_MEMORY_SCOPE_AGENT); }
__device__ __forceinline__ unsigned xb_xcc_id() { return (unsigned)__builtin_amdgcn_s_getreg((3 << 11) | 20) & 0xFu; }
#define XB_SPIN(cond, bar) do { unsigned _sp = 0; while (cond) { __builtin_amdgcn_s_sleep(1); \
    if ((++_sp & 255u) == 0u) { if (xb_ld(&(bar)[XB_TMO])) break; if (_sp > XB_SPIN_CAP) { atomicAdd(&(bar)[XB_TMO], 1u); break; } } } } while (0)

struct XcdBarrier {
    unsigned* bar; unsigned x;
    volatile LAS unsigned* st;
};

__device__ __forceinline__ XcdBarrier xcd_barrier_post(unsigned* bar, volatile LAS unsigned* st) {
    XcdBarrier b; b.bar = bar; b.x = xb_xcc_id(); b.st = st;
    if (threadIdx.x == 0) (void)xb_add(&bar[XB_XCNT(b.x)], 1u);
    return b;
}
__device__ __forceinline__ void xcd_barrier_complete(unsigned* bar, unsigned x, unsigned& nloc, unsigned& nx) {
    const unsigned G = gridDim.x * gridDim.y * gridDim.z;
    unsigned sum, cnt, mine, sp = 0u;
    for (;;) {
        sum = 0u; cnt = 0u; mine = 0u;
#pragma unroll
        for (unsigned j = 0; j < 16; ++j) { const unsigned c = xb_ld(&bar[XB_XCNT(j)]); sum += c; cnt += (c > 0u) ? 1u : 0u; mine = (j == x) ? c : mine; }
        if (sum == G) break;
        __builtin_amdgcn_s_sleep(1);
        if ((++sp & 255u) == 0u) { if (xb_ld(&bar[XB_TMO])) break; if (sp > XB_SPIN_CAP) { atomicAdd(&bar[XB_TMO], 1u); break; } }
    }
    nloc = mine > 0u ? mine : 1u; nx = cnt > 0u ? cnt : 1u;
}

__device__ __forceinline__ void xcd_barrier(const XcdBarrier& b) {
    asm volatile("s_waitcnt vmcnt(0)" ::: "memory");
    __syncthreads();
    if (threadIdx.x == 0) {
        unsigned* bar = b.bar;
        __builtin_amdgcn_s_waitcnt(0);
        unsigned nloc = b.st[0], nx = b.st[1];
        if (nloc == 0u) { xcd_barrier_complete(bar, b.x, nloc, nx); b.st[0] = nloc; b.st[1] = nx; }
        const unsigned old = xb_add(&bar[XB_XSUB(b.x)], 1u);
        const unsigned gen = old / nloc;
        if (old + 1u == (gen + 1u) * nloc) {
            __builtin_amdgcn_fence(__ATOMIC_RELEASE, "agent");
            asm volatile("s_waitcnt vmcnt(0)" ::: "memory");
            const unsigned og = xb_add(&bar[XB_TOP], 1u);
            const unsigned tg = og / nx;
            if (og + 1u == (tg + 1u) * nx) xb_add(&bar[XB_TOPGEN], 1u);
            else XB_SPIN(xb_ld(&bar[XB_TOPGEN]) == tg, bar);
            __builtin_amdgcn_fence(__ATOMIC_ACQUIRE, "agent");
            xb_add(&bar[XB_XGEN(b.x)], 1u);
            asm volatile("s_waitcnt vmcnt(0)" ::: "memory");
        } else {
            XB_SPIN(xb_ld(&bar[XB_XGEN(b.x)]) == gen, bar);
            __builtin_amdgcn_fence(__ATOMIC_ACQUIRE, "agent");
            asm volatile("s_waitcnt vmcnt(0)" ::: "memory");
        }
    }
    __syncthreads();
}
#ifndef PROBE_REPEAT
#define PROBE_REPEAT -1
#endif
#ifndef PROBE_FIRST
#define PROBE_FIRST 0
#endif
#define REPS(k) ((PROBE_REPEAT == (k)) ? 2 : 1)
struct Args { const float* in[16]; float* out; unsigned char* ws; unsigned long long flags; };
#define IDS() int tid_o = threadIdx.x; asm volatile("" : "+v"(tid_o)); const int tid = tid_o, lane = tid & 63, wave = __builtin_amdgcn_readfirstlane(tid >> 6); (void)lane; (void)wave
#define OPQ() int z_ = 0; asm volatile("" : "+s"(z_))
#define INP(k) (args.in[z_ + (k)])

__global__ void __launch_bounds__(NWAVES * 64, 2) fwd_mega(Args args) {
    extern __shared__ __attribute__((aligned(16))) unsigned char lds[];
    cg::grid_group grid = cg::this_grid();
    LAS unsigned char* lds3 = (LAS unsigned char*)lds;
    const int G = gridDim.x, bx = blockIdx.x;
    if (threadIdx.x < 2) ((volatile LAS unsigned*)(lds3 + BARST_OFF))[threadIdx.x] = 0u;
    __syncthreads();
    unsigned char* ws = args.ws;
    const XcdBarrier xbar = xcd_barrier_post((unsigned*)(ws + WS_BAR), (volatile LAS unsigned*)(lds3 + BARST_OFF));
    float* out = args.out;
    bf16* Win_t = (bf16*)(ws + WS_WIN); bf16* Wbrf_t = (bf16*)(ws + WS_WBRF); bf16* Wbrd_t = (bf16*)(ws + WS_WBRD); bf16* Wout_t = (bf16*)(ws + WS_WOUT);
    bf16* Wup_t = (bf16*)(ws + WS_WUP); bf16* Wdn_t = (bf16*)(ws + WS_WDN);
    bf16* XN = (bf16*)(ws + WS_XN); bf16* QKV = (bf16*)(ws + WS_QKV); bf16* GATES = (bf16*)(ws + WS_GATES);
    bf16* OA = (bf16*)(ws + WS_OA); bf16* OB = (bf16*)(ws + WS_OB); bf16* OP0 = (bf16*)(ws + WS_OP0); bf16* OP1 = (bf16*)(ws + WS_OP1); bf16* OP2 = (bf16*)(ws + WS_OP2);
    float* T = (float*)(ws + WS_T); bf16* MG = (bf16*)(ws + WS_MG); bf16* XB = (bf16*)(ws + WS_XB); bf16* ACT = (bf16*)(ws + WS_ACT); bf16* U = (bf16*)(ws + WS_U); float* US = (float*)(ws + WS_US); (void)U; (void)US;
    float* SSQ = (float*)(ws + WS_SSQ); float* CUM = (float*)(ws + WS_CUM); float* LOGF = (float*)(ws + WS_LOGF); float* LSE = (float*)(ws + WS_LSE);
    unsigned* ctl = (unsigned*)(ws + WS_CTL); float* GAIN = (float*)(ws + WS_GAIN); float* RSTD = (float*)(ws + WS_RSTD);

#if !defined(ONLY) || ONLY == 0
    _Pragma("unroll 1") for (int rep_ = 0; rep_ < REPS(0); ++rep_) {
        IDS();
        OPQ(); const float* x = INP(0); const float* g_attn = INP(1); const float* w_in = INP(2); const float* b_forget = INP(3); const float* gq_fox = INP(4); const float* gk_fox = INP(5); const float* gq_dil = INP(6); const float* gk_dil = INP(7);
        const float* w_br_fox = INP(8); const float* w_br_dil = INP(9); const float* w_out = INP(10); const float* g_ffn = INP(11); const float* w_up = INP(12); const float* w_down = INP(15);
        if (bx == 1) for (int i = tid; i < 1024; i += NWAVES * 64) { GAIN[i] = gq_fox[i]; GAIN[1024 + i] = gk_fox[i]; GAIN[2048 + i] = gq_dil[i]; GAIN[3072 + i] = gk_dil[i]; }
        LAS float* scr = (LAS float*)(lds3 + wave * 16384);
        const int gw = bx * NWAVES + wave, NGW = G * NWAVES;
        constexpr int I_IN = (DM / 64) * (NPROJ / 32), I_BR = (1024 / 64) * (DM / 32), I_OUT = (DM / 64) * (DM / 32), I_UP = (DM / 64) * (NUP / 32);
        transpose_matrix<1, false>(w_in, DM, INC, NPROJ, Win_t, DM, 0, nullptr, 0, gw, NGW, scr, lane);
        transpose_matrix<0, true>(w_br_fox, 1024, DM, DM, Wbrf_t, 2048, 0, nullptr, I_IN % NGW, gw, NGW, scr, lane);
        transpose_matrix<0, true>(w_br_dil, 1024, DM, DM, Wbrf_t, 2048, 1024, nullptr, (I_IN + I_BR) % NGW, gw, NGW, scr, lane);
        transpose_matrix<0, true>(w_out, DM, DM, DM, Wout_t, DM, 0, nullptr, (I_IN + 2 * I_BR) % NGW, gw, NGW, scr, lane);
        transpose_matrix<2, true>(w_up, DM, NUP, NUP, Wup_t, DM, 0, g_ffn, (I_IN + 2 * I_BR + I_OUT) % NGW, gw, NGW, scr, lane);
        if (G != 256) transpose_matrix<0, true>(w_down, DFF, DM, DM, Wdn_t, DFF, 0, nullptr, (I_IN + 2 * I_BR + I_OUT + I_UP) % NGW, gw, NGW, scr, lane);
        __syncthreads();
        LAS float* wf = (LAS float*)lds3;
        {
            const float* wsrc = w_in + 3072 + (tid & 7);
#pragma unroll 1
            for (int b0 = 0; b0 < 32; b0 += 8) { float tv[8];
#pragma unroll
                for (int q = 0; q < 8; ++q) tv[q] = wsrc[(size_t)((tid + (b0 + q) * NWAVES * 64) >> 3) * INC];
#pragma unroll
                for (int q = 0; q < 8; ++q) wf[tid + (b0 + q) * NWAVES * 64] = tv[q]; }
        }
        __syncthreads();
        for (int m = gw; m < M; m += NGW) {
            const f32x4* xr = (const f32x4*)(x + (size_t)m * DM) + lane; const f32x4* gr = (const f32x4*)g_attn + lane;
            f32x4 v[8]; float s = 0.f;
#pragma unroll
            for (int j = 0; j < 8; ++j) { v[j] = __builtin_nontemporal_load(xr + 64 * j); s += (v[j][0] * v[j][0] + v[j][1] * v[j][1]) + (v[j][2] * v[j][2] + v[j][3] * v[j][3]); }
            const float rstd = 1.f / sqrtf(wave_sum(s) * (1.f / DM) + EPS);
            float fa[8] = {0.f, 0.f, 0.f, 0.f, 0.f, 0.f, 0.f, 0.f};
            unsigned long long* o8 = (unsigned long long*)(XN + (size_t)m * DM) + lane;
#pragma unroll
            for (int j = 0; j < 8; ++j) { const f32x4 h = v[j] * rstd * gr[64 * j];
                o8[64 * j] = (unsigned long long)pk2(h[0], h[1]) | ((unsigned long long)pk2(h[2], h[3]) << 32);
#pragma unroll
                for (int c = 0; c < 4; ++c) { const LAS f32x4* wp = (const LAS f32x4*)(wf + (size_t)(256 * j + 4 * lane + c) * 8); const f32x4 wa = wp[0], wb = wp[1];
                    fa[0] = fmaf(h[c], wa[0], fa[0]); fa[1] = fmaf(h[c], wa[1], fa[1]); fa[2] = fmaf(h[c], wa[2], fa[2]); fa[3] = fmaf(h[c], wa[3], fa[3]);
                    fa[4] = fmaf(h[c], wb[0], fa[4]); fa[5] = fmaf(h[c], wb[1], fa[5]); fa[6] = fmaf(h[c], wb[2], fa[6]); fa[7] = fmaf(h[c], wb[3], fa[7]); }
                asm volatile("" ::: "memory"); }
#pragma unroll
            for (int hh = 0; hh < 8; ++hh) fa[hh] = wave_sum(fa[hh]);
            if (lane < 8) { float z = fa[0];
#pragma unroll
                for (int hh = 1; hh < 8; ++hh) z = (lane == hh) ? fa[hh] : z;
                z += b_forget[lane];
                LOGF[(size_t)m * 8 + lane] = fminf(z, 0.f) - log1pf(expf(-fabsf(z))); }
        }
        __syncthreads();
    }
#endif
    if (args.flags & 1ull) grid.sync();
    xcd_barrier(xbar);

#if !defined(ONLY) || ONLY == 1
    _Pragma("unroll 1") for (int rep_ = 0; rep_ < REPS(1); ++rep_) {
        if (rep_ > 0) xcd_barrier(xbar);
        IDS();
        if (bx < NB * NH) { const int bb = bx >> 3, h = bx & 7; LAS float* wt = (LAS float*)lds3;
            float v[4]; float s = 0.f;
#pragma unroll
            for (int j = 0; j < 4; ++j) { v[j] = LOGF[((size_t)bb * SEQ + 4 * tid + j) * 8 + h]; s += v[j]; v[j] = s; }
            float inc = s;
#pragma unroll
            for (int o = 1; o < 64; o <<= 1) { const float t = __shfl_up(inc, o); if (lane >= o) inc += t; }
            if (lane == 63) wt[wave] = inc;
            __syncthreads();
            float off = inc - s;
            for (int w = 0; w < wave; ++w) off += wt[w];
#pragma unroll
            for (int j = 0; j < 4; ++j) CUM[(size_t)bx * SEQ + 4 * tid + j] = off + v[j];
            __syncthreads();
        }
        pg8::Gemm g{XN, Win_t, M, NPROJ, DM}; pg8::StaticOrder S; S.init(M, NPROJ, G, bx);
        pg8::EpiProj E{QKV, GATES, GAIN, (LAS float*)(lds3 + XL_OFF)};
        pg8::gemm_phase<pg8::EpiProj, pg8::StaticOrder, true, true>(lds3, g, S, E);
    }
#endif
    xcd_barrier(xbar);

#if !defined(ONLY) || ONLY == 2
    _Pragma("unroll 1") for (int rep_ = 0; rep_ < REPS(2); ++rep_) {
        if (rep_ > 0) xcd_barrier(xbar);
        IDS();
        const att::AttnArgs A{QKV, ws, (long)WS_OA, (long)WS_OP0, (long)WS_OP2 - (long)WS_OP0 - 32 * (long)MiB, LSE, CUM};
        att::attn_phase((char*)lds, A, ctl + 16 * rep_, rep_ ? PROBE_FIRST : 0);
    }
#endif
    xcd_barrier(xbar);

#if !defined(ONLY) || ONLY == 3
    _Pragma("unroll 1") for (int rep_ = 0; rep_ < REPS(3); ++rep_) {
        if (rep_ > 0) xcd_barrier(xbar);
        IDS();
        const int gt = bx * (NWAVES * 64) + tid, NT = G * NWAVES * 64;
        for (int i = gt; i < M * 128; i += NT) { const int m = i >> 7, c8 = (i & 127) * 8, h = c8 >> 7;
            const float l0 = LSE[(size_t)m * 8 + h], l1 = LSE[(size_t)(M + m) * 8 + h], l2 = LSE[(size_t)(2 * M + m) * 8 + h];
            const float mx = fmaxf(l0, fmaxf(l1, l2));
            float w0 = __builtin_amdgcn_exp2f(l0 - mx), w1 = __builtin_amdgcn_exp2f(l1 - mx), w2 = __builtin_amdgcn_exp2f(l2 - mx);
            const float inv = 1.f / (w0 + w1 + w2); w0 *= inv; w1 *= inv; w2 *= inv;
            const v4u a = __builtin_nontemporal_load((const v4u*)(OP0 + (size_t)m * 1024 + c8)), b = __builtin_nontemporal_load((const v4u*)(OP1 + (size_t)m * 1024 + c8)), c = __builtin_nontemporal_load((const v4u*)(OP2 + (size_t)m * 1024 + c8));
            v4u o;
#pragma unroll
            for (int k = 0; k < 4; ++k) { const float lo = w0 * pg8::bflo(a[k]) + w1 * pg8::bflo(b[k]) + w2 * pg8::bflo(c[k]), hi = w0 * pg8::bfhi(a[k]) + w1 * pg8::bfhi(b[k]) + w2 * pg8::bfhi(c[k]); o[k] = pk2(lo, hi); }
            *(v4u*)(OA + (size_t)m * 2048 + 1024 + c8) = o; }
    }
#endif
    xcd_barrier(xbar);

#if !defined(ONLY) || ONLY == 4
    _Pragma("unroll 1") for (int rep_ = 0; rep_ < REPS(4); ++rep_) {
        if (rep_ > 0) xcd_barrier(xbar);
        IDS();
        pg8::StaticOrder S; S.init(M, DM, G, bx);
        pg8::Gemm g{OA, Wbrf_t, M, DM, 2048}; pg8::EpiBr E{GATES, MG};
        pg8::gemm_phase<pg8::EpiBr, pg8::StaticOrder, true, true>(lds3, g, S, E);
    }
#endif
    xcd_barrier(xbar);

#if !defined(ONLY) || ONLY == 5
    _Pragma("unroll 1") for (int rep_ = 0; rep_ < REPS(5); ++rep_) {
        if (rep_ > 0) xcd_barrier(xbar);
        IDS();
        pg8::Gemm g{MG, Wout_t, M, DM, DM}; pg8::StaticOrder S; S.init(M, DM, G, bx);
        OPQ(); pg8::EpiOut E{INP(0), XB, SSQ};
        pg8::gemm_phase<pg8::EpiOut, pg8::StaticOrder, false, true>(lds3, g, S, E);
    }
#endif
    xcd_barrier(xbar);

#if !defined(ONLY) || ONLY == 6
    _Pragma("unroll 1") for (int rep_ = 0; rep_ < REPS(6); ++rep_) {
        if (rep_ > 0) xcd_barrier(xbar);
        IDS();
#pragma unroll 1
        for (int r0 = tid; r0 < M; r0 += 8 * NWAVES * 64) { f32x4 sa[8], sb[8];
#pragma unroll
            for (int q = 0; q < 8; ++q) { const size_t r = (size_t)(r0 + q * NWAVES * 64); sa[q] = *(const f32x4*)(SSQ + r * 8); sb[q] = *(const f32x4*)(SSQ + r * 8 + 4); }
#pragma unroll
            for (int q = 0; q < 8; ++q) RSTD[r0 + q * NWAVES * 64] = 1.f / sqrtf((((sa[q][0] + sa[q][1]) + (sa[q][2] + sa[q][3])) + ((sb[q][0] + sb[q][1]) + (sb[q][2] + sb[q][3]))) * (1.f / DM) + EPS); }
        asm volatile("s_waitcnt vmcnt(0)" ::: "memory"); __syncthreads();
        pg8::Gemm g{XB, Wup_t, M, NUP, DM}; pg8::StaticOrder S; S.init(M, NUP, G, bx);
#if FUSED_CONV
        OPQ(); pg8::EpiUpConv E{RSTD, INP(13), INP(14), ACT, US, (LAS float*)(lds3 + XL_OFF)};
        pg8::gemm_phase<pg8::EpiUpConv, pg8::StaticOrder, CONV_ALIGN, true>(lds3, g, S, E);
#else
        pg8::EpiUp E{RSTD, U};
        pg8::gemm_phase<pg8::EpiUp, pg8::StaticOrder, true, true>(lds3, g, S, E);
        if (G == 256 && bx >= 128) { OPQ(); const float* w_down = INP(15);
            transpose_matrix<0, true>(w_down, DFF, DM, DM, Wdn_t, DFF, 0, nullptr, 0, (bx - 128) * NWAVES + wave, 128 * NWAVES, (LAS float*)(lds3 + wave * 16384), lane); }
#endif
    }
#endif
    xcd_barrier(xbar);

#if (!defined(ONLY) || ONLY == 8) && !FUSED_CONV
    _Pragma("unroll 1") for (int rep_ = 0; rep_ < REPS(8); ++rep_) {
        if (rep_ > 0) xcd_barrier(xbar);
        IDS();
        OPQ(); const float* w_conv = INP(13); const float* b_conv = INP(14);
        const int gt = bx * (NWAVES * 64) + tid, NTH = G * NWAVES * 64;
        for (int it = gt; it < 704 * 512; it += NTH) { const int r = it / 704, k = it - r * 704, t0 = r * 16, pn = k >> 4, j8 = (k & 15) * 8;
            const unsigned ug = 256 * pn + j8, c = 8 * k;
            float wg[3][8], wv[3][8], bg[8], bv[8];
#pragma unroll
            for (int tp = 0; tp < 3; ++tp)
#pragma unroll
                for (int q = 0; q < 2; ++q) { const f32x4 a = *(const f32x4*)(w_conv + tp * NUP + c + 4 * q), b = *(const f32x4*)(w_conv + tp * NUP + DFF + c + 4 * q);
#pragma unroll
                    for (int j = 0; j < 4; ++j) { wg[tp][4 * q + j] = a[j]; wv[tp][4 * q + j] = b[j]; } }
#pragma unroll
            for (int q = 0; q < 2; ++q) { const f32x4 a = *(const f32x4*)(b_conv + c + 4 * q), b = *(const f32x4*)(b_conv + DFF + c + 4 * q);
#pragma unroll
                for (int j = 0; j < 4; ++j) { bg[4 * q + j] = a[j]; bv[4 * q + j] = b[j]; } }
            float g2[8], g1[8], v2[8], v1[8];
            if ((t0 & (SEQ - 1)) == 0) {
#pragma unroll
                for (int j = 0; j < 8; ++j) { g2[j] = 0.f; g1[j] = 0.f; v2[j] = 0.f; v1[j] = 0.f; }
            } else {
                const v4u a2 = *(const v4u*)(U + (size_t)(t0 - 2) * NUP + ug), b2 = *(const v4u*)(U + (size_t)(t0 - 2) * NUP + ug + 128);
                const v4u a1 = *(const v4u*)(U + (size_t)(t0 - 1) * NUP + ug), b1 = *(const v4u*)(U + (size_t)(t0 - 1) * NUP + ug + 128);
#pragma unroll
                for (int q = 0; q < 4; ++q) { g2[2 * q] = pg8::bflo(a2[q]); g2[2 * q + 1] = pg8::bfhi(a2[q]); v2[2 * q] = pg8::bflo(b2[q]); v2[2 * q + 1] = pg8::bfhi(b2[q]);
                    g1[2 * q] = pg8::bflo(a1[q]); g1[2 * q + 1] = pg8::bfhi(a1[q]); v1[2 * q] = pg8::bflo(b1[q]); v1[2 * q + 1] = pg8::bfhi(b1[q]); }
            }
            for (int i4 = 0; i4 < 16; i4 += 4) {
                v4u a0[4], b0[4];
#pragma unroll
                for (int i = 0; i < 4; ++i) { const size_t t = (size_t)(t0 + i4 + i);
                    a0[i] = __builtin_nontemporal_load((const v4u*)(U + t * NUP + ug)); b0[i] = __builtin_nontemporal_load((const v4u*)(U + t * NUP + ug + 128)); }
#pragma unroll
                for (int i = 0; i < 4; ++i) { const size_t t = (size_t)(t0 + i4 + i);
                    float g0[8], v0[8], o[8];
#pragma unroll
                    for (int q = 0; q < 4; ++q) { g0[2 * q] = pg8::bflo(a0[i][q]); g0[2 * q + 1] = pg8::bfhi(a0[i][q]); v0[2 * q] = pg8::bflo(b0[i][q]); v0[2 * q + 1] = pg8::bfhi(b0[i][q]); }
#pragma unroll
                    for (int j = 0; j < 8; ++j) { const float gt_ = fmaf(wg[0][j], g2[j], fmaf(wg[1][j], g1[j], fmaf(wg[2][j], g0[j], bg[j])));
                        const float vl = fmaf(wv[0][j], v2[j], fmaf(wv[1][j], v1[j], fmaf(wv[2][j], v0[j], bv[j])));
                        o[j] = gt_ * pg8::sigm(gt_) * vl; g2[j] = g1[j]; g1[j] = g0[j]; v2[j] = v1[j]; v1[j] = v0[j]; }
                    v4u w; w.x = pk2(o[0], o[1]); w.y = pk2(o[2], o[3]); w.z = pk2(o[4], o[5]); w.w = pk2(o[6], o[7]);
                    *(v4u*)(ACT + t * DFF + c) = w; } }
        }
    }
#endif
    #if !FUSED_CONV
    xcd_barrier(xbar);
#endif

#if !defined(ONLY) || ONLY == 7
    _Pragma("unroll 1") for (int rep_ = 0; rep_ < REPS(7); ++rep_) {
        if (rep_ > 0) xcd_barrier(xbar);
        IDS();
        pg8::StaticOrder S; S.init(M, DM, G, bx);
#if FUSED_CONV
        {
            OPQ(); const float* w_conv = INP(13); const float* b_conv = INP(14); pg8::Unit u0;
            if (S.next(0, u0)) {
                for (int i = tid; i < 4 * DFF; i += NWAVES * 64) { const int gq = i / DFF, c = i - gq * DFF, Gi = 4 * u0.pm + gq; const bool first = (Gi & 31) == 0;
                    const float* up = US + (size_t)Gi * 4 * NUP;
                    float cv[2][2];
#pragma unroll
                    for (int bj = 0; bj < 2; ++bj) { const int uc = bj * DFF + c; const float u0v = first ? 0.f : up[uc], u1v = first ? 0.f : up[NUP + uc], u2v = up[2 * NUP + uc], u3v = up[3 * NUP + uc];
                        const float w0 = w_conv[uc], w1 = w_conv[NUP + uc], w2 = w_conv[2 * NUP + uc], bb = b_conv[uc];
                        cv[bj][0] = fmaf(w0, u0v, fmaf(w1, u1v, fmaf(w2, u2v, bb))); cv[bj][1] = fmaf(w0, u1v, fmaf(w1, u2v, fmaf(w2, u3v, bb))); }
#pragma unroll
                    for (int t = 0; t < 2; ++t) { const float gte = cv[0][t]; ACT[(size_t)(64 * Gi + t) * DFF + c] = (bf16)f2bf(gte * pg8::sigm(gte) * cv[1][t]); } }
            }
            asm volatile("s_waitcnt vmcnt(0)" ::: "memory"); __threadfence(); __syncthreads();
        }
#endif
        pg8::Gemm g{ACT, Wdn_t, M, DM, DFF};
        pg8::EpiFinal E{XB, out};
        pg8::gemm_phase<pg8::EpiFinal, pg8::StaticOrder, true, true>(lds3, g, S, E);
    }
#endif
}

extern "C" void kernel_launch(void* const* d_in, const int* in_sizes, int n_in, void* d_out, int out_size, void* d_ws, size_t ws_size, hipStream_t stream) {
    static int grid = 0;
    if (grid == 0) {
        if (n_in != 16 || in_sizes[0] != M * DM || out_size != M * DM || ws_size < WS_END) { fprintf(stderr, "kernel_launch: unexpected shapes (n_in %d, in0 %d, out %d, ws %zu)\n", n_in, n_in > 0 ? in_sizes[0] : -1, out_size, ws_size); grid = -1; return; }
        int dev = 0, cus = 0, per_cu = 0;
        (void)hipGetDevice(&dev); (void)hipDeviceGetAttribute(&cus, hipDeviceAttributeMultiprocessorCount, dev);
        if (hipFuncSetAttribute((const void*)fwd_mega, hipFuncAttributeMaxDynamicSharedMemorySize, LDS_BYTES) != hipSuccess) { fprintf(stderr, "kernel_launch: hipFuncSetAttribute failed\n"); grid = -1; return; }
        if (hipOccupancyMaxActiveBlocksPerMultiprocessor(&per_cu, (const void*)fwd_mega, NWAVES * 64, LDS_BYTES) != hipSuccess || per_cu < 1) { fprintf(stderr, "kernel_launch: occupancy query says %d\n", per_cu); per_cu = 1; }
        (void)hipGetLastError();
        grid = cus * 1;
        if (grid != 256) fprintf(stderr, "kernel_launch: %d CUs; the single-unit GEMM phases assume 256\n", grid);
    }
    if (grid < 0) return;
    if (hipMemsetAsync(d_ws, 0, 128 * 1024, stream) != hipSuccess) { fprintf(stderr, "kernel_launch: hipMemsetAsync failed\n"); return; }
    Args a{};
    for (int i = 0; i < 16; ++i) a.in[i] = (const float*)d_in[i];
    a.out = (float*)d_out; a.ws = (unsigned char*)d_ws;
    void* kargs[] = {&a};
    hipError_t e = hipLaunchCooperativeKernel((const void*)fwd_mega, dim3(grid), dim3(NWAVES * 64), kargs, LDS_BYTES, stream);
    if (e != hipSuccess) fprintf(stderr, "cooperative launch failed: %s (grid %d)\n", hipGetErrorString(e), grid);
}
```

```cpp
#include <hip/hip_runtime.h>
#include <hip/hip_cooperative_groups.h>
#include <cstdio>
#include <cstdint>
namespace cg = cooperative_groups;
namespace pg8 {
#define PG8_LAS __attribute__((address_space(3)))
typedef unsigned short bf16_t;
typedef short bf16x8 __attribute__((ext_vector_type(8)));
typedef float f32x4 __attribute__((ext_vector_type(4)));
typedef unsigned u32x4 __attribute__((ext_vector_type(4)));
constexpr int BM = 256, BK = 64, HALF = 128, HTB = HALF * BK * 2  , STAGE_BYTES = 8 * HTB, NXCD = 8, WGM = 4;

__host__ __device__ __forceinline__ int lds_byte(int r, int c) { const int st = (r >> 4) * 2 + (c >> 5), rr = r & 15, cc = c & 31, ob = rr * 64 + cc * 2; return st * 1024 + (ob ^ (((ob >> 9) & 1) << 5)); }
__host__ __device__ __forceinline__ void stage_rc(int b, int& R, int& C) { const int st = b / 1024, sb = b % 1024, swz = sb ^ (((sb >> 9) & 1) << 5); R = (st >> 1) * 16 + swz / 64; C = (st & 1) * 32 + (swz % 64) / 2; }
__host__ __device__ __forceinline__ int perm32(int rho) { const int n = rho >> 4, i = rho & 15; return 8 * (i >> 2) + 4 * n + (i & 3); }

struct Unit { int pm, pn; };
struct Gemm { const bf16_t* A; const bf16_t* Bt; int M, N, K; };

struct StaticOrder {
    int nM, nN, nwg, G, c;
    __host__ __device__ void init(int M, int N, int G_, int c_) { nM = M / BM; nN = N / BM; nwg = nM * nN; G = G_; c = c_; }
    __host__ __device__ bool next(int i, Unit& u) const {
        const long L = (long)i * G + c; if (L >= nwg) return false;
        int wgid = (int)L; { const int q = nwg / NXCD, r = nwg % NXCD, xcd = wgid % NXCD, off = wgid / NXCD; wgid = (xcd < r ? xcd * (q + 1) : r * (q + 1) + (xcd - r) * q) + off; }
        const int nig = WGM * nN, gid = wgid / nig, fm = gid * WGM, gsz = (nM - fm) < WGM ? (nM - fm) : WGM;
        u.pm = fm + ((wgid % nig) % gsz); u.pn = (wgid % nig) / gsz; return true;
    }
    __device__ __forceinline__ void a_ready(const Unit&) const {}
    __device__ __forceinline__ void done(const Unit&) const {}
};

__device__ __forceinline__ unsigned cvt_pk_bf16(float lo, float hi) { unsigned r; asm volatile("v_cvt_pk_bf16_f32 %0, %1, %2" : "=v"(r) : "v"(lo), "v"(hi)); return r; }
typedef unsigned u32x4e __attribute__((ext_vector_type(4)));
constexpr float LOG2E = 1.4426950408889634f;
constexpr float EPSN = 1e-6f;
constexpr float QSCALE = 0.08838834764831845f * 1.4426950408889634f;
__device__ __forceinline__ float sigm(float x) { return __builtin_amdgcn_rcpf(1.f + __builtin_amdgcn_exp2f(-x * LOG2E)); }
__device__ __forceinline__ float bflo(unsigned w) { return __uint_as_float(w << 16); }
__device__ __forceinline__ float bfhi(unsigned w) { return __uint_as_float(w & 0xffff0000u); }
__device__ __forceinline__ u32x4e pack8f(const f32x4 a, const f32x4 b) { u32x4e w; w.x = cvt_pk_bf16(a[0], a[1]); w.y = cvt_pk_bf16(a[2], a[3]); w.z = cvt_pk_bf16(b[0], b[1]); w.w = cvt_pk_bf16(b[2], b[3]); return w; }
#define EPI_LDSBAR() do { asm volatile("s_waitcnt lgkmcnt(0)" ::: "memory"); __builtin_amdgcn_s_barrier(); asm volatile("" ::: "memory"); } while (0)

struct EpiProj {
    static constexpr bool PERM = true, AFTER_DRAIN = false, HAS_MID = false;
    bf16_t* QKV; bf16_t* GATES; const float* gains; PG8_LAS float* xl;
    __device__ __forceinline__ void operator()(f32x4 (&acc)[2][2][4][2], const Unit& u, int wr, int wc, int fr, int fq) const {
        const int colt = u.pn * BM, row0 = u.pm * BM + wr * 64 + fr, seg = colt >> 10;
        const bool norm = (seg == 0) | (seg == 1) | (seg == 3) | (seg == 4);
        if (!norm) {
            bf16_t* base; int ldc, col0;
            if (colt >= 6144) { base = GATES; ldc = 4096; col0 = colt - 6144; } else { base = QKV; ldc = 6144; col0 = colt; }
            col0 += wc * 32 + 8 * fq;
#pragma unroll
            for (int ai = 0; ai < 2; ++ai)
#pragma unroll
                for (int m = 0; m < 4; ++m) { bf16_t* rowp = base + (size_t)(row0 + ai * HALF + m * 16) * ldc + col0;
#pragma unroll
                    for (int bj = 0; bj < 2; ++bj) *(u32x4e*)(rowp + bj * HALF) = pack8f(acc[ai][bj][m][0], acc[ai][bj][m][1]); }
        } else {
#pragma unroll
            for (int ai = 0; ai < 2; ++ai)
#pragma unroll
                for (int m = 0; m < 4; ++m)
#pragma unroll
                    for (int bj = 0; bj < 2; ++bj) { const f32x4 a = acc[ai][bj][m][0], b = acc[ai][bj][m][1];
                        float s = (a[0] * a[0] + a[1] * a[1]) + (a[2] * a[2] + a[3] * a[3]) + (b[0] * b[0] + b[1] * b[1]) + (b[2] * b[2] + b[3] * b[3]);
                        s += __shfl_xor(s, 16); s += __shfl_xor(s, 32);
                        if (fq == 0) xl[((ai * HALF + wr * 64 + m * 16 + fr) * 2 + bj) * 4 + wc] = s; }
            EPI_LDSBAR();
            const float* gp = gains + (seg - (seg >= 3 ? 1 : 0)) * 1024 + (colt & 1023) + wc * 32 + 8 * fq;
            const float qs = (seg == 0 || seg == 3) ? QSCALE : 1.f;
            f32x4 g[2][2];
#pragma unroll
            for (int bj = 0; bj < 2; ++bj)
#pragma unroll
                for (int n = 0; n < 2; ++n) g[bj][n] = *(const f32x4*)(gp + bj * HALF + 4 * n) * qs;
            bf16_t* base = QKV + colt + wc * 32 + 8 * fq;
#pragma unroll
            for (int ai = 0; ai < 2; ++ai)
#pragma unroll
                for (int m = 0; m < 4; ++m) { bf16_t* rowp = base + (size_t)(row0 + ai * HALF + m * 16) * 6144;
#pragma unroll
                    for (int bj = 0; bj < 2; ++bj) { const f32x4 p = *(const PG8_LAS f32x4*)(xl + ((ai * HALF + wr * 64 + m * 16 + fr) * 2 + bj) * 4);
                        const float rs = __builtin_amdgcn_rsqf(((p[0] + p[1]) + (p[2] + p[3])) * (1.f / 128.f) + EPSN);
                        *(u32x4e*)(rowp + bj * HALF) = pack8f(acc[ai][bj][m][0] * rs * g[bj][0], acc[ai][bj][m][1] * rs * g[bj][1]); } }
        }
    }
};

__device__ __forceinline__ void gate8(const bf16_t* p, f32x4& s0, f32x4& s1) {
    const u32x4e w = *(const u32x4e*)p;
    s0[0] = sigm(bflo(w.x)); s0[1] = sigm(bfhi(w.x)); s0[2] = sigm(bflo(w.y)); s0[3] = sigm(bfhi(w.y));
    s1[0] = sigm(bflo(w.z)); s1[1] = sigm(bfhi(w.z)); s1[2] = sigm(bflo(w.w)); s1[3] = sigm(bfhi(w.w));
}
struct EpiBr {
    static constexpr bool PERM = true, AFTER_DRAIN = false, HAS_MID = true;
    const bf16_t* G; bf16_t* MG;
    __device__ __forceinline__ void mid(f32x4 (&acc)[2][2][4][2], const Unit& u, int wr, int wc, int fr_in, int fq_in) const {
        (void)fr_in; (void)fq_in; int ln_ = (int)(threadIdx.x & 63u); asm volatile("" : "+v"(ln_)); const int fr = ln_ & 15, fq = ln_ >> 4;
        const int row0 = u.pm * BM + wr * 64 + fr, col0 = u.pn * BM + wc * 32 + 8 * fq;
#define RAT(x, y) ((1.f + __builtin_amdgcn_exp2f(-(y) * LOG2E)) * __builtin_amdgcn_rcpf(1.f + __builtin_amdgcn_exp2f(-(x) * LOG2E)))
#pragma unroll
        for (int ai = 0; ai < 2; ++ai) {
            u32x4e ga[4][2], gb[4][2];
#pragma unroll
            for (int m = 0; m < 4; ++m)
#pragma unroll
                for (int bj = 0; bj < 2; ++bj) { const bf16_t* gp = G + (size_t)(row0 + ai * HALF + m * 16) * 4096 + col0 + bj * HALF; ga[m][bj] = *(const u32x4e*)gp; gb[m][bj] = *(const u32x4e*)(gp + 2048); }
#pragma unroll
            for (int m = 0; m < 4; ++m)
#pragma unroll
                for (int bj = 0; bj < 2; ++bj) { const u32x4e a = ga[m][bj], b = gb[m][bj]; f32x4 r0, r1;
                    r0[0] = RAT(bflo(a.x), bflo(b.x)); r0[1] = RAT(bfhi(a.x), bfhi(b.x)); r0[2] = RAT(bflo(a.y), bflo(b.y)); r0[3] = RAT(bfhi(a.y), bfhi(b.y));
                    r1[0] = RAT(bflo(a.z), bflo(b.z)); r1[1] = RAT(bfhi(a.z), bfhi(b.z)); r1[2] = RAT(bflo(a.w), bflo(b.w)); r1[3] = RAT(bfhi(a.w), bfhi(b.w));
                    acc[ai][bj][m][0] = acc[ai][bj][m][0] * r0; acc[ai][bj][m][1] = acc[ai][bj][m][1] * r1; }
            asm volatile("" ::: "memory"); __builtin_amdgcn_sched_barrier(0); }
#undef RAT
    }
    __device__ __forceinline__ void operator()(f32x4 (&acc)[2][2][4][2], const Unit& u, int wr, int wc, int fr, int fq) const {
        const int row0 = u.pm * BM + wr * 64 + fr, col0 = u.pn * BM + wc * 32 + 8 * fq;
#pragma unroll
        for (int ai = 0; ai < 2; ++ai)
#pragma unroll
            for (int m = 0; m < 4; ++m) { const size_t row = (size_t)(row0 + ai * HALF + m * 16);
#pragma unroll
                for (int bj = 0; bj < 2; ++bj) { const int col = col0 + bj * HALF; f32x4 s0, s1; gate8(G + row * 4096 + 2048 + col, s0, s1);
                    *(u32x4e*)(MG + row * 2048 + col) = pack8f(acc[ai][bj][m][0] * s0, acc[ai][bj][m][1] * s1); } }
    }
};
struct EpiOut {
    static constexpr bool PERM = true, AFTER_DRAIN = true, HAS_MID = false;
    const float* X; bf16_t* XB; float* SSQ;
    __device__ __forceinline__ void fused(f32x4 (&acc)[2][2][4][2], const Unit& u, int wr, int wc, int fr, int fq, PG8_LAS unsigned char* lds, int wid, int lane) const {
        PG8_LAS float* P = (PG8_LAS float*)lds;
        const int row0 = u.pm * BM + wr * 64 + fr, col0 = u.pn * BM + wc * 32 + 8 * fq;
#pragma unroll
        for (int ai = 0; ai < 2; ++ai)
#pragma unroll
            for (int m = 0; m < 4; ++m) { const size_t row = (size_t)(row0 + ai * HALF + m * 16); float ss = 0.f;
#pragma unroll
                for (int bj = 0; bj < 2; ++bj) { const size_t off = row * 2048 + col0 + bj * HALF;
                    const f32x4 v0 = acc[ai][bj][m][0] + __builtin_nontemporal_load((const f32x4*)(X + off)), v1 = acc[ai][bj][m][1] + __builtin_nontemporal_load((const f32x4*)(X + off + 4));
                    *(u32x4e*)(XB + off) = pack8f(v0, v1);
                    ss += (v0[0] * v0[0] + v0[1] * v0[1]) + (v0[2] * v0[2] + v0[3] * v0[3]) + (v1[0] * v1[0] + v1[1] * v1[1]) + (v1[2] * v1[2] + v1[3] * v1[3]); }
                ss += __shfl_xor(ss, 16); ss += __shfl_xor(ss, 32);
                if (fq == 0) P[(ai * HALF + wr * 64 + m * 16 + fr) * 4 + wc] = ss; }
        EPI_LDSBAR();
        const int tid = wid * 64 + lane;
        if (tid < 256) { const f32x4 p = *(const PG8_LAS f32x4*)(P + tid * 4); SSQ[(size_t)(u.pm * BM + tid) * 8 + u.pn] = (p[0] + p[1]) + (p[2] + p[3]); }
    }
};
#ifndef CONV_LDSW
#define CONV_LDSW 0
#endif
__device__ __forceinline__ float ror1f(float v) { return __builtin_bit_cast(float, __builtin_amdgcn_update_dpp(0, __builtin_bit_cast(int, v), 0x121, 0xf, 0xf, false)); }
__device__ __forceinline__ float ror2f(float v) { return __builtin_bit_cast(float, __builtin_amdgcn_update_dpp(0, __builtin_bit_cast(int, v), 0x122, 0xf, 0xf, false)); }
struct EpiUpConv {
    static constexpr bool PERM = true, AFTER_DRAIN = false, HAS_MID = false;
    const float* RSTD; const float* wconv; const float* bconv; bf16_t* ACT; float* US; PG8_LAS float* xl;
    __device__ __forceinline__ void operator()(f32x4 (&acc)[2][2][4][2], const Unit& u, int wr, int wc, int fr_in, int fq_in) const {
        typedef unsigned u32x2e __attribute__((ext_vector_type(2)));
        PG8_LAS float* wl = xl + (unsigned)(wr * 4 + wc) * 256u;
        { const unsigned L_ = threadIdx.x & 63u, ucol_ = (L_ >> 5) * 5632u + (unsigned)u.pn * 128u + (unsigned)wc * 32u + (L_ & 31u);
          const float t0_ = wconv[ucol_], t1_ = wconv[11264u + ucol_], t2_ = wconv[22528u + ucol_], t3_ = bconv[ucol_];
          wl[L_] = t0_; wl[64u + L_] = t1_; wl[128u + L_] = t2_; wl[192u + L_] = t3_;
          asm volatile("s_waitcnt lgkmcnt(0)" ::: "memory"); }
        (void)fr_in; (void)fq_in; int ln_ = (int)(threadIdx.x & 63u); asm volatile("" : "+v"(ln_)); const int fr = ln_ & 15, fq = ln_ >> 4;
        const unsigned cw = (unsigned)(u.pn * 128 + wc * 32 + 8 * fq), row0 = (unsigned)(u.pm * BM + wr * 64 + fr);
        const bool lo = fr < 2, hi14 = fr >= 14, f1 = fr >= 1, f2 = fr >= 2;
#pragma unroll
        for (int ai = 0; ai < 2; ++ai) { const unsigned G = (unsigned)(4 * u.pm + 2 * ai + wr);
            float rs[4];
#pragma unroll
            for (int m = 0; m < 4; ++m) rs[m] = RSTD[row0 + ai * HALF + m * 16];
            const unsigned aoff = (row0 + ai * HALF) * 5632u + cw;
            const unsigned us_lo = (G * 4 + 2 + (fr & 1)) * 11264u; const bool sthi = hi14 && (G + 1 < 128);
#pragma unroll
            for (int n = 0; n < 2; ++n) {
#pragma unroll
                for (int j = 0; j < 4; ++j) { unsigned col = cw + 4 * n + j; asm volatile("" : "+v"(col));
#pragma unroll
                    for (int bj = 0; bj < 2; ++bj) { const unsigned ucol = bj * 5632 + col;
                        const unsigned lc = (unsigned)bj * 32u + (col - (unsigned)u.pn * 128u - (unsigned)wc * 32u);
                        const float w0 = wl[lc], w1 = wl[64u + lc], w2 = wl[128u + lc], bb = wl[192u + lc];
                        float pa1 = 0.f, pa2 = 0.f;
#pragma unroll
                        for (int m = 0; m < 4; ++m) { const float uu = acc[ai][bj][m][n][j] * rs[m];
                            if (m == 0) { if (lo) US[us_lo + ucol] = uu; }
                            if (m == 3) { if (sthi) US[us_lo + 22528u + ucol] = uu; }
                            const float a1 = ror1f(uu), a2 = ror2f(uu);
                            const float p1 = f1 ? a1 : pa1, p2 = f2 ? a2 : pa2;
                            acc[ai][bj][m][n][j] = fmaf(w0, p2, fmaf(w1, p1, fmaf(w2, uu, bb)));
                            pa1 = a1; pa2 = a2; }
                        }
#pragma unroll
                    for (int m = 0; m < 4; ++m) { const float g0 = acc[ai][0][m][n][j]; acc[ai][0][m][n][j] = g0 * sigm(g0) * acc[ai][1][m][n][j]; }
                    asm volatile("" ::: "memory"); }
#pragma unroll
                for (int m = 0; m < 4; ++m) { u32x2e w; w.x = cvt_pk_bf16(acc[ai][0][m][n][0], acc[ai][0][m][n][1]); w.y = cvt_pk_bf16(acc[ai][0][m][n][2], acc[ai][0][m][n][3]);
                    if (!(m == 0 && lo)) *(u32x2e*)(ACT + (aoff + (unsigned)(m * 16 * 5632 + 4 * n))) = w; }
                asm volatile("" ::: "memory"); __builtin_amdgcn_sched_barrier(0); } }
    }
};
struct EpiUp {
    static constexpr bool PERM = true, AFTER_DRAIN = false, HAS_MID = false;
    const float* RSTD; bf16_t* U;
    __device__ __forceinline__ void operator()(f32x4 (&acc)[2][2][4][2], const Unit& u, int wr, int wc, int fr, int fq) const {
        const int row0 = u.pm * BM + wr * 64 + fr, col0 = u.pn * BM + wc * 32 + 8 * fq;
#pragma unroll
        for (int ai = 0; ai < 2; ++ai)
#pragma unroll
            for (int m = 0; m < 4; ++m) { const int row = row0 + ai * HALF + m * 16; const float rs = RSTD[row]; bf16_t* rowp = U + (size_t)row * 11264 + col0;
#pragma unroll
                for (int bj = 0; bj < 2; ++bj) *(u32x4e*)(rowp + bj * HALF) = pack8f(acc[ai][bj][m][0] * rs, acc[ai][bj][m][1] * rs); }
    }
};
struct EpiFinal {
    static constexpr bool PERM = true, AFTER_DRAIN = false, HAS_MID = false;
    const bf16_t* XB; float* OUT;
    __device__ __forceinline__ void operator()(f32x4 (&acc)[2][2][4][2], const Unit& u, int wr, int wc, int fr, int fq) const {
        const int row0 = u.pm * BM + wr * 64 + fr, col0 = u.pn * BM + wc * 32 + 8 * fq;
#pragma unroll
        for (int ai = 0; ai < 2; ++ai)
#pragma unroll
            for (int m = 0; m < 4; ++m)
#pragma unroll
                for (int bj = 0; bj < 2; ++bj) { const size_t off = (size_t)(row0 + ai * HALF + m * 16) * 2048 + col0 + bj * HALF;
                    const u32x4e w = __builtin_nontemporal_load((const u32x4e*)(XB + off));
                    const f32x4 a = {bflo(w.x), bfhi(w.x), bflo(w.y), bfhi(w.y)}, b = {bflo(w.z), bfhi(w.z), bflo(w.w), bfhi(w.w)};
                    __builtin_nontemporal_store(a + acc[ai][bj][m][0], (f32x4*)(OUT + off)); __builtin_nontemporal_store(b + acc[ai][bj][m][1], (f32x4*)(OUT + off + 4)); }
    }
};

template <class Epi, class Sched, bool ALIGN_EPI = false, bool SP2 = false>
__device__ __forceinline__ void gemm_phase(PG8_LAS unsigned char* lds, const Gemm g, const Sched& S, const Epi& E) {
    int tid_o = threadIdx.x; asm volatile("" : "+v"(tid_o));
    const int tid = tid_o, wid = __builtin_amdgcn_readfirstlane(tid >> 6), lane = tid & 63, wr = wid >> 2, wc = wid & 3, fr = lane & 15, fq = lane >> 4;
    const int K = g.K, nt = K / BK;
    unsigned voffA[1], voffB[1];
#pragma unroll
    for (int i = 0; i < 1; ++i) { int R, C; stage_rc(tid * 16 + i * 8192, R, C); const int Rb = Epi::PERM ? ((R & ~31) + perm32(R & 31)) : R;
        voffA[i] = (unsigned)(R * K + C) * 2u; voffB[i] = (unsigned)(Rb * K + C) * 2u; }
    const size_t vstep = (size_t)K * 128;
    const size_t kstep = (size_t)(BK * 2);
    const size_t hstep = (size_t)HALF * K * 2;
    const size_t tstep = 2 * hstep;
    const unsigned ldsw = (unsigned)wid * 1024u;
    const int aoff = lds_byte(wr * 64 + fr, fq * 8), boff = lds_byte(wc * 32 + fr, fq * 8);
#define PG8_SA(b, h) (((b) * 2 + (h)) * HTB)
#define PG8_SB(b, h) ((4 + (b) * 2 + (h)) * HTB)
#define PG8_STAGE(bufoff, gbase, voff) do { _Pragma("unroll") for (int _i = 0; _i < 2; ++_i) \
        __builtin_amdgcn_global_load_lds((const unsigned*)((const char*)(gbase) + (size_t)_i * vstep + (voff)[0]), (PG8_LAS unsigned*)(lds + (bufoff) + ldsw + _i * 8192), 16, 0, 0); } while (0)
#define PG8_LDA(dst, b, h) do { _Pragma("unroll") for (int m = 0; m < 4; ++m) _Pragma("unroll") for (int k = 0; k < 2; ++k) dst[m][k] = *(const PG8_LAS bf16x8*)(lds + PG8_SA(b, h) + aoff + m * 2048 + k * 1024); } while (0)
#define PG8_LDB(dst, b, h) do { _Pragma("unroll") for (int n = 0; n < 2; ++n) _Pragma("unroll") for (int k = 0; k < 2; ++k) dst[n][k] = *(const PG8_LAS bf16x8*)(lds + PG8_SB(b, h) + boff + n * 2048 + k * 1024); } while (0)
#define PG8_MMA(ai, bj, At, Bt) do { __builtin_amdgcn_s_setprio(1); _Pragma("unroll") for (int m = 0; m < 4; ++m) _Pragma("unroll") for (int n = 0; n < 2; ++n) _Pragma("unroll") for (int k = 0; k < 2; ++k) \
        acc[ai][bj][m][n] = __builtin_amdgcn_mfma_f32_16x16x32_bf16(Bt[n][k], At[m][k], acc[ai][bj][m][n], 0, 0, 0); __builtin_amdgcn_s_setprio(0); } while (0)
#define PG8_WAIT_V(n) asm volatile("s_waitcnt vmcnt(" #n ")" ::: "memory")
#define PG8_WAIT_L(n) asm volatile("s_waitcnt lgkmcnt(" #n ")" ::: "memory")
#define PG8_BAR __builtin_amdgcn_s_barrier()
#define PG8_SCHED __builtin_amdgcn_sched_barrier(0)
    Unit cur, nxt; int ui = 0;
    if (!S.next(0, cur)) return;
    f32x4 acc[2][2][4][2];
#pragma unroll
    for (int a = 0; a < 2; ++a)
#pragma unroll
        for (int b = 0; b < 2; ++b)
#pragma unroll
            for (int m = 0; m < 4; ++m)
#pragma unroll
                for (int n = 0; n < 2; ++n) acc[a][b][m][n] = (f32x4){0.f, 0.f, 0.f, 0.f};
    bf16x8 At[4][2], B0[2][2], B1[2][2];
    const char* cA = (const char*)g.A + (size_t)cur.pm * tstep; const char* cB = (const char*)g.Bt + (size_t)cur.pn * tstep;
    S.a_ready(cur);
    if constexpr (SP2) {
        PG8_STAGE(PG8_SB(0, 0), cB, voffB); PG8_STAGE(PG8_SB(0, 1), cB + hstep, voffB); PG8_STAGE(PG8_SA(0, 0), cA, voffA); PG8_STAGE(PG8_SA(0, 1), cA + hstep, voffA);
        if (wr == 1) PG8_BAR;
        PG8_WAIT_V(2); PG8_BAR;
        PG8_STAGE(PG8_SB(1, 0), cB + kstep, voffB); PG8_STAGE(PG8_SA(1, 0), cA + kstep, voffA); PG8_STAGE(PG8_SB(1, 1), cB + hstep + kstep, voffB);
        PG8_WAIT_V(6); PG8_BAR;
    } else {
        PG8_STAGE(PG8_SB(0, 0), cB, voffB); PG8_STAGE(PG8_SA(0, 0), cA, voffA); PG8_STAGE(PG8_SB(0, 1), cB + hstep, voffB); PG8_STAGE(PG8_SA(0, 1), cA + hstep, voffA);
        if (wr == 1) PG8_BAR;
        PG8_WAIT_V(4); PG8_BAR;
        PG8_STAGE(PG8_SB(1, 0), cB + kstep, voffB); PG8_STAGE(PG8_SA(1, 0), cA + kstep, voffA); PG8_STAGE(PG8_SB(1, 1), cB + hstep + kstep, voffB);
        PG8_WAIT_V(6); PG8_BAR;
    }
    for (;;) {
        const bool has_next = S.next(ui + 1, nxt);
        const char* nA = has_next ? (const char*)g.A + (size_t)nxt.pm * tstep : cA; const char* nB = has_next ? (const char*)g.Bt + (size_t)nxt.pn * tstep : cB;
        for (int t = 0; t < nt; t += 2) {
            if constexpr (Epi::HAS_MID) { if (t == (nt >> 1)) E.mid(acc, cur, wr, wc, fr, fq); }
            const bool last = (t == nt - 2);
            const char* a1 = cA + (size_t)(t + 1) * kstep;
            const char* a2 = last ? nA : cA + (size_t)(t + 2) * kstep; const char* b2 = last ? nB : cB + (size_t)(t + 2) * kstep;
            const char* a3 = a2 + kstep; const char* b3 = b2 + kstep;
            if (last && has_next) S.a_ready(nxt);
            if constexpr (SP2) {
            PG8_LDB(B0, 0, 0); PG8_LDB(B1, 0, 1); PG8_SCHED; PG8_LDA(At, 0, 0); PG8_STAGE(PG8_SA(1, 1), a1 + hstep, voffA);
            PG8_WAIT_V(8); PG8_WAIT_L(0); PG8_BAR; PG8_MMA(0, 0, At, B0); PG8_MMA(0, 1, At, B1); PG8_BAR; PG8_SCHED;
            PG8_LDA(At, 0, 1); PG8_STAGE(PG8_SB(0, 0), b2, voffB); PG8_STAGE(PG8_SB(0, 1), b2 + hstep, voffB); PG8_STAGE(PG8_SA(0, 0), a2, voffA);
            PG8_WAIT_V(8); PG8_WAIT_L(0); PG8_BAR; PG8_MMA(1, 0, At, B0); PG8_MMA(1, 1, At, B1); PG8_BAR; PG8_SCHED;
            PG8_LDB(B0, 1, 0); PG8_LDB(B1, 1, 1); PG8_SCHED; PG8_LDA(At, 1, 0); PG8_STAGE(PG8_SA(0, 1), a2 + hstep, voffA);
            PG8_WAIT_V(8); PG8_WAIT_L(0); PG8_BAR; PG8_MMA(0, 0, At, B0); PG8_MMA(0, 1, At, B1); PG8_BAR; PG8_SCHED;
            PG8_LDA(At, 1, 1); PG8_STAGE(PG8_SB(1, 0), b3, voffB); PG8_STAGE(PG8_SB(1, 1), b3 + hstep, voffB); PG8_STAGE(PG8_SA(1, 0), a3, voffA);
            PG8_WAIT_V(8); PG8_WAIT_L(0); PG8_BAR; PG8_MMA(1, 0, At, B0); PG8_MMA(1, 1, At, B1); PG8_BAR; PG8_SCHED;
            } else {
            PG8_LDB(B0, 0, 0); PG8_SCHED; PG8_LDA(At, 0, 0); PG8_STAGE(PG8_SA(1, 1), a1 + hstep, voffA);
            PG8_WAIT_L(8); PG8_BAR; PG8_WAIT_L(0); PG8_MMA(0, 0, At, B0); PG8_BAR; PG8_SCHED;
            PG8_LDB(B1, 0, 1); PG8_STAGE(PG8_SB(0, 0), b2, voffB);
            PG8_BAR; PG8_WAIT_L(0); PG8_MMA(0, 1, At, B1); PG8_BAR;
            PG8_LDA(At, 0, 1); PG8_STAGE(PG8_SA(0, 0), a2, voffA);
            PG8_BAR; PG8_WAIT_L(0); PG8_MMA(1, 0, At, B0); PG8_BAR; PG8_SCHED;
            PG8_STAGE(PG8_SB(0, 1), b2 + hstep, voffB);
            PG8_WAIT_V(6); PG8_BAR; PG8_MMA(1, 1, At, B1); PG8_BAR;
            PG8_LDB(B0, 1, 0); PG8_SCHED; PG8_LDA(At, 1, 0); PG8_STAGE(PG8_SA(0, 1), a2 + hstep, voffA);
            PG8_WAIT_L(8); PG8_BAR; PG8_WAIT_L(0); PG8_MMA(0, 0, At, B0); PG8_BAR; PG8_SCHED;
            PG8_LDB(B1, 1, 1); PG8_STAGE(PG8_SB(1, 0), b3, voffB);
            PG8_BAR; PG8_WAIT_L(0); PG8_MMA(0, 1, At, B1); PG8_BAR;
            PG8_LDA(At, 1, 1); PG8_STAGE(PG8_SA(1, 0), a3, voffA);
            PG8_BAR; PG8_WAIT_L(0); PG8_MMA(1, 0, At, B0); PG8_BAR; PG8_SCHED;
            PG8_STAGE(PG8_SB(1, 1), b3 + hstep, voffB);
            PG8_WAIT_V(6); PG8_BAR; PG8_MMA(1, 1, At, B1); PG8_BAR;
            }
        }
        if constexpr (ALIGN_EPI) { if (wr == 0) PG8_BAR; }
        if constexpr (!Epi::AFTER_DRAIN) { E(acc, cur, wr, wc, fr, fq); S.done(cur); }
        if (!has_next) break;
#pragma unroll
        for (int a = 0; a < 2; ++a)
#pragma unroll
            for (int b = 0; b < 2; ++b)
#pragma unroll
                for (int m = 0; m < 4; ++m)
#pragma unroll
                    for (int n = 0; n < 2; ++n) acc[a][b][m][n] = (f32x4){0.f, 0.f, 0.f, 0.f};
        cur = nxt; cA = nA; cB = nB; ++ui;
        if constexpr (ALIGN_EPI) { if (wr == 1) PG8_BAR; }
    }
    PG8_WAIT_V(0);
    if constexpr (!ALIGN_EPI) { if (wr == 0) PG8_BAR; }
    PG8_BAR;
    if constexpr (Epi::AFTER_DRAIN) { E.fused(acc, cur, wr, wc, fr, fq, lds, wid, lane); S.done(cur); }
#undef PG8_SA
#undef PG8_SB
#undef PG8_STAGE
#undef PG8_LDA
#undef PG8_LDB
#undef PG8_MMA
#undef PG8_WAIT_V
#undef PG8_WAIT_L
#undef PG8_BAR
#undef PG8_SCHED
}
}

namespace att {
typedef unsigned short bf16;
constexpr int D = 128, NW = 8, QBLK = 32, KVBLK = 64, QB = NW * QBLK;
constexpr int SHM_V = KVBLK * D * 2, SHM_K = KVBLK * D * 2;
constexpr int LDS_WS = 2 * SHM_V + 2 * SHM_K, LDS_KB = LDS_WS + NW * 64 * 4, LDS_SLOT = LDS_KB + 2 * 64 * 4, LDS_Q = LDS_SLOT + 256, LDS_END = LDS_Q + NW * 8192;
constexpr float SCALE = 1.f, THR = 8.f;
typedef short bf16x8 __attribute__((ext_vector_type(8)));
typedef short s16x4 __attribute__((ext_vector_type(4)));
typedef float f32x16 __attribute__((ext_vector_type(16)));
typedef float f32x4 __attribute__((ext_vector_type(4)));
typedef unsigned u32x4 __attribute__((ext_vector_type(4)));
template <class A, class Bt> struct same_t { static constexpr bool v = false; };
template <class A> struct same_t<A, A> { static constexpr bool v = true; };

#define KSWZ(row, colB) ((row) * 256 + ((colB) ^ (((row) & 7) << 4)))
#define SBAR() __builtin_amdgcn_sched_barrier(0)
__device__ __forceinline__ int v_st(int k, int c) { const int kk = (k & ~0xC) | ((k & 4) << 1) | ((k & 8) >> 1); return ((kk >> 3) * 4 + (c >> 5)) * 512 + ((kk & 7) * 32 + (c & 31)) * 2; }
__device__ __forceinline__ int v_rd_base(int lane) { return ((lane & 3) << 3) | (((lane >> 2) & 3) << 6) | (((lane >> 4) & 1) << 5) | (((lane >> 5) & 1) << 8); }
constexpr int v_rd_off(int d0, int ks, int half) { return d0 * 512 + ks * 4096 + half * 2048; }
__device__ __forceinline__ int crow(int r, int hi) { return (r & 3) + 8 * (r >> 2) + 4 * hi; }
__device__ __forceinline__ unsigned cvtpk(float lo, float hi) {
    unsigned r; asm volatile("v_cvt_pk_bf16_f32 %0, %1, %2" : "=v"(r) : "v"(lo), "v"(hi)); return r;
}
__device__ __forceinline__ bf16x8 pack8(f32x4 a, f32x4 b) {
    u32x4 w = {cvtpk(a[0], a[1]), cvtpk(a[2], a[3]), cvtpk(b[0], b[1]), cvtpk(b[2], b[3])};
    return *reinterpret_cast<bf16x8*>(&w);
}
template <class T> __device__ __forceinline__ bf16x8 load8(const T* p) {
    if constexpr (same_t<T, float>::v) { return pack8(*(const f32x4*)p, *(const f32x4*)(p + 4)); }
    else { return *reinterpret_cast<const bf16x8*>(p); }
}
__device__ __forceinline__ void mask_tile(f32x16& p0, f32x16& p1, int dq, unsigned W) {
    const float NEG = -__builtin_inff();
#pragma unroll
    for (int r = 0; r < 16; ++r) {
        const int c = (r & 3) + 8 * (r >> 2);
        if ((unsigned)(dq - c) >= W) p0[r] = NEG;
        if ((unsigned)(dq - c - 32) >= W) p1[r] = NEG;
    }
}
__device__ __forceinline__ void partialSM(f32x16& p0, f32x16& p1, float& m_reg, float& mn, float& alpha) {
    float pmax = p0[0]; for (int r = 1; r < 16; ++r) pmax = fmaxf(pmax, p0[r]); for (int r = 0; r < 16; ++r) pmax = fmaxf(pmax, p1[r]);
    { auto rr = __builtin_amdgcn_permlane32_swap(__float_as_uint(pmax), __float_as_uint(pmax), false, false);
      pmax = fmaxf(__uint_as_float(rr[0]), __uint_as_float(rr[1])); }
    constexpr float C2 = 1.f;
    if (__builtin_expect(__all((pmax - m_reg) * SCALE <= THR), 1)) { mn = m_reg; alpha = 1.f; }
    else { mn = fmaxf(m_reg, pmax); alpha = __builtin_amdgcn_exp2f((m_reg - mn) * C2); m_reg = mn; }
    const float mnL = -mn * C2;
    for (int r = 0; r < 16; ++r) p0[r] = fmaf(p0[r], C2, mnL); for (int r = 0; r < 16; ++r) p1[r] = fmaf(p1[r], C2, mnL);
    for (int r = 0; r < 16; ++r) p0[r] = __builtin_amdgcn_exp2f(p0[r]);
}
__device__ __forceinline__ void finishSM(f32x16& p0, f32x16& p1, float alpha, float& l_reg, bf16x8& pa0, bf16x8& pa1, bf16x8& pa2, bf16x8& pa3) {
    for (int r = 0; r < 16; ++r) p1[r] = __builtin_amdgcn_exp2f(p1[r]);
    float ps = 0; for (int r = 0; r < 16; ++r) ps += p0[r]; for (int r = 0; r < 16; ++r) ps += p1[r];
    { auto rr = __builtin_amdgcn_permlane32_swap(__float_as_uint(ps), __float_as_uint(ps), false, false);
      ps = __uint_as_float(rr[0]) + __uint_as_float(rr[1]); }
    l_reg = l_reg * alpha + ps;
#define PK4(P, B_, OUT) do { unsigned a0 = cvtpk(P[B_+0], P[B_+1]), a1 = cvtpk(P[B_+2], P[B_+3]);                          \
        unsigned b0 = cvtpk(P[B_+4], P[B_+5]), b1 = cvtpk(P[B_+6], P[B_+7]);                                             \
        auto r0 = __builtin_amdgcn_permlane32_swap(a0, b0, false, false); auto r1 = __builtin_amdgcn_permlane32_swap(a1, b1, false, false); \
        u32x4 w = {r0[0], r1[0], r0[1], r1[1]}; OUT = *reinterpret_cast<bf16x8*>(&w); } while (0)
    PK4(p0, 0, pa0); PK4(p0, 8, pa1); PK4(p1, 0, pa2); PK4(p1, 8, pa3);
#undef PK4
}
template <int KB, bool SK>
__device__ __forceinline__ void qkt(f32x16& p0, f32x16& p1, const char* K_lds, const float* kbl, int r32, int hi, const __attribute__((address_space(3))) char* q_lds, bool act) {
    if (SK && !act) { const float NEG = -__builtin_inff();
#pragma unroll
        for (int r = 0; r < 16; ++r) { p0[r] = NEG; p1[r] = NEG; } return; }
    { const float* kb_ = kbl + KB * 64 + 4 * hi;
#pragma unroll
      for (int j = 0; j < 4; ++j) { const f32x4 a = *(const f32x4*)(kb_ + 8 * j), b = *(const f32x4*)(kb_ + 32 + 8 * j);
          p0[4 * j] = a[0]; p0[4 * j + 1] = a[1]; p0[4 * j + 2] = a[2]; p0[4 * j + 3] = a[3];
          p1[4 * j] = b[0]; p1[4 * j + 1] = b[1]; p1[4 * j + 2] = b[2]; p1[4 * j + 3] = b[3]; } }
    const char* kb[4];
#pragma unroll
    for (int dd = 0; dd < 4; ++dd) kb[dd] = K_lds + KB * SHM_K + KSWZ(r32, (dd * 16 + hi * 8) * 2);
#pragma unroll
    for (int d0 = 0; d0 < 8; ++d0) { const char* a = kb[d0 & 3] + (d0 >> 2) * 128;
        bf16x8 b0 = *reinterpret_cast<const bf16x8*>(a);
        bf16x8 b1 = *reinterpret_cast<const bf16x8*>(a + 32 * 256);
        const bf16x8 q_ = *(const __attribute__((address_space(3))) bf16x8*)(q_lds + d0 * 1024);
        p0 = __builtin_amdgcn_mfma_f32_32x32x16_bf16(b0, q_, p0, 0, 0, 0);
        p1 = __builtin_amdgcn_mfma_f32_32x32x16_bf16(b1, q_, p1, 0, 0, 0); }
}
template <int VB, bool SK>
__device__ __forceinline__ void pv_tile(f32x16* o, int vb0, bf16x8 pa0, bf16x8 pa1, bf16x8 pa2, bf16x8 pa3, bool act) {
    if (SK && !act) return;
#define TRRD(dst, off) asm volatile("ds_read_b64_tr_b16 %0, %1 offset:%2" : "=&v"(dst) : "v"(vb0), "i"(off) : "memory")
#define PV_D0(d0) do { s16x4 l0, l1, l2, l3, h0, h1, h2, h3; constexpr int b_ = VB * SHM_V + v_rd_off(d0, 0, 0);     \
        TRRD(l0, b_); TRRD(h0, b_ + 2048); TRRD(l1, b_ + 4096); TRRD(h1, b_ + 6144); TRRD(l2, b_ + 8192); TRRD(h2, b_ + 10240); TRRD(l3, b_ + 12288); TRRD(h3, b_ + 14336); \
        asm volatile("s_waitcnt lgkmcnt(0)" ::: "memory"); SBAR();                 \
        o[d0] = __builtin_amdgcn_mfma_f32_32x32x16_bf16(pa0, (bf16x8){l0[0], l0[1], l0[2], l0[3], h0[0], h0[1], h0[2], h0[3]}, o[d0], 0, 0, 0);   \
        o[d0] = __builtin_amdgcn_mfma_f32_32x32x16_bf16(pa1, (bf16x8){l1[0], l1[1], l1[2], l1[3], h1[0], h1[1], h1[2], h1[3]}, o[d0], 0, 0, 0);   \
        o[d0] = __builtin_amdgcn_mfma_f32_32x32x16_bf16(pa2, (bf16x8){l2[0], l2[1], l2[2], l2[3], h2[0], h2[1], h2[2], h2[3]}, o[d0], 0, 0, 0);   \
        o[d0] = __builtin_amdgcn_mfma_f32_32x32x16_bf16(pa3, (bf16x8){l3[0], l3[1], l3[2], l3[3], h3[0], h3[1], h3[2], h3[3]}, o[d0], 0, 0, 0); } while (0)
    PV_D0(0); PV_D0(1); PV_D0(2); PV_D0(3);
#undef PV_D0
#undef TRRD
}

constexpr float LOG2E = 1.4426950408889634f;
struct Blk {
    const bf16* Q; const bf16* K; const bf16* V; bf16* O; float* LSE; const float* CUM;
    long rs, os; int ls;
    int P0, L, W, nvalid; float sd2, cref;
};
struct Seam { bf16x8 st_v0, st_v1, st_k0, st_k1; float st_b0, st_b1; };
__device__ __forceinline__ float kbias_raw(const Blk& B, int key) { return B.CUM ? B.CUM[key] : B.sd2 * (float)(key - B.P0); }
__device__ __forceinline__ float kbias_fin(const Blk& B, float raw) { return B.CUM ? -raw * LOG2E : raw; }
__device__ __forceinline__ int swa_jlo(int P0, int W) { const int lowk = P0 - W + 1; return lowk > 0 ? lowk / KVBLK : 0; }
__device__ __forceinline__ int swa_jhi(int P0, int L) { int j = (P0 + QB - 1) / KVBLK + 1; const int jm = L / KVBLK; return j > jm ? jm : j; }
__device__ __forceinline__ bf16x8 ld8(const bf16* p) { return *reinterpret_cast<const bf16x8*>(p); }
#define ROWP(p, rs_, k0, rr) ((p) + (size_t)(k0) * (rs_) + (unsigned)(((rr) * (int)(rs_)) + sc))
#define VMW() asm volatile("s_waitcnt vmcnt(0)" ::: "memory")
#define SLOAD(B_, k0) do { const bf16* vb_ = (B_).V + (size_t)(k0) * (B_).rs; const bf16* kb_ = (B_).K + (size_t)(k0) * (B_).rs;     \
                           unsigned o0_ = (unsigned)(sr * (int)(B_).rs + sc), o1_ = o0_ + 32u * (unsigned)(B_).rs; asm volatile("" : "+v"(o0_), "+v"(o1_));       \
                           S.st_v0 = ld8(vb_ + o0_); S.st_v1 = ld8(vb_ + o1_); S.st_k0 = ld8(kb_ + o0_); S.st_k1 = ld8(kb_ + o1_);                                  \
                           if ((tid & 15) == 0) { S.st_b0 = kbias_raw((B_), (k0) + sr); S.st_b1 = kbias_raw((B_), (k0) + 32 + sr); } } while (0)
#define SWRITE_K(bf, B_) do { *(bf16x8*)(K_lds + (bf) * SHM_K + kws) = S.st_k0; *(bf16x8*)(K_lds + (bf) * SHM_K + kws + 32 * 256) = S.st_k1;       \
                          if ((tid & 15) == 0) { kbl[(bf) * 64 + sr] = kbias_fin((B_), S.st_b0); kbl[(bf) * 64 + 32 + sr] = kbias_fin((B_), S.st_b1); } } while (0)
#define SWRITE_V(bf) do { *(bf16x8*)(V_lds + (bf) * SHM_V + vst0) = S.st_v0; *(bf16x8*)(V_lds + (bf) * SHM_V + vst1) = S.st_v1; } while (0)
#define QLOAD(B_) do { const int ri_ = (wid * QBLK + r32 < (B_).nvalid) ? wid * QBLK + r32 : (B_).nvalid - 1;                                    \
        const bf16* qp_ = (B_).Q + (unsigned)(ri_ * (int)(B_).rs + hi * 8);                                                                       \
        _Pragma("unroll") for (int hf_ = 0; hf_ < 2; ++hf_) { bf16x8 t_[4];                                                                      \
            _Pragma("unroll") for (int d0 = 0; d0 < 4; ++d0) t_[d0] = ld8(qp_ + (hf_ * 4 + d0) * 16);                                           \
            _Pragma("unroll") for (int d0 = 0; d0 < 4; ++d0) *(__attribute__((address_space(3))) bf16x8*)(q_lds + (hf_ * 4 + d0) * 1024) = t_[d0]; } } while (0)

__device__ __forceinline__ void prime(const Blk& cur, char* lds, Seam& S) {
    int tid_o = threadIdx.x; asm volatile("" : "+v"(tid_o));
    const int tid = tid_o, wid = __builtin_amdgcn_readfirstlane(tid >> 6), lane = tid & 63, r32 = lane & 31, hi = lane >> 5;
    const int sr = tid >> 4, sc = (tid & 15) * 8, kws = KSWZ(sr, sc * 2); char* K_lds = lds + 2 * SHM_V; float* kbl = (float*)(lds + LDS_KB); __attribute__((address_space(3))) char* q_lds = (__attribute__((address_space(3))) char*)(lds + LDS_Q + wid * 8192 + lane * 16);
    const int kb0 = (swa_jhi(cur.P0, cur.L) - 1) * KVBLK;
    S.st_b0 = 0.f; S.st_b1 = 0.f;
    QLOAD(cur);
    SLOAD(cur, kb0); VMW(); SWRITE_K(0, cur);
    __syncthreads();
}
#ifndef ATT_SK
#define ATT_SK true
#endif
struct AttnArgs { const bf16* QKV; unsigned char* ws; long offOA, offOP0, offOP2x; float* LSE; const float* CUM; };
__device__ __forceinline__ Blk decode(int i, const AttnArgs& A);
template <bool SK>
__device__ __forceinline__ bool block(const Blk& cur, Blk& nxt, int pend, int nitems, volatile int* slot, const AttnArgs& A, char* lds, Seam& S) {
    int tid_o = threadIdx.x; asm volatile("" : "+v"(tid_o));
    const int tid = tid_o, wid = __builtin_amdgcn_readfirstlane(tid >> 6), lane = tid & 63, r32 = lane & 31, hi = lane >> 5;
    const int W = cur.W;
    const int j_lo = swa_jlo(cur.P0, W);
    const int j_hi = swa_jhi(cur.P0, cur.L);
    const int NT = j_hi - j_lo;
    const int qlo = cur.P0 + wid * QBLK, qm = qlo + r32 - 4 * hi;
    char* V_lds = lds; char* K_lds = lds + 2 * SHM_V;
    float* ws = (float*)(lds + LDS_WS) + wid * 64; float* li_l = ws, * al_l = ws + 32; float* kbl = (float*)(lds + LDS_KB); __attribute__((address_space(3))) char* q_lds = (__attribute__((address_space(3))) char*)(lds + LDS_Q + wid * 8192 + lane * 16);
    float m_reg = -1e30f, l_reg = 0; f32x16 o[4] = {};
    const int sr = tid >> 4, sc = (tid & 15) * 8, vst0 = v_st(sr, sc), vst1 = v_st(32 + sr, sc), kws = KSWZ(sr, sc * 2);
    const int vb0 = (int)(uintptr_t)V_lds + v_rd_base(lane);
#define RESC(a) do { if (__any((a) < 1.f)) { if (hi == 0) al_l[r32] = (a); asm volatile("s_waitcnt lgkmcnt(0)" ::: "memory");              \
                     for (int d_ = 0; d_ < 4; ++d_) for (int r = 0; r < 16; ++r) o[d_][r] *= al_l[crow(r, hi)]; } } while (0)
#define KBASE(t) ((j_hi - 1 - (t)) * KVBLK)
#define ACT(t) (KBASE(t) <= qlo + QBLK - 1 && KBASE(t) + KVBLK - 1 >= qlo - W + 1)
#define MASKT(P0_, P1_, t) do { const int kb_ = KBASE(t); if ((!SK || ACT(t)) && (kb_ + KVBLK - 1 > qlo || kb_ <= qlo + QBLK - 1 - W)) mask_tile(P0_, P1_, qm - kb_, (unsigned)W); } while (0)
    f32x16 pA0, pA1, pB0, pB1; float mnA, mnB, alA, alB; bf16x8 pa0, pa1, pa2, pa3;
    SWRITE_V(0); SBAR();
    if (NT > 1) SLOAD(cur, KBASE(1));
    SBAR(); qkt<0, SK>(pA0, pA1, K_lds, kbl, r32, hi, q_lds, ACT(0));
    MASKT(pA0, pA1, 0); partialSM(pA0, pA1, m_reg, mnA, alA);
    if (NT > 1) { VMW(); SWRITE_V(1); SWRITE_K(1, cur); }
    __syncthreads();
#define HALF_STEP(PX0, PX1, mnX, alX, PY0, PY1, alY, t, KB, VB, SB) do {                                                      \
        SBAR(); qkt<KB, SK>(PX0, PX1, K_lds, kbl, r32, hi, q_lds, ACT(t));                                                     \
        finishSM(PY0, PY1, alY, l_reg, pa0, pa1, pa2, pa3); SBAR();                                                           \
        if ((t) + 1 < NT) { SLOAD(cur, KBASE((t) + 1)); SBAR(); }                                                             \
        pv_tile<VB, SK>(o, vb0, pa0, pa1, pa2, pa3, ACT((t) - 1)); MASKT(PX0, PX1, (t)); partialSM(PX0, PX1, m_reg, mnX, alX); \
        __syncthreads();                                                                                                      \
        if ((t) + 1 < NT) { VMW(); SWRITE_V(SB); SWRITE_K(SB, cur); }                                                              \
        RESC(alX); __syncthreads(); } while (0)
    for (int t = 1; t + 1 < NT; t += 2) {
        HALF_STEP(pB0, pB1, mnB, alB, pA0, pA1, alA, t, 1, 0, 0);
        HALF_STEP(pA0, pA1, mnA, alA, pB0, pB1, alB, t + 1, 0, 1, 1);
    }
    const bool even = (NT & 1) == 0;
    if (even) { SBAR(); qkt<1, SK>(pB0, pB1, K_lds, kbl, r32, hi, q_lds, ACT(NT - 1)); SBAR(); }
    if (tid == 0) slot[0] = pend;
    __syncthreads();
    const int ni = __builtin_amdgcn_readfirstlane(slot[0]); const bool last = ni >= nitems;
    nxt = decode(last ? 0 : ni, A);
    if (!last) { const int kbn = (swa_jhi(nxt.P0, nxt.L) - 1) * KVBLK;
        SLOAD(nxt, kbn); SBAR();
        QLOAD(nxt); }
    SBAR();
    finishSM(pA0, pA1, alA, l_reg, pa0, pa1, pa2, pa3); SBAR();
    pv_tile<0, SK>(o, vb0, pa0, pa1, pa2, pa3, ACT(even ? NT - 2 : NT - 1));
    if (even) { MASKT(pB0, pB1, NT - 1); partialSM(pB0, pB1, m_reg, mnB, alB); __syncthreads(); RESC(alB);
        finishSM(pB0, pB1, alB, l_reg, pa0, pa1, pa2, pa3); SBAR(); pv_tile<1, SK>(o, vb0, pa0, pa1, pa2, pa3, ACT(NT - 1)); }
    SBAR(); if (!last) SWRITE_K(0, nxt); SBAR();
    int lne_ = (int)(threadIdx.x & 63u); asm volatile("" : "+v"(lne_)); const int r32e = lne_ & 31, hie = lne_ >> 5;
    if (hie == 0) li_l[r32e] = l_reg; asm volatile("s_waitcnt lgkmcnt(0)" ::: "memory");
    float rli[16];
#pragma unroll
    for (int r = 0; r < 16; ++r) rli[r] = __builtin_amdgcn_rcpf(li_l[crow(r, hie)]);
    bf16* Ow = cur.O + (size_t)(wid * QBLK) * cur.os;
#pragma unroll
    for (int r = 0; r < 16; ++r) { const int orow = crow(r, hie); const bool ok = (wid * QBLK + orow < cur.nvalid) && ((r32e & 1) == 0);
#pragma unroll
        for (int d0 = 0; d0 < 4; ++d0) { const float v = o[d0][r] * rli[r]; const float vn = __shfl_xor(v, 1);
            if (ok) *(unsigned*)(Ow + (unsigned)(orow * (int)cur.os + d0 * 32 + r32e)) = cvtpk(v, vn); } }
    if (cur.LSE && hie == 0 && wid * QBLK + r32e < cur.nvalid)
        cur.LSE[(unsigned)((wid * QBLK + r32e) * cur.ls)] = m_reg + __builtin_amdgcn_logf(l_reg) - cur.sd2 * (float)(wid * QBLK + r32e);
    __syncthreads();
    return last;
#undef RESC
#undef KBASE
#undef ACT
#undef MASKT
#undef HALF_STEP
}
#undef ROWP
#undef VMW
#undef SLOAD
#undef SWRITE_K
#undef SWRITE_V
#undef QLOAD

constexpr int NITEMS = 256 + 256 + 256 + 512;
__device__ __forceinline__ Blk decode(int i_in, const AttnArgs& A) {
    const int i = __builtin_amdgcn_readfirstlane(i_in);
    Blk b; int bh, qb, res, dil, pat; const bool fox = i < 256;
    if (i < 256) { qb = 7 - (i >> 5); bh = i & 31; res = 0; dil = 1; pat = 0; }
    else if (i < 512) { const int j = i - 256; qb = 7 - (j >> 5); bh = j & 31; res = 0; dil = 1; pat = 0; }
    else if (i < 768) { const int j = i - 512; bh = j & 31; const int rest = j >> 5; res = rest >> 1; qb = rest & 1; dil = 4; pat = 1; }
    else { const int j = i - 768; bh = j & 31; res = j >> 5; qb = 0; dil = 16; pat = 2; }
    const int bb = bh >> 3, h = bh & 7, L = 2048 / dil, P0 = qb * 256;
    const size_t tok0 = (size_t)bb * 2048 + res;
    const int seg = fox ? 0 : 3;
    const bf16* base = A.QKV + tok0 * 6144 + h * 128;
    const int opitch = fox ? 2048 : 1024;
    b.rs = (long)dil * 6144; b.os = (long)dil * opitch; b.ls = dil * 8;
    b.Q = base + seg * 1024 + (size_t)P0 * b.rs; b.K = base + (seg + 1) * 1024; b.V = base + (seg + 2) * 1024;
    long ooff = A.offOP0 + (long)pat * (16l << 20) + (pat == 2 ? A.offOP2x : 0l); ooff = fox ? A.offOA : ooff;
    bf16* ob = (bf16*)(A.ws + ooff);
    b.O = ob + (tok0 + (size_t)P0 * dil) * opitch + h * 128;
    float* lb = A.LSE + (size_t)pat * (8192 * 8);
    b.LSE = fox ? nullptr : lb + (tok0 + (size_t)P0 * dil) * 8 + h;
    b.CUM = fox ? A.CUM + (size_t)bh * 2048 : nullptr;
    b.cref = 0.f;
    b.P0 = P0; b.L = L; b.W = fox ? (1 << 30) : 129; b.nvalid = (L - P0) < QB ? (L - P0) : QB;
    b.sd2 = fox ? 0.f : __builtin_amdgcn_exp2f(-(float)(h + 1)) * (float)dil * LOG2E;
    return b;
}
__device__ __forceinline__ void attn_phase(char* lds, const AttnArgs& A, unsigned* ctr, int first = 0) {
    volatile int* slot = (volatile int*)(lds + LDS_SLOT);
    const int G = (int)gridDim.x, ci = first + (int)blockIdx.x;
    if (ci >= NITEMS) return;
    Blk cur = decode(ci, A); Seam S;
    prime(cur, lds, S);
    for (;;) {
        int pend = NITEMS; if (threadIdx.x == 0) pend = first + G + (int)atomicAdd(ctr, 1u);
        Blk nxt; bool last;
        if (cur.CUM) last = block<false>(cur, nxt, pend, NITEMS, slot, A, lds, S);
        else last = block<true>(cur, nxt, pend, NITEMS, slot, A, lds, S);
        if (last) break;
        cur = nxt;
    }
}
#undef SBAR
}

#define GAS __attribute__((address_space(1)))
#define LAS __attribute__((address_space(3)))
typedef unsigned short bf16;
typedef unsigned v4u __attribute__((ext_vector_type(4)));
typedef float f32x4 __attribute__((ext_vector_type(4)));
constexpr int NWAVES = 8;
constexpr int NB = 4, SEQ = 2048, DM = 2048, M = NB * SEQ, NH = 8, HD = 128, DFF = 5632, NUP = 2 * DFF, INC = 10248, NPROJ = 10240;
constexpr float EPS = 1e-6f;
constexpr float LOG2E_F = 1.4426950408889634f;
constexpr size_t MiB = 1u << 20;
constexpr size_t WS_CTL = 0, WS_BAR = 64 * 1024;
constexpr size_t WS_GAIN = 2 * MiB, WS_RSTD = 3 * MiB;
constexpr size_t WS_SSQ = 256 * 1024, WS_CUM = 512 * 1024, WS_LOGF = 768 * 1024, WS_LSE = 1 * MiB;
constexpr size_t WS_WIN = 4 * MiB, WS_WBRF = 44 * MiB, WS_WBRD = 48 * MiB, WS_WOUT = 52 * MiB, WS_WUP = 60 * MiB, WS_WDN = 104 * MiB;
constexpr size_t WS_XN = 126 * MiB;
constexpr size_t WS_QKV = 158 * MiB;
constexpr size_t WS_GATES = 254 * MiB;
constexpr size_t WS_OA = 4 * MiB, WS_OB = 20 * MiB;
constexpr size_t WS_OP0 = 126 * MiB, WS_OP1 = 142 * MiB, WS_OP2 = 318 * MiB;
constexpr size_t WS_T = 158 * MiB, WS_MG = 222 * MiB;
constexpr size_t WS_XB = 126 * MiB;
#ifndef CONV_ALIGN
#define CONV_ALIGN false
#endif
#ifndef FUSED_CONV
#define FUSED_CONV 0
#endif
constexpr size_t WS_U = 158 * MiB;
constexpr size_t WS_ACT = FUSED_CONV ? 158 * MiB : 4 * MiB, WS_US = 254 * MiB;
constexpr size_t WS_END = 334 * MiB;
constexpr int RING_BYTES = 131072, XL_OFF = RING_BYTES, BARST_OFF = 143360, LDS_BYTES = 147456;
static_assert(att::LDS_END <= LDS_BYTES, "attention LDS");

__device__ __forceinline__ unsigned f2bf(float f) { unsigned u = __builtin_bit_cast(unsigned, f); return (u + 0x7fffu + ((u >> 16) & 1u)) >> 16; }
__device__ __forceinline__ unsigned pk2(float lo, float hi) { return f2bf(lo) | (f2bf(hi) << 16); }
__device__ __forceinline__ float wave_sum(float v) {
#pragma unroll
    for (int o = 1; o < 64; o <<= 1) v += __shfl_xor(v, o);
    return v;
}
template <int MODE, bool NTST>
__device__ __forceinline__ void transpose_matrix(const float* W, int K, int Nsrc, int Ndst, bf16* WT, int Kdst, int koff, const float* kscale, int rot, int gw, int NGW, LAS float* scr, int lane) {
    const int nblk = Ndst / 32, nitems = (K / 64) * nblk, rr = lane >> 3, c4 = (lane & 7) * 4, c = lane & 7;
    int it = gw - rot; if (it < 0) it += NGW;
    f32x4 v[8]; int k0 = 0, n0 = 0;
#define TM_LOAD(dst, IT, K0, N0) do { const int kb_ = (IT) / nblk; N0 = 32 * ((IT) - kb_ * nblk); K0 = 64 * kb_;                                   \
        const int sc_ = MODE == 0 ? N0 : (MODE == 1 ? (N0 < 3072 ? N0 : N0 + 8) : (((N0 >> 7) & 1) * 5632 + 128 * (N0 >> 8) + (N0 & 127)));       \
        _Pragma("unroll") for (int i = 0; i < 8; ++i) dst[i] = __builtin_nontemporal_load((const f32x4*)(W + (size_t)(K0 + 8 * i + rr) * Nsrc + sc_ + c4)); } while (0)
    if (it < nitems) TM_LOAD(v, it, k0, n0);
    while (it < nitems) {
        const int itn = it + NGW; f32x4 vn[8]; int k0n = 0, n0n = 0;
        if (itn < nitems) TM_LOAD(vn, itn, k0n, n0n);
        if (kscale) {
#pragma unroll
            for (int i = 0; i < 8; ++i) v[i] = v[i] * kscale[k0 + 8 * i + rr]; }
#pragma unroll
        for (int i = 0; i < 8; ++i) { LAS float* d = scr + (8 * i + rr) * 33 + c4; d[0] = v[i][0]; d[1] = v[i][1]; d[2] = v[i][2]; d[3] = v[i][3]; }
        asm volatile("s_waitcnt lgkmcnt(0)" ::: "memory");
#pragma unroll
        for (int j = 0; j < 4; ++j) { const int n = (lane >> 3) + 8 * j; const LAS float* sp = scr + (8 * c) * 33 + n;
            v4u o; o.x = pk2(sp[0 * 33], sp[1 * 33]); o.y = pk2(sp[2 * 33], sp[3 * 33]); o.z = pk2(sp[4 * 33], sp[5 * 33]); o.w = pk2(sp[6 * 33], sp[7 * 33]);
            if constexpr (NTST) __builtin_nontemporal_store(o, (v4u*)(WT + (size_t)(n0 + n) * Kdst + koff + k0 + 8 * c)); else *(v4u*)(WT + (size_t)(n0 + n) * Kdst + koff + k0 + 8 * c) = o; }
        asm volatile("s_waitcnt lgkmcnt(0)" ::: "memory");
        it = itn; k0 = k0n; n0 = n0n;
#pragma unroll
        for (int i = 0; i < 8; ++i) v[i] = vn[i];
    }
#undef TM_LOAD
}

typedef GAS unsigned gu32;
#define RLX_AGENT __ATOMIC_RELAXED, __HIP_MEMORY_SCOPE_AGENT
#define XB_TMO      128
#define XB_XCNT(j)  (256  + 64 * (j))
#define XB_XSUB(j)  (1280 + 64 * (j))
#define XB_XGEN(j)  (2304 + 64 * (j))
#define XB_TOP      3328
#define XB_TOPGEN   3392
#define XCD_BAR_WORDS 3456
#define XB_SPIN_CAP (1u << 18)

__device__ __forceinline__ unsigned xb_ld(unsigned* p)              { return __hip_atomic_load(p, __ATOMIC_RELAXED, __HIP_MEMORY_SCOPE_AGENT); }
__device__ __forceinline__ unsigned xb_add(unsigned* p, unsigned v) { return __hip_atomic_fetch_add(p, v, __ATOMIC_RELAXED, __HIP_MEMORY_SCOPE_AGENT); }
__device__ __forceinline__ unsigned xb_xcc_id() { return (unsigned)__builtin_amdgcn_s_getreg((3 << 11) | 20) & 0xFu; }
#define XB_SPIN(cond, bar) do { unsigned _sp = 0; while (cond) { __builtin_amdgcn_s_sleep(1); \
    if ((++_sp & 255u) == 0u) { if (xb_ld(&(bar)[XB_TMO])) break; if (_sp > XB_SPIN_CAP) { atomicAdd(&(bar)[XB_TMO], 1u); break; } } } } while (0)

struct XcdBarrier {
    unsigned* bar; unsigned x;
    volatile LAS unsigned* st;
};

__device__ __forceinline__ XcdBarrier xcd_barrier_post(unsigned* bar, volatile LAS unsigned* st) {
    XcdBarrier b; b.bar = bar; b.x = xb_xcc_id(); b.st = st;
    if (threadIdx.x == 0) (void)xb_add(&bar[XB_XCNT(b.x)], 1u);
    return b;
}
__device__ __forceinline__ void xcd_barrier_complete(unsigned* bar, unsigned x, unsigned& nloc, unsigned& nx) {
    const unsigned G = gridDim.x * gridDim.y * gridDim.z;
    unsigned sum, cnt, mine, sp = 0u;
    for (;;) {
        sum = 0u; cnt = 0u; mine = 0u;
#pragma unroll
        for (unsigned j = 0; j < 16; ++j) { const unsigned c = xb_ld(&bar[XB_XCNT(j)]); sum += c; cnt += (c > 0u) ? 1u : 0u; mine = (j == x) ? c : mine; }
        if (sum == G) break;
        __builtin_amdgcn_s_sleep(1);
        if ((++sp & 255u) == 0u) { if (xb_ld(&bar[XB_TMO])) break; if (sp > XB_SPIN_CAP) { atomicAdd(&bar[XB_TMO], 1u); break; } }
    }
    nloc = mine > 0u ? mine : 1u; nx = cnt > 0u ? cnt : 1u;
}

__device__ __forceinline__ void xcd_barrier(const XcdBarrier& b) {
    asm volatile("s_waitcnt vmcnt(0)" ::: "memory");
    __syncthreads();
    if (threadIdx.x == 0) {
        unsigned* bar = b.bar;
        __builtin_amdgcn_s_waitcnt(0);
        unsigned nloc = b.st[0], nx = b.st[1];
        if (nloc == 0u) { xcd_barrier_complete(bar, b.x, nloc, nx); b.st[0] = nloc; b.st[1] = nx; }
        const unsigned old = xb_add(&bar[XB_XSUB(b.x)], 1u);
        const unsigned gen = old / nloc;
        if (old + 1u == (gen + 1u) * nloc) {
            __builtin_amdgcn_fence(__ATOMIC_RELEASE, "agent");
            asm volatile("s_waitcnt vmcnt(0)" ::: "memory");
            const unsigned og = xb_add(&bar[XB_TOP], 1u);
            const unsigned tg = og / nx;
            if (og + 1u == (tg + 1u) * nx) xb_add(&bar[XB_TOPGEN], 1u);
            else XB_SPIN(xb_ld(&bar[XB_TOPGEN]) == tg, bar);
            __builtin_amdgcn_fence(__ATOMIC_ACQUIRE, "agent");
            xb_add(&bar[XB_XGEN(b.x)], 1u);
            asm volatile("s_waitcnt vmcnt(0)" ::: "memory");
        } else {
            XB_SPIN(xb_ld(&bar[XB_XGEN(b.x)]) == gen, bar);
            __builtin_amdgcn_fence(__ATOMIC_ACQUIRE, "agent");
            asm volatile("s_waitcnt vmcnt(0)" ::: "memory");
        }
    }
    __syncthreads();
}
#ifndef PROBE_REPEAT
#define PROBE_REPEAT -1
#endif
#ifndef PROBE_FIRST
#define PROBE_FIRST 0
#endif
#define REPS(k) ((PROBE_REPEAT == (k)) ? 2 : 1)
struct Args { const float* in[16]; float* out; unsigned char* ws; unsigned long long flags; };
#define IDS() int tid_o = threadIdx.x; asm volatile("" : "+v"(tid_o)); const int tid = tid_o, lane = tid & 63, wave = __builtin_amdgcn_readfirstlane(tid >> 6); (void)lane; (void)wave
#define OPQ() int z_ = 0; asm volatile("" : "+s"(z_))
#define INP(k) (args.in[z_ + (k)])

__global__ void __launch_bounds__(NWAVES * 64, 2) fwd_mega(Args args) {
    extern __shared__ __attribute__((aligned(16))) unsigned char lds[];
    cg::grid_group grid = cg::this_grid();
    LAS unsigned char* lds3 = (LAS unsigned char*)lds;
    const int G = gridDim.x, bx = blockIdx.x;
    if (threadIdx.x < 2) ((volatile LAS unsigned*)(lds3 + BARST_OFF))[threadIdx.x] = 0u;
    __syncthreads();
    unsigned char* ws = args.ws;
    const XcdBarrier xbar = xcd_barrier_post((unsigned*)(ws + WS_BAR), (volatile LAS unsigned*)(lds3 + BARST_OFF));
    float* out = args.out;
    bf16* Win_t = (bf16*)(ws + WS_WIN); bf16* Wbrf_t = (bf16*)(ws + WS_WBRF); bf16* Wbrd_t = (bf16*)(ws + WS_WBRD); bf16* Wout_t = (bf16*)(ws + WS_WOUT);
    bf16* Wup_t = (bf16*)(ws + WS_WUP); bf16* Wdn_t = (bf16*)(ws + WS_WDN);
    bf16* XN = (bf16*)(ws + WS_XN); bf16* QKV = (bf16*)(ws + WS_QKV); bf16* GATES = (bf16*)(ws + WS_GATES);
    bf16* OA = (bf16*)(ws + WS_OA); bf16* OB = (bf16*)(ws + WS_OB); bf16* OP0 = (bf16*)(ws + WS_OP0); bf16* OP1 = (bf16*)(ws + WS_OP1); bf16* OP2 = (bf16*)(ws + WS_OP2);
    float* T = (float*)(ws + WS_T); bf16* MG = (bf16*)(ws + WS_MG); bf16* XB = (bf16*)(ws + WS_XB); bf16* ACT = (bf16*)(ws + WS_ACT); bf16* U = (bf16*)(ws + WS_U); float* US = (float*)(ws + WS_US); (void)U; (void)US;
    float* SSQ = (float*)(ws + WS_SSQ); float* CUM = (float*)(ws + WS_CUM); float* LOGF = (float*)(ws + WS_LOGF); float* LSE = (float*)(ws + WS_LSE);
    unsigned* ctl = (unsigned*)(ws + WS_CTL); float* GAIN = (float*)(ws + WS_GAIN); float* RSTD = (float*)(ws + WS_RSTD);

#if !defined(ONLY) || ONLY == 0
    _Pragma("unroll 1") for (int rep_ = 0; rep_ < REPS(0); ++rep_) {
        IDS();
        OPQ(); const float* x = INP(0); const float* g_attn = INP(1); const float* w_in = INP(2); const float* b_forget = INP(3); const float* gq_fox = INP(4); const float* gk_fox = INP(5); const float* gq_dil = INP(6); const float* gk_dil = INP(7);
        const float* w_br_fox = INP(8); const float* w_br_dil = INP(9); const float* w_out = INP(10); const float* g_ffn = INP(11); const float* w_up = INP(12); const float* w_down = INP(15);
        if (bx == 1) for (int i = tid; i < 1024; i += NWAVES * 64) { GAIN[i] = gq_fox[i]; GAIN[1024 + i] = gk_fox[i]; GAIN[2048 + i] = gq_dil[i]; GAIN[3072 + i] = gk_dil[i]; }
        LAS float* scr = (LAS float*)(lds3 + wave * 16384);
        const int gw = bx * NWAVES + wave, NGW = G * NWAVES;
        constexpr int I_IN = (DM / 64) * (NPROJ / 32), I_BR = (1024 / 64) * (DM / 32), I_OUT = (DM / 64) * (DM / 32), I_UP = (DM / 64) * (NUP / 32);
        transpose_matrix<1, false>(w_in, DM, INC, NPROJ, Win_t, DM, 0, nullptr, 0, gw, NGW, scr, lane);
        if (G != 256) transpose_matrix<0, true>(w_down, DFF, DM, DM, Wdn_t, DFF, 0, nullptr, (I_IN + 2 * I_BR + I_OUT + I_UP) % NGW, gw, NGW, scr, lane);
        __syncthreads();
        LAS float* wf = (LAS float*)lds3;
        {
            const float* wsrc = w_in + 3072 + (tid & 7);
#pragma unroll 1
            for (int b0 = 0; b0 < 32; b0 += 8) { float tv[8];
#pragma unroll
                for (int q = 0; q < 8; ++q) tv[q] = wsrc[(size_t)((tid + (b0 + q) * NWAVES * 64) >> 3) * INC];
#pragma unroll
                for (int q = 0; q < 8; ++q) wf[tid + (b0 + q) * NWAVES * 64] = tv[q]; }
        }
        __syncthreads();
        for (int m = gw; m < M; m += NGW) {
            const f32x4* xr = (const f32x4*)(x + (size_t)m * DM) + lane; const f32x4* gr = (const f32x4*)g_attn + lane;
            f32x4 v[8]; float s = 0.f;
#pragma unroll
            for (int j = 0; j < 8; ++j) { v[j] = __builtin_nontemporal_load(xr + 64 * j); s += (v[j][0] * v[j][0] + v[j][1] * v[j][1]) + (v[j][2] * v[j][2] + v[j][3] * v[j][3]); }
            const float rstd = 1.f / sqrtf(wave_sum(s) * (1.f / DM) + EPS);
            float fa[8] = {0.f, 0.f, 0.f, 0.f, 0.f, 0.f, 0.f, 0.f};
            unsigned long long* o8 = (unsigned long long*)(XN + (size_t)m * DM) + lane;
#pragma unroll
            for (int j = 0; j < 8; ++j) { const f32x4 h = v[j] * rstd * gr[64 * j];
                o8[64 * j] = (unsigned long long)pk2(h[0], h[1]) | ((unsigned long long)pk2(h[2], h[3]) << 32);
#pragma unroll
                for (int c = 0; c < 4; ++c) { const LAS f32x4* wp = (const LAS f32x4*)(wf + (size_t)(256 * j + 4 * lane + c) * 8); const f32x4 wa = wp[0], wb = wp[1];
                    fa[0] = fmaf(h[c], wa[0], fa[0]); fa[1] = fmaf(h[c], wa[1], fa[1]); fa[2] = fmaf(h[c], wa[2], fa[2]); fa[3] = fmaf(h[c], wa[3], fa[3]);
                    fa[4] = fmaf(h[c], wb[0], fa[4]); fa[5] = fmaf(h[c], wb[1], fa[5]); fa[6] = fmaf(h[c], wb[2], fa[6]); fa[7] = fmaf(h[c], wb[3], fa[7]); }
                asm volatile("" ::: "memory"); }
#pragma unroll
            for (int hh = 0; hh < 8; ++hh) fa[hh] = wave_sum(fa[hh]);
            if (lane < 8) { float z = fa[0];
#pragma unroll
                for (int hh = 1; hh < 8; ++hh) z = (lane == hh) ? fa[hh] : z;
                z += b_forget[lane];
                LOGF[(size_t)m * 8 + lane] = fminf(z, 0.f) - log1pf(expf(-fabsf(z))); }
        }
        __syncthreads();
    }
#endif
    if (args.flags & 1ull) grid.sync();
    xcd_barrier(xbar);

#if !defined(ONLY) || ONLY == 1
    _Pragma("unroll 1") for (int rep_ = 0; rep_ < REPS(1); ++rep_) {
        if (rep_ > 0) xcd_barrier(xbar);
        IDS();
        if (bx < NB * NH) { const int bb = bx >> 3, h = bx & 7; LAS float* wt = (LAS float*)lds3;
            float v[4]; float s = 0.f;
#pragma unroll
            for (int j = 0; j < 4; ++j) { v[j] = LOGF[((size_t)bb * SEQ + 4 * tid + j) * 8 + h]; s += v[j]; v[j] = s; }
            float inc = s;
#pragma unroll
            for (int o = 1; o < 64; o <<= 1) { const float t = __shfl_up(inc, o); if (lane >= o) inc += t; }
            if (lane == 63) wt[wave] = inc;
            __syncthreads();
            float off = inc - s;
            for (int w = 0; w < wave; ++w) off += wt[w];
#pragma unroll
            for (int j = 0; j < 4; ++j) CUM[(size_t)bx * SEQ + 4 * tid + j] = off + v[j];
            __syncthreads();
        }
        pg8::Gemm g{XN, Win_t, M, NPROJ, DM}; pg8::StaticOrder S; S.init(M, NPROJ, G, bx);
        pg8::EpiProj E{QKV, GATES, GAIN, (LAS float*)(lds3 + XL_OFF)};
        pg8::gemm_phase<pg8::EpiProj, pg8::StaticOrder, true, true>(lds3, g, S, E);
    }
#endif
    xcd_barrier(xbar);

#if !defined(ONLY) || ONLY == 2
    _Pragma("unroll 1") for (int rep_ = 0; rep_ < REPS(2); ++rep_) {
        if (rep_ > 0) xcd_barrier(xbar);
        IDS();
        const att::AttnArgs A{QKV, ws, (long)WS_OA, (long)WS_OP0, (long)WS_OP2 - (long)WS_OP0 - 32 * (long)MiB, LSE, CUM};
        att::attn_phase((char*)lds, A, ctl + 16 * rep_, rep_ ? PROBE_FIRST : 0);
        __syncthreads();
        { OPQ(); const float* w_br_fox = INP(8); const float* w_br_dil = INP(9); const float* w_out = INP(10); const float* g_ffn = INP(11); const float* w_up = INP(12);
          LAS float* scr = (LAS float*)(lds3 + wave * 16384); const int gw = bx * NWAVES + wave, NGW = G * NWAVES;
          constexpr int I_BR = (1024 / 64) * (DM / 32), I_OUT = (DM / 64) * (DM / 32);
          transpose_matrix<0, true>(w_br_fox, 1024, DM, DM, Wbrf_t, 2048, 0, nullptr, 0, gw, NGW, scr, lane);
          transpose_matrix<0, true>(w_br_dil, 1024, DM, DM, Wbrf_t, 2048, 1024, nullptr, I_BR % NGW, gw, NGW, scr, lane);
          transpose_matrix<0, true>(w_out, DM, DM, DM, Wout_t, DM, 0, nullptr, (2 * I_BR) % NGW, gw, NGW, scr, lane);
          transpose_matrix<2, true>(w_up, DM, NUP, NUP, Wup_t, DM, 0, g_ffn, (2 * I_BR + I_OUT) % NGW, gw, NGW, scr, lane); }
    }
#endif
    xcd_barrier(xbar);

#if !defined(ONLY) || ONLY == 3
    _Pragma("unroll 1") for (int rep_ = 0; rep_ < REPS(3); ++rep_) {
        if (rep_ > 0) xcd_barrier(xbar);
        IDS();
        const int gt = bx * (NWAVES * 64) + tid, NT = G * NWAVES * 64;
        for (int i = gt; i < M * 128; i += NT) { const int m = i >> 7, c8 = (i & 127) * 8, h = c8 >> 7;
            const float l0 = LSE[(size_t)m * 8 + h], l1 = LSE[(size_t)(M + m) * 8 + h], l2 = LSE[(size_t)(2 * M + m) * 8 + h];
            const float mx = fmaxf(l0, fmaxf(l1, l2));
            float w0 = __builtin_amdgcn_exp2f(l0 - mx), w1 = __builtin_amdgcn_exp2f(l1 - mx), w2 = __builtin_amdgcn_exp2f(l2 - mx);
            const float inv = 1.f / (w0 + w1 + w2); w0 *= inv; w1 *= inv; w2 *= inv;
            const v4u a = __builtin_nontemporal_load((const v4u*)(OP0 + (size_t)m * 1024 + c8)), b = __builtin_nontemporal_load((const v4u*)(OP1 + (size_t)m * 1024 + c8)), c = __builtin_nontemporal_load((const v4u*)(OP2 + (size_t)m * 1024 + c8));
            v4u o;
#pragma unroll
            for (int k = 0; k < 4; ++k) { const float lo = w0 * pg8::bflo(a[k]) + w1 * pg8::bflo(b[k]) + w2 * pg8::bflo(c[k]), hi = w0 * pg8::bfhi(a[k]) + w1 * pg8::bfhi(b[k]) + w2 * pg8::bfhi(c[k]); o[k] = pk2(lo, hi); }
            *(v4u*)(OA + (size_t)m * 2048 + 1024 + c8) = o; }
    }
#endif
    xcd_barrier(xbar);

#if !defined(ONLY) || ONLY == 4
    _Pragma("unroll 1") for (int rep_ = 0; rep_ < REPS(4); ++rep_) {
        if (rep_ > 0) xcd_barrier(xbar);
        IDS();
        pg8::StaticOrder S; S.init(M, DM, G, bx);
        pg8::Gemm g{OA, Wbrf_t, M, DM, 2048}; pg8::EpiBr E{GATES, MG};
        pg8::gemm_phase<pg8::EpiBr, pg8::StaticOrder, true, true>(lds3, g, S, E);
    }
#endif
    xcd_barrier(xbar);

#if !defined(ONLY) || ONLY == 5
    _Pragma("unroll 1") for (int rep_ = 0; rep_ < REPS(5); ++rep_) {
        if (rep_ > 0) xcd_barrier(xbar);
        IDS();
        pg8::Gemm g{MG, Wout_t, M, DM, DM}; pg8::StaticOrder S; S.init(M, DM, G, bx);
        OPQ(); pg8::EpiOut E{INP(0), XB, SSQ};
        pg8::gemm_phase<pg8::EpiOut, pg8::StaticOrder, false, true>(lds3, g, S, E);
    }
#endif
    xcd_barrier(xbar);

#if !defined(ONLY) || ONLY == 6
    _Pragma("unroll 1") for (int rep_ = 0; rep_ < REPS(6); ++rep_) {
        if (rep_ > 0) xcd_barrier(xbar);
        IDS();
#pragma unroll 1
        for (int r0 = tid; r0 < M; r0 += 8 * NWAVES * 64) { f32x4 sa[8], sb[8];
#pragma unroll
            for (int q = 0; q < 8; ++q) { const size_t r = (size_t)(r0 + q * NWAVES * 64); sa[q] = *(const f32x4*)(SSQ + r * 8); sb[q] = *(const f32x4*)(SSQ + r * 8 + 4); }
#pragma unroll
            for (int q = 0; q < 8; ++q) RSTD[r0 + q * NWAVES * 64] = 1.f / sqrtf((((sa[q][0] + sa[q][1]) + (sa[q][2] + sa[q][3])) + ((sb[q][0] + sb[q][1]) + (sb[q][2] + sb[q][3]))) * (1.f / DM) + EPS); }
        asm volatile("s_waitcnt vmcnt(0)" ::: "memory"); __syncthreads();
        pg8::Gemm g{XB, Wup_t, M, NUP, DM}; pg8::StaticOrder S; S.init(M, NUP, G, bx);
#if FUSED_CONV
        OPQ(); pg8::EpiUpConv E{RSTD, INP(13), INP(14), ACT, US, (LAS float*)(lds3 + XL_OFF)};
        pg8::gemm_phase<pg8::EpiUpConv, pg8::StaticOrder, CONV_ALIGN, true>(lds3, g, S, E);
#else
        pg8::EpiUp E{RSTD, U};
        pg8::gemm_phase<pg8::EpiUp, pg8::StaticOrder, true, true>(lds3, g, S, E);
        if (G == 256 && bx >= 128) { OPQ(); const float* w_down = INP(15);
            transpose_matrix<0, true>(w_down, DFF, DM, DM, Wdn_t, DFF, 0, nullptr, 0, (bx - 128) * NWAVES + wave, 128 * NWAVES, (LAS float*)(lds3 + wave * 16384), lane); }
#endif
    }
#endif
    xcd_barrier(xbar);

#if (!defined(ONLY) || ONLY == 8) && !FUSED_CONV
    _Pragma("unroll 1") for (int rep_ = 0; rep_ < REPS(8); ++rep_) {
        if (rep_ > 0) xcd_barrier(xbar);
        IDS();
        OPQ(); const float* w_conv = INP(13); const float* b_conv = INP(14);
        const int gt = bx * (NWAVES * 64) + tid, NTH = G * NWAVES * 64;
        for (int it = gt; it < 704 * 512; it += NTH) { const int r = it / 704, k = it - r * 704, t0 = r * 16, pn = k >> 4, j8 = (k & 15) * 8;
            const unsigned ug = 256 * pn + j8, c = 8 * k;
            float wg[3][8], wv[3][8], bg[8], bv[8];
#pragma unroll
            for (int tp = 0; tp < 3; ++tp)
#pragma unroll
                for (int q = 0; q < 2; ++q) { const f32x4 a = *(const f32x4*)(w_conv + tp * NUP + c + 4 * q), b = *(const f32x4*)(w_conv + tp * NUP + DFF + c + 4 * q);
#pragma unroll
                    for (int j = 0; j < 4; ++j) { wg[tp][4 * q + j] = a[j]; wv[tp][4 * q + j] = b[j]; } }
#pragma unroll
            for (int q = 0; q < 2; ++q) { const f32x4 a = *(const f32x4*)(b_conv + c + 4 * q), b = *(const f32x4*)(b_conv + DFF + c + 4 * q);
#pragma unroll
                for (int j = 0; j < 4; ++j) { bg[4 * q + j] = a[j]; bv[4 * q + j] = b[j]; } }
            float g2[8], g1[8], v2[8], v1[8];
            if ((t0 & (SEQ - 1)) == 0) {
#pragma unroll
                for (int j = 0; j < 8; ++j) { g2[j] = 0.f; g1[j] = 0.f; v2[j] = 0.f; v1[j] = 0.f; }
            } else {
                const v4u a2 = *(const v4u*)(U + (size_t)(t0 - 2) * NUP + ug), b2 = *(const v4u*)(U + (size_t)(t0 - 2) * NUP + ug + 128);
                const v4u a1 = *(const v4u*)(U + (size_t)(t0 - 1) * NUP + ug), b1 = *(const v4u*)(U + (size_t)(t0 - 1) * NUP + ug + 128);
#pragma unroll
                for (int q = 0; q < 4; ++q) { g2[2 * q] = pg8::bflo(a2[q]); g2[2 * q + 1] = pg8::bfhi(a2[q]); v2[2 * q] = pg8::bflo(b2[q]); v2[2 * q + 1] = pg8::bfhi(b2[q]);
                    g1[2 * q] = pg8::bflo(a1[q]); g1[2 * q + 1] = pg8::bfhi(a1[q]); v1[2 * q] = pg8::bflo(b1[q]); v1[2 * q + 1] = pg8::bfhi(b1[q]); }
            }
            for (int i4 = 0; i4 < 16; i4 += 4) {
                v4u a0[4], b0[4];
#pragma unroll
                for (int i = 0; i < 4; ++i) { const size_t t = (size_t)(t0 + i4 + i);
                    a0[i] = __builtin_nontemporal_load((const v4u*)(U + t * NUP + ug)); b0[i] = __builtin_nontemporal_load((const v4u*)(U + t * NUP + ug + 128)); }
#pragma unroll
                for (int i = 0; i < 4; ++i) { const size_t t = (size_t)(t0 + i4 + i);
                    float g0[8], v0[8], o[8];
#pragma unroll
                    for (int q = 0; q < 4; ++q) { g0[2 * q] = pg8::bflo(a0[i][q]); g0[2 * q + 1] = pg8::bfhi(a0[i][q]); v0[2 * q] = pg8::bflo(b0[i][q]); v0[2 * q + 1] = pg8::bfhi(b0[i][q]); }
#pragma unroll
                    for (int j = 0; j < 8; ++j) { const float gt_ = fmaf(wg[0][j], g2[j], fmaf(wg[1][j], g1[j], fmaf(wg[2][j], g0[j], bg[j])));
                        const float vl = fmaf(wv[0][j], v2[j], fmaf(wv[1][j], v1[j], fmaf(wv[2][j], v0[j], bv[j])));
                        o[j] = gt_ * pg8::sigm(gt_) * vl; g2[j] = g1[j]; g1[j] = g0[j]; v2[j] = v1[j]; v1[j] = v0[j]; }
                    v4u w; w.x = pk2(o[0], o[1]); w.y = pk2(o[2], o[3]); w.z = pk2(o[4], o[5]); w.w = pk2(o[6], o[7]);
                    *(v4u*)(ACT + t * DFF + c) = w; } }
        }
    }
#endif
    #if !FUSED_CONV
    xcd_barrier(xbar);
#endif

#if !defined(ONLY) || ONLY == 7
    _Pragma("unroll 1") for (int rep_ = 0; rep_ < REPS(7); ++rep_) {
        if (rep_ > 0) xcd_barrier(xbar);
        IDS();
        pg8::StaticOrder S; S.init(M, DM, G, bx);
#if FUSED_CONV
        {
            OPQ(); const float* w_conv = INP(13); const float* b_conv = INP(14); pg8::Unit u0;
            if (S.next(0, u0)) {
                for (int i = tid; i < 4 * DFF; i += NWAVES * 64) { const int gq = i / DFF, c = i - gq * DFF, Gi = 4 * u0.pm + gq; const bool first = (Gi & 31) == 0;
                    const float* up = US + (size_t)Gi * 4 * NUP;
                    float cv[2][2];
#pragma unroll
                    for (int bj = 0; bj < 2; ++bj) { const int uc = bj * DFF + c; const float u0v = first ? 0.f : up[uc], u1v = first ? 0.f : up[NUP + uc], u2v = up[2 * NUP + uc], u3v = up[3 * NUP + uc];
                        const float w0 = w_conv[uc], w1 = w_conv[NUP + uc], w2 = w_conv[2 * NUP + uc], bb = b_conv[uc];
                        cv[bj][0] = fmaf(w0, u0v, fmaf(w1, u1v, fmaf(w2, u2v, bb))); cv[bj][1] = fmaf(w0, u1v, fmaf(w1, u2v, fmaf(w2, u3v, bb))); }
#pragma unroll
                    for (int t = 0; t < 2; ++t) { const float gte = cv[0][t]; ACT[(size_t)(64 * Gi + t) * DFF + c] = (bf16)f2bf(gte * pg8::sigm(gte) * cv[1][t]); } }
            }
            asm volatile("s_waitcnt vmcnt(0)" ::: "memory"); __threadfence(); __syncthreads();
        }
#endif
        pg8::Gemm g{ACT, Wdn_t, M, DM, DFF};
        pg8::EpiFinal E{XB, out};
        pg8::gemm_phase<pg8::EpiFinal, pg8::StaticOrder, true, true>(lds3, g, S, E);
    }
#endif
}

extern "C" void kernel_launch(void* const* d_in, const int* in_sizes, int n_in, void* d_out, int out_size, void* d_ws, size_t ws_size, hipStream_t stream) {
    static int grid = 0;
    if (grid == 0) {
        if (n_in != 16 || in_sizes[0] != M * DM || out_size != M * DM || ws_size < WS_END) { fprintf(stderr, "kernel_launch: unexpected shapes (n_in %d, in0 %d, out %d, ws %zu)\n", n_in, n_in > 0 ? in_sizes[0] : -1, out_size, ws_size); grid = -1; return; }
        int dev = 0, cus = 0, per_cu = 0;
        (void)hipGetDevice(&dev); (void)hipDeviceGetAttribute(&cus, hipDeviceAttributeMultiprocessorCount, dev);
        if (hipFuncSetAttribute((const void*)fwd_mega, hipFuncAttributeMaxDynamicSharedMemorySize, LDS_BYTES) != hipSuccess) { fprintf(stderr, "kernel_launch: hipFuncSetAttribute failed\n"); grid = -1; return; }
        if (hipOccupancyMaxActiveBlocksPerMultiprocessor(&per_cu, (const void*)fwd_mega, NWAVES * 64, LDS_BYTES) != hipSuccess || per_cu < 1) { fprintf(stderr, "kernel_launch: occupancy query says %d\n", per_cu); per_cu = 1; }
        (void)hipGetLastError();
        grid = cus * 1;
        if (grid != 256) fprintf(stderr, "kernel_launch: %d CUs; the single-unit GEMM phases assume 256\n", grid);
    }
    if (grid < 0) return;
    if (hipMemsetAsync(d_ws, 0, 128 * 1024, stream) != hipSuccess) { fprintf(stderr, "kernel_launch: hipMemsetAsync failed\n"); return; }
    Args a{};
    for (int i = 0; i < 16; ++i) a.in[i] = (const float*)d_in[i];
    a.out = (float*)d_out; a.ws = (unsigned char*)d_ws;
    void* kargs[] = {&a};
    hipError_t e = hipLaunchCooperativeKernel((const void*)fwd_mega, dim3(grid), dim3(NWAVES * 64), kargs, LDS_BYTES, stream);
    if (e != hipSuccess) fprintf(stderr, "cooperative launch failed: %s (grid %d)\n", hipGetErrorString(e), grid);
}
```

```cpp
#include <hip/hip_runtime.h>
#include <hip/hip_cooperative_groups.h>
#include <cstdio>
#include <cstdint>
namespace cg = cooperative_groups;
namespace pg8 {
#define PG8_LAS __attribute__((address_space(3)))
typedef unsigned short bf16_t;
typedef short bf16x8 __attribute__((ext_vector_type(8)));
typedef float f32x4 __attribute__((ext_vector_type(4)));
typedef unsigned u32x4 __attribute__((ext_vector_type(4)));
constexpr int BM = 256, BK = 64, HALF = 128, HTB = HALF * BK * 2  , STAGE_BYTES = 8 * HTB, NXCD = 8, WGM = 4;

__host__ __device__ __forceinline__ int lds_byte(int r, int c) { const int st = (r >> 4) * 2 + (c >> 5), rr = r & 15, cc = c & 31, ob = rr * 64 + cc * 2; return st * 1024 + (ob ^ (((ob >> 9) & 1) << 5)); }
__host__ __device__ __forceinline__ void stage_rc(int b, int& R, int& C) { const int st = b / 1024, sb = b % 1024, swz = sb ^ (((sb >> 9) & 1) << 5); R = (st >> 1) * 16 + swz / 64; C = (st & 1) * 32 + (swz % 64) / 2; }
__host__ __device__ __forceinline__ int perm32(int rho) { const int n = rho >> 4, i = rho & 15; return 8 * (i >> 2) + 4 * n + (i & 3); }

struct Unit { int pm, pn; };
struct Gemm { const bf16_t* A; const bf16_t* Bt; int M, N, K; };

struct StaticOrder {
    int nM, nN, nwg, G, c;
    __host__ __device__ void init(int M, int N, int G_, int c_) { nM = M / BM; nN = N / BM; nwg = nM * nN; G = G_; c = c_; }
    __host__ __device__ bool next(int i, Unit& u) const {
        const long L = (long)i * G + c; if (L >= nwg) return false;
        int wgid = (int)L; { const int q = nwg / NXCD, r = nwg % NXCD, xcd = wgid % NXCD, off = wgid / NXCD; wgid = (xcd < r ? xcd * (q + 1) : r * (q + 1) + (xcd - r) * q) + off; }
        const int nig = WGM * nN, gid = wgid / nig, fm = gid * WGM, gsz = (nM - fm) < WGM ? (nM - fm) : WGM;
        u.pm = fm + ((wgid % nig) % gsz); u.pn = (wgid % nig) / gsz; return true;
    }
    __device__ __forceinline__ void a_ready(const Unit&) const {}
    __device__ __forceinline__ void done(const Unit&) const {}
};

__device__ __forceinline__ unsigned cvt_pk_bf16(float lo, float hi) { unsigned r; asm volatile("v_cvt_pk_bf16_f32 %0, %1, %2" : "=v"(r) : "v"(lo), "v"(hi)); return r; }
typedef unsigned u32x4e __attribute__((ext_vector_type(4)));
constexpr float LOG2E = 1.4426950408889634f;
constexpr float EPSN = 1e-6f;
constexpr float QSCALE = 0.08838834764831845f * 1.4426950408889634f;
__device__ __forceinline__ float sigm(float x) { return __builtin_amdgcn_rcpf(1.f + __builtin_amdgcn_exp2f(-x * LOG2E)); }
__device__ __forceinline__ float bflo(unsigned w) { return __uint_as_float(w << 16); }
__device__ __forceinline__ float bfhi(unsigned w) { return __uint_as_float(w & 0xffff0000u); }
__device__ __forceinline__ u32x4e pack8f(const f32x4 a, const f32x4 b) { u32x4e w; w.x = cvt_pk_bf16(a[0], a[1]); w.y = cvt_pk_bf16(a[2], a[3]); w.z = cvt_pk_bf16(b[0], b[1]); w.w = cvt_pk_bf16(b[2], b[3]); return w; }
#define EPI_LDSBAR() do { asm volatile("s_waitcnt lgkmcnt(0)" ::: "memory"); __builtin_amdgcn_s_barrier(); asm volatile("" ::: "memory"); } while (0)

struct EpiProj {
    static constexpr bool PERM = true, AFTER_DRAIN = false, HAS_MID = false;
    bf16_t* QKV; bf16_t* GATES; const float* gains; PG8_LAS float* xl;
    __device__ __forceinline__ void operator()(f32x4 (&acc)[2][2][4][2], const Unit& u, int wr, int wc, int fr, int fq) const {
        const int colt = u.pn * BM, row0 = u.pm * BM + wr * 64 + fr, seg = colt >> 10;
        const bool norm = (seg == 0) | (seg == 1) | (seg == 3) | (seg == 4);
        if (!norm) {
            bf16_t* base; int ldc, col0;
            if (colt >= 6144) { base = GATES; ldc = 4096; col0 = colt - 6144; } else { base = QKV; ldc = 6144; col0 = colt; }
            col0 += wc * 32 + 8 * fq;
#pragma unroll
            for (int ai = 0; ai < 2; ++ai)
#pragma unroll
                for (int m = 0; m < 4; ++m) { bf16_t* rowp = base + (size_t)(row0 + ai * HALF + m * 16) * ldc + col0;
#pragma unroll
                    for (int bj = 0; bj < 2; ++bj) *(u32x4e*)(rowp + bj * HALF) = pack8f(acc[ai][bj][m][0], acc[ai][bj][m][1]); }
        } else {
#pragma unroll
            for (int ai = 0; ai < 2; ++ai)
#pragma unroll
                for (int m = 0; m < 4; ++m)
#pragma unroll
                    for (int bj = 0; bj < 2; ++bj) { const f32x4 a = acc[ai][bj][m][0], b = acc[ai][bj][m][1];
                        float s = (a[0] * a[0] + a[1] * a[1]) + (a[2] * a[2] + a[3] * a[3]) + (b[0] * b[0] + b[1] * b[1]) + (b[2] * b[2] + b[3] * b[3]);
                        s += __shfl_xor(s, 16); s += __shfl_xor(s, 32);
                        if (fq == 0) xl[((ai * HALF + wr * 64 + m * 16 + fr) * 2 + bj) * 4 + wc] = s; }
            EPI_LDSBAR();
            const float* gp = gains + (seg - (seg >= 3 ? 1 : 0)) * 1024 + (colt & 1023) + wc * 32 + 8 * fq;
            const float qs = (seg == 0 || seg == 3) ? QSCALE : 1.f;
            f32x4 g[2][2];
#pragma unroll
            for (int bj = 0; bj < 2; ++bj)
#pragma unroll
                for (int n = 0; n < 2; ++n) g[bj][n] = *(const f32x4*)(gp + bj * HALF + 4 * n) * qs;
            bf16_t* base = QKV + colt + wc * 32 + 8 * fq;
#pragma unroll
            for (int ai = 0; ai < 2; ++ai)
#pragma unroll
                for (int m = 0; m < 4; ++m) { bf16_t* rowp = base + (size_t)(row0 + ai * HALF + m * 16) * 6144;
#pragma unroll
                    for (int bj = 0; bj < 2; ++bj) { const f32x4 p = *(const PG8_LAS f32x4*)(xl + ((ai * HALF + wr * 64 + m * 16 + fr) * 2 + bj) * 4);
                        const float rs = __builtin_amdgcn_rsqf(((p[0] + p[1]) + (p[2] + p[3])) * (1.f / 128.f) + EPSN);
                        *(u32x4e*)(rowp + bj * HALF) = pack8f(acc[ai][bj][m][0] * rs * g[bj][0], acc[ai][bj][m][1] * rs * g[bj][1]); } }
        }
    }
};

__device__ __forceinline__ void gate8(const bf16_t* p, f32x4& s0, f32x4& s1) {
    const u32x4e w = *(const u32x4e*)p;
    s0[0] = sigm(bflo(w.x)); s0[1] = sigm(bfhi(w.x)); s0[2] = sigm(bflo(w.y)); s0[3] = sigm(bfhi(w.y));
    s1[0] = sigm(bflo(w.z)); s1[1] = sigm(bfhi(w.z)); s1[2] = sigm(bflo(w.w)); s1[3] = sigm(bfhi(w.w));
}
struct EpiBr {
    static constexpr bool PERM = true, AFTER_DRAIN = false, HAS_MID = true;
    const bf16_t* G; bf16_t* MG;
    __device__ __forceinline__ void mid(f32x4 (&acc)[2][2][4][2], const Unit& u, int wr, int wc, int fr_in, int fq_in) const {
        (void)fr_in; (void)fq_in; int ln_ = (int)(threadIdx.x & 63u); asm volatile("" : "+v"(ln_)); const int fr = ln_ & 15, fq = ln_ >> 4;
        const int row0 = u.pm * BM + wr * 64 + fr, col0 = u.pn * BM + wc * 32 + 8 * fq;
#define RAT(x, y) ((1.f + __builtin_amdgcn_exp2f(-(y) * LOG2E)) * __builtin_amdgcn_rcpf(1.f + __builtin_amdgcn_exp2f(-(x) * LOG2E)))
#pragma unroll
        for (int ai = 0; ai < 2; ++ai) {
            u32x4e ga[4][2], gb[4][2];
#pragma unroll
            for (int m = 0; m < 4; ++m)
#pragma unroll
                for (int bj = 0; bj < 2; ++bj) { const bf16_t* gp = G + (size_t)(row0 + ai * HALF + m * 16) * 4096 + col0 + bj * HALF; ga[m][bj] = *(const u32x4e*)gp; gb[m][bj] = *(const u32x4e*)(gp + 2048); }
#pragma unroll
            for (int m = 0; m < 4; ++m)
#pragma unroll
                for (int bj = 0; bj < 2; ++bj) { const u32x4e a = ga[m][bj], b = gb[m][bj]; f32x4 r0, r1;
                    r0[0] = RAT(bflo(a.x), bflo(b.x)); r0[1] = RAT(bfhi(a.x), bfhi(b.x)); r0[2] = RAT(bflo(a.y), bflo(b.y)); r0[3] = RAT(bfhi(a.y), bfhi(b.y));
                    r1[0] = RAT(bflo(a.z), bflo(b.z)); r1[1] = RAT(bfhi(a.z), bfhi(b.z)); r1[2] = RAT(bflo(a.w), bflo(b.w)); r1[3] = RAT(bfhi(a.w), bfhi(b.w));
                    acc[ai][bj][m][0] = acc[ai][bj][m][0] * r0; acc[ai][bj][m][1] = acc[ai][bj][m][1] * r1; }
            asm volatile("" ::: "memory"); __builtin_amdgcn_sched_barrier(0); }
#undef RAT
    }
    __device__ __forceinline__ void operator()(f32x4 (&acc)[2][2][4][2], const Unit& u, int wr, int wc, int fr, int fq) const {
        const int row0 = u.pm * BM + wr * 64 + fr, col0 = u.pn * BM + wc * 32 + 8 * fq;
#pragma unroll
        for (int ai = 0; ai < 2; ++ai)
#pragma unroll
            for (int m = 0; m < 4; ++m) { const size_t row = (size_t)(row0 + ai * HALF + m * 16);
#pragma unroll
                for (int bj = 0; bj < 2; ++bj) { const int col = col0 + bj * HALF; f32x4 s0, s1; gate8(G + row * 4096 + 2048 + col, s0, s1);
                    *(u32x4e*)(MG + row * 2048 + col) = pack8f(acc[ai][bj][m][0] * s0, acc[ai][bj][m][1] * s1); } }
    }
};
struct EpiOut {
    static constexpr bool PERM = true, AFTER_DRAIN = true, HAS_MID = false;
    const float* X; bf16_t* XB; float* SSQ;
    __device__ __forceinline__ void fused(f32x4 (&acc)[2][2][4][2], const Unit& u, int wr, int wc, int fr, int fq, PG8_LAS unsigned char* lds, int wid, int lane) const {
        PG8_LAS float* P = (PG8_LAS float*)lds;
        const int row0 = u.pm * BM + wr * 64 + fr, col0 = u.pn * BM + wc * 32 + 8 * fq;
#pragma unroll
        for (int ai = 0; ai < 2; ++ai)
#pragma unroll
            for (int m = 0; m < 4; ++m) { const size_t row = (size_t)(row0 + ai * HALF + m * 16); float ss = 0.f;
#pragma unroll
                for (int bj = 0; bj < 2; ++bj) { const size_t off = row * 2048 + col0 + bj * HALF;
                    const f32x4 v0 = acc[ai][bj][m][0] + __builtin_nontemporal_load((const f32x4*)(X + off)), v1 = acc[ai][bj][m][1] + __builtin_nontemporal_load((const f32x4*)(X + off + 4));
                    *(u32x4e*)(XB + off) = pack8f(v0, v1);
                    ss += (v0[0] * v0[0] + v0[1] * v0[1]) + (v0[2] * v0[2] + v0[3] * v0[3]) + (v1[0] * v1[0] + v1[1] * v1[1]) + (v1[2] * v1[2] + v1[3] * v1[3]); }
                ss += __shfl_xor(ss, 16); ss += __shfl_xor(ss, 32);
                if (fq == 0) P[(ai * HALF + wr * 64 + m * 16 + fr) * 4 + wc] = ss; }
        EPI_LDSBAR();
        const int tid = wid * 64 + lane;
        if (tid < 256) { const f32x4 p = *(const PG8_LAS f32x4*)(P + tid * 4); SSQ[(size_t)(u.pm * BM + tid) * 8 + u.pn] = (p[0] + p[1]) + (p[2] + p[3]); }
    }
};
#ifndef CONV_LDSW
#define CONV_LDSW 0
#endif
__device__ __forceinline__ float ror1f(float v) { return __builtin_bit_cast(float, __builtin_amdgcn_update_dpp(0, __builtin_bit_cast(int, v), 0x121, 0xf, 0xf, false)); }
__device__ __forceinline__ float ror2f(float v) { return __builtin_bit_cast(float, __builtin_amdgcn_update_dpp(0, __builtin_bit_cast(int, v), 0x122, 0xf, 0xf, false)); }
struct EpiUpConv {
    static constexpr bool PERM = true, AFTER_DRAIN = false, HAS_MID = false;
    const float* RSTD; const float* wconv; const float* bconv; bf16_t* ACT; float* US; PG8_LAS float* xl;
    __device__ __forceinline__ void operator()(f32x4 (&acc)[2][2][4][2], const Unit& u, int wr, int wc, int fr_in, int fq_in) const {
        typedef unsigned u32x2e __attribute__((ext_vector_type(2)));
        PG8_LAS float* wl = xl + (unsigned)(wr * 4 + wc) * 256u;
        { const unsigned L_ = threadIdx.x & 63u, ucol_ = (L_ >> 5) * 5632u + (unsigned)u.pn * 128u + (unsigned)wc * 32u + (L_ & 31u);
          const float t0_ = wconv[ucol_], t1_ = wconv[11264u + ucol_], t2_ = wconv[22528u + ucol_], t3_ = bconv[ucol_];
          wl[L_] = t0_; wl[64u + L_] = t1_; wl[128u + L_] = t2_; wl[192u + L_] = t3_;
          asm volatile("s_waitcnt lgkmcnt(0)" ::: "memory"); }
        (void)fr_in; (void)fq_in; int ln_ = (int)(threadIdx.x & 63u); asm volatile("" : "+v"(ln_)); const int fr = ln_ & 15, fq = ln_ >> 4;
        const unsigned cw = (unsigned)(u.pn * 128 + wc * 32 + 8 * fq), row0 = (unsigned)(u.pm * BM + wr * 64 + fr);
        const bool lo = fr < 2, hi14 = fr >= 14, f1 = fr >= 1, f2 = fr >= 2;
#pragma unroll
        for (int ai = 0; ai < 2; ++ai) { const unsigned G = (unsigned)(4 * u.pm + 2 * ai + wr);
            float rs[4];
#pragma unroll
            for (int m = 0; m < 4; ++m) rs[m] = RSTD[row0 + ai * HALF + m * 16];
            const unsigned aoff = (row0 + ai * HALF) * 5632u + cw;
            const unsigned us_lo = (G * 4 + 2 + (fr & 1)) * 11264u; const bool sthi = hi14 && (G + 1 < 128);
#pragma unroll
            for (int n = 0; n < 2; ++n) {
#pragma unroll
                for (int j = 0; j < 4; ++j) { unsigned col = cw + 4 * n + j; asm volatile("" : "+v"(col));
#pragma unroll
                    for (int bj = 0; bj < 2; ++bj) { const unsigned ucol = bj * 5632 + col;
                        const unsigned lc = (unsigned)bj * 32u + (col - (unsigned)u.pn * 128u - (unsigned)wc * 32u);
                        const float w0 = wl[lc], w1 = wl[64u + lc], w2 = wl[128u + lc], bb = wl[192u + lc];
                        float pa1 = 0.f, pa2 = 0.f;
#pragma unroll
                        for (int m = 0; m < 4; ++m) { const float uu = acc[ai][bj][m][n][j] * rs[m];
                            if (m == 0) { if (lo) US[us_lo + ucol] = uu; }
                            if (m == 3) { if (sthi) US[us_lo + 22528u + ucol] = uu; }
                            const float a1 = ror1f(uu), a2 = ror2f(uu);
                            const float p1 = f1 ? a1 : pa1, p2 = f2 ? a2 : pa2;
                            acc[ai][bj][m][n][j] = fmaf(w0, p2, fmaf(w1, p1, fmaf(w2, uu, bb)));
                            pa1 = a1; pa2 = a2; }
                        }
#pragma unroll
                    for (int m = 0; m < 4; ++m) { const float g0 = acc[ai][0][m][n][j]; acc[ai][0][m][n][j] = g0 * sigm(g0) * acc[ai][1][m][n][j]; }
                    asm volatile("" ::: "memory"); }
#pragma unroll
                for (int m = 0; m < 4; ++m) { u32x2e w; w.x = cvt_pk_bf16(acc[ai][0][m][n][0], acc[ai][0][m][n][1]); w.y = cvt_pk_bf16(acc[ai][0][m][n][2], acc[ai][0][m][n][3]);
                    if (!(m == 0 && lo)) *(u32x2e*)(ACT + (aoff + (unsigned)(m * 16 * 5632 + 4 * n))) = w; }
                asm volatile("" ::: "memory"); __builtin_amdgcn_sched_barrier(0); } }
    }
};
struct EpiUp {
    static constexpr bool PERM = true, AFTER_DRAIN = false, HAS_MID = false;
    const float* RSTD; bf16_t* U;
    __device__ __forceinline__ void operator()(f32x4 (&acc)[2][2][4][2], const Unit& u, int wr, int wc, int fr, int fq) const {
        const int row0 = u.pm * BM + wr * 64 + fr, col0 = u.pn * BM + wc * 32 + 8 * fq;
#pragma unroll
        for (int ai = 0; ai < 2; ++ai)
#pragma unroll
            for (int m = 0; m < 4; ++m) { const int row = row0 + ai * HALF + m * 16; const float rs = RSTD[row]; bf16_t* rowp = U + (size_t)row * 11264 + col0;
#pragma unroll
                for (int bj = 0; bj < 2; ++bj) *(u32x4e*)(rowp + bj * HALF) = pack8f(acc[ai][bj][m][0] * rs, acc[ai][bj][m][1] * rs); }
    }
};
struct EpiFinal {
    static constexpr bool PERM = true, AFTER_DRAIN = false, HAS_MID = false;
    const bf16_t* XB; float* OUT;
    __device__ __forceinline__ void operator()(f32x4 (&acc)[2][2][4][2], const Unit& u, int wr, int wc, int fr, int fq) const {
        const int row0 = u.pm * BM + wr * 64 + fr, col0 = u.pn * BM + wc * 32 + 8 * fq;
#pragma unroll
        for (int ai = 0; ai < 2; ++ai)
#pragma unroll
            for (int m = 0; m < 4; ++m)
#pragma unroll
                for (int bj = 0; bj < 2; ++bj) { const size_t off = (size_t)(row0 + ai * HALF + m * 16) * 2048 + col0 + bj * HALF;
                    const u32x4e w = __builtin_nontemporal_load((const u32x4e*)(XB + off));
                    const f32x4 a = {bflo(w.x), bfhi(w.x), bflo(w.y), bfhi(w.y)}, b = {bflo(w.z), bfhi(w.z), bflo(w.w), bfhi(w.w)};
                    __builtin_nontemporal_store(a + acc[ai][bj][m][0], (f32x4*)(OUT + off)); __builtin_nontemporal_store(b + acc[ai][bj][m][1], (f32x4*)(OUT + off + 4)); }
    }
};

template <class Epi, class Sched, bool ALIGN_EPI = false, bool SP2 = false>
__device__ __forceinline__ void gemm_phase(PG8_LAS unsigned char* lds, const Gemm g, const Sched& S, const Epi& E) {
    int tid_o = threadIdx.x; asm volatile("" : "+v"(tid_o));
    const int tid = tid_o, wid = __builtin_amdgcn_readfirstlane(tid >> 6), lane = tid & 63, wr = wid >> 2, wc = wid & 3, fr = lane & 15, fq = lane >> 4;
    const int K = g.K, nt = K / BK;
    unsigned voffA[1], voffB[1];
#pragma unroll
    for (int i = 0; i < 1; ++i) { int R, C; stage_rc(tid * 16 + i * 8192, R, C); const int Rb = Epi::PERM ? ((R & ~31) + perm32(R & 31)) : R;
        voffA[i] = (unsigned)(R * K + C) * 2u; voffB[i] = (unsigned)(Rb * K + C) * 2u; }
    const size_t vstep = (size_t)K * 128;
    const size_t kstep = (size_t)(BK * 2);
    const size_t hstep = (size_t)HALF * K * 2;
    const size_t tstep = 2 * hstep;
    const unsigned ldsw = (unsigned)wid * 1024u;
    const int aoff = lds_byte(wr * 64 + fr, fq * 8), boff = lds_byte(wc * 32 + fr, fq * 8);
#define PG8_SA(b, h) (((b) * 2 + (h)) * HTB)
#define PG8_SB(b, h) ((4 + (b) * 2 + (h)) * HTB)
#define PG8_STAGE(bufoff, gbase, voff) do { _Pragma("unroll") for (int _i = 0; _i < 2; ++_i) \
        __builtin_amdgcn_global_load_lds((const unsigned*)((const char*)(gbase) + (size_t)_i * vstep + (voff)[0]), (PG8_LAS unsigned*)(lds + (bufoff) + ldsw + _i * 8192), 16, 0, 0); } while (0)
#define PG8_LDA(dst, b, h) do { _Pragma("unroll") for (int m = 0; m < 4; ++m) _Pragma("unroll") for (int k = 0; k < 2; ++k) dst[m][k] = *(const PG8_LAS bf16x8*)(lds + PG8_SA(b, h) + aoff + m * 2048 + k * 1024); } while (0)
#define PG8_LDB(dst, b, h) do { _Pragma("unroll") for (int n = 0; n < 2; ++n) _Pragma("unroll") for (int k = 0; k < 2; ++k) dst[n][k] = *(const PG8_LAS bf16x8*)(lds + PG8_SB(b, h) + boff + n * 2048 + k * 1024); } while (0)
#define PG8_MMA(ai, bj, At, Bt) do { __builtin_amdgcn_s_setprio(1); _Pragma("unroll") for (int m = 0; m < 4; ++m) _Pragma("unroll") for (int n = 0; n < 2; ++n) _Pragma("unroll") for (int k = 0; k < 2; ++k) \
        acc[ai][bj][m][n] = __builtin_amdgcn_mfma_f32_16x16x32_bf16(Bt[n][k], At[m][k], acc[ai][bj][m][n], 0, 0, 0); __builtin_amdgcn_s_setprio(0); } while (0)
#define PG8_WAIT_V(n) asm volatile("s_waitcnt vmcnt(" #n ")" ::: "memory")
#define PG8_WAIT_L(n) asm volatile("s_waitcnt lgkmcnt(" #n ")" ::: "memory")
#define PG8_BAR __builtin_amdgcn_s_barrier()
#define PG8_SCHED __builtin_amdgcn_sched_barrier(0)
    Unit cur, nxt; int ui = 0;
    if (!S.next(0, cur)) return;
    f32x4 acc[2][2][4][2];
#pragma unroll
    for (int a = 0; a < 2; ++a)
#pragma unroll
        for (int b = 0; b < 2; ++b)
#pragma unroll
            for (int m = 0; m < 4; ++m)
#pragma unroll
                for (int n = 0; n < 2; ++n) acc[a][b][m][n] = (f32x4){0.f, 0.f, 0.f, 0.f};
    bf16x8 At[4][2], B0[2][2], B1[2][2];
    const char* cA = (const char*)g.A + (size_t)cur.pm * tstep; const char* cB = (const char*)g.Bt + (size_t)cur.pn * tstep;
    S.a_ready(cur);
    if constexpr (SP2) {
        PG8_STAGE(PG8_SB(0, 0), cB, voffB); PG8_STAGE(PG8_SB(0, 1), cB + hstep, voffB); PG8_STAGE(PG8_SA(0, 0), cA, voffA); PG8_STAGE(PG8_SA(0, 1), cA + hstep, voffA);
        if (wr == 1) PG8_BAR;
        PG8_WAIT_V(2); PG8_BAR;
        PG8_STAGE(PG8_SB(1, 0), cB + kstep, voffB); PG8_STAGE(PG8_SA(1, 0), cA + kstep, voffA); PG8_STAGE(PG8_SB(1, 1), cB + hstep + kstep, voffB);
        PG8_WAIT_V(6); PG8_BAR;
    } else {
        PG8_STAGE(PG8_SB(0, 0), cB, voffB); PG8_STAGE(PG8_SA(0, 0), cA, voffA); PG8_STAGE(PG8_SB(0, 1), cB + hstep, voffB); PG8_STAGE(PG8_SA(0, 1), cA + hstep, voffA);
        if (wr == 1) PG8_BAR;
        PG8_WAIT_V(4); PG8_BAR;
        PG8_STAGE(PG8_SB(1, 0), cB + kstep, voffB); PG8_STAGE(PG8_SA(1, 0), cA + kstep, voffA); PG8_STAGE(PG8_SB(1, 1), cB + hstep + kstep, voffB);
        PG8_WAIT_V(6); PG8_BAR;
    }
    for (;;) {
        const bool has_next = S.next(ui + 1, nxt);
        const char* nA = has_next ? (const char*)g.A + (size_t)nxt.pm * tstep : cA; const char* nB = has_next ? (const char*)g.Bt + (size_t)nxt.pn * tstep : cB;
        for (int t = 0; t < nt; t += 2) {
            if constexpr (Epi::HAS_MID) { if (t == (nt >> 1)) E.mid(acc, cur, wr, wc, fr, fq); }
            const bool last = (t == nt - 2);
            const char* a1 = cA + (size_t)(t + 1) * kstep;
            const char* a2 = last ? nA : cA + (size_t)(t + 2) * kstep; const char* b2 = last ? nB : cB + (size_t)(t + 2) * kstep;
            const char* a3 = a2 + kstep; const char* b3 = b2 + kstep;
            if (last && has_next) S.a_ready(nxt);
            if constexpr (SP2) {
            PG8_LDB(B0, 0, 0); PG8_LDB(B1, 0, 1); PG8_SCHED; PG8_LDA(At, 0, 0); PG8_STAGE(PG8_SA(1, 1), a1 + hstep, voffA);
            PG8_WAIT_V(8); PG8_WAIT_L(0); PG8_BAR; PG8_MMA(0, 0, At, B0); PG8_MMA(0, 1, At, B1); PG8_BAR; PG8_SCHED;
            PG8_LDA(At, 0, 1); PG8_STAGE(PG8_SB(0, 0), b2, voffB); PG8_STAGE(PG8_SB(0, 1), b2 + hstep, voffB); PG8_STAGE(PG8_SA(0, 0), a2, voffA);
            PG8_WAIT_V(8); PG8_WAIT_L(0); PG8_BAR; PG8_MMA(1, 0, At, B0); PG8_MMA(1, 1, At, B1); PG8_BAR; PG8_SCHED;
            PG8_LDB(B0, 1, 0); PG8_LDB(B1, 1, 1); PG8_SCHED; PG8_LDA(At, 1, 0); PG8_STAGE(PG8_SA(0, 1), a2 + hstep, voffA);
            PG8_WAIT_V(8); PG8_WAIT_L(0); PG8_BAR; PG8_MMA(0, 0, At, B0); PG8_MMA(0, 1, At, B1); PG8_BAR; PG8_SCHED;
            PG8_LDA(At, 1, 1); PG8_STAGE(PG8_SB(1, 0), b3, voffB); PG8_STAGE(PG8_SB(1, 1), b3 + hstep, voffB); PG8_STAGE(PG8_SA(1, 0), a3, voffA);
            PG8_WAIT_V(8); PG8_WAIT_L(0); PG8_BAR; PG8_MMA(1, 0, At, B0); PG8_MMA(1, 1, At, B1); PG8_BAR; PG8_SCHED;
            } else {
            PG8_LDB(B0, 0, 0); PG8_SCHED; PG8_LDA(At, 0, 0); PG8_STAGE(PG8_SA(1, 1), a1 + hstep, voffA);
            PG8_WAIT_L(8); PG8_BAR; PG8_WAIT_L(0); PG8_MMA(0, 0, At, B0); PG8_BAR; PG8_SCHED;
            PG8_LDB(B1, 0, 1); PG8_STAGE(PG8_SB(0, 0), b2, voffB);
            PG8_BAR; PG8_WAIT_L(0); PG8_MMA(0, 1, At, B1); PG8_BAR;
            PG8_LDA(At, 0, 1); PG8_STAGE(PG8_SA(0, 0), a2, voffA);
            PG8_BAR; PG8_WAIT_L(0); PG8_MMA(1, 0, At, B0); PG8_BAR; PG8_SCHED;
            PG8_STAGE(PG8_SB(0, 1), b2 + hstep, voffB);
            PG8_WAIT_V(6); PG8_BAR; PG8_MMA(1, 1, At, B1); PG8_BAR;
            PG8_LDB(B0, 1, 0); PG8_SCHED; PG8_LDA(At, 1, 0); PG8_STAGE(PG8_SA(0, 1), a2 + hstep, voffA);
            PG8_WAIT_L(8); PG8_BAR; PG8_WAIT_L(0); PG8_MMA(0, 0, At, B0); PG8_BAR; PG8_SCHED;
            PG8_LDB(B1, 1, 1); PG8_STAGE(PG8_SB(1, 0), b3, voffB);
            PG8_BAR; PG8_WAIT_L(0); PG8_MMA(0, 1, At, B1); PG8_BAR;
            PG8_LDA(At, 1, 1); PG8_STAGE(PG8_SA(1, 0), a3, voffA);
            PG8_BAR; PG8_WAIT_L(0); PG8_MMA(1, 0, At, B0); PG8_BAR; PG8_SCHED;
            PG8_STAGE(PG8_SB(1, 1), b3 + hstep, voffB);
            PG8_WAIT_V(6); PG8_BAR; PG8_MMA(1, 1, At, B1); PG8_BAR;
            }
        }
        if constexpr (ALIGN_EPI) { if (wr == 0) PG8_BAR; }
        if constexpr (!Epi::AFTER_DRAIN) { E(acc, cur, wr, wc, fr, fq); S.done(cur); }
        if (!has_next) break;
#pragma unroll
        for (int a = 0; a < 2; ++a)
#pragma unroll
            for (int b = 0; b < 2; ++b)
#pragma unroll
                for (int m = 0; m < 4; ++m)
#pragma unroll
                    for (int n = 0; n < 2; ++n) acc[a][b][m][n] = (f32x4){0.f, 0.f, 0.f, 0.f};
        cur = nxt; cA = nA; cB = nB; ++ui;
        if constexpr (ALIGN_EPI) { if (wr == 1) PG8_BAR; }
    }
    PG8_WAIT_V(0);
    if constexpr (!ALIGN_EPI) { if (wr == 0) PG8_BAR; }
    PG8_BAR;
    if constexpr (Epi::AFTER_DRAIN) { E.fused(acc, cur, wr, wc, fr, fq, lds, wid, lane); S.done(cur); }
#undef PG8_SA
#undef PG8_SB
#undef PG8_STAGE
#undef PG8_LDA
#undef PG8_LDB
#undef PG8_MMA
#undef PG8_WAIT_V
#undef PG8_WAIT_L
#undef PG8_BAR
#undef PG8_SCHED
}
}

namespace att {
typedef unsigned short bf16;
constexpr int D = 128, NW = 8, QBLK = 32, KVBLK = 64, QB = NW * QBLK;
constexpr int SHM_V = KVBLK * D * 2, SHM_K = KVBLK * D * 2;
constexpr int LDS_WS = 2 * SHM_V + 2 * SHM_K, LDS_KB = LDS_WS + NW * 64 * 4, LDS_SLOT = LDS_KB + 2 * 64 * 4, LDS_Q = LDS_SLOT + 256, LDS_END = LDS_Q + NW * 8192;
constexpr float SCALE = 1.f, THR = 8.f;
typedef short bf16x8 __attribute__((ext_vector_type(8)));
typedef short s16x4 __attribute__((ext_vector_type(4)));
typedef float f32x16 __attribute__((ext_vector_type(16)));
typedef float f32x4 __attribute__((ext_vector_type(4)));
typedef unsigned u32x4 __attribute__((ext_vector_type(4)));
template <class A, class Bt> struct same_t { static constexpr bool v = false; };
template <class A> struct same_t<A, A> { static constexpr bool v = true; };

#define KSWZ(row, colB) ((row) * 256 + ((colB) ^ (((row) & 7) << 4)))
#define SBAR() __builtin_amdgcn_sched_barrier(0)
__device__ __forceinline__ int v_st(int k, int c) { const int kk = (k & ~0xC) | ((k & 4) << 1) | ((k & 8) >> 1); return ((kk >> 3) * 4 + (c >> 5)) * 512 + ((kk & 7) * 32 + (c & 31)) * 2; }
__device__ __forceinline__ int v_rd_base(int lane) { return ((lane & 3) << 3) | (((lane >> 2) & 3) << 6) | (((lane >> 4) & 1) << 5) | (((lane >> 5) & 1) << 8); }
constexpr int v_rd_off(int d0, int ks, int half) { return d0 * 512 + ks * 4096 + half * 2048; }
__device__ __forceinline__ int crow(int r, int hi) { return (r & 3) + 8 * (r >> 2) + 4 * hi; }
__device__ __forceinline__ unsigned cvtpk(float lo, float hi) {
    unsigned r; asm volatile("v_cvt_pk_bf16_f32 %0, %1, %2" : "=v"(r) : "v"(lo), "v"(hi)); return r;
}
__device__ __forceinline__ bf16x8 pack8(f32x4 a, f32x4 b) {
    u32x4 w = {cvtpk(a[0], a[1]), cvtpk(a[2], a[3]), cvtpk(b[0], b[1]), cvtpk(b[2], b[3])};
    return *reinterpret_cast<bf16x8*>(&w);
}
template <class T> __device__ __forceinline__ bf16x8 load8(const T* p) {
    if constexpr (same_t<T, float>::v) { return pack8(*(const f32x4*)p, *(const f32x4*)(p + 4)); }
    else { return *reinterpret_cast<const bf16x8*>(p); }
}
__device__ __forceinline__ void mask_tile(f32x16& p0, f32x16& p1, int dq, unsigned W) {
    const float NEG = -__builtin_inff();
#pragma unroll
    for (int r = 0; r < 16; ++r) {
        const int c = (r & 3) + 8 * (r >> 2);
        if ((unsigned)(dq - c) >= W) p0[r] = NEG;
        if ((unsigned)(dq - c - 32) >= W) p1[r] = NEG;
    }
}
__device__ __forceinline__ void partialSM(f32x16& p0, f32x16& p1, float& m_reg, float& mn, float& alpha) {
    float pmax = p0[0]; for (int r = 1; r < 16; ++r) pmax = fmaxf(pmax, p0[r]); for (int r = 0; r < 16; ++r) pmax = fmaxf(pmax, p1[r]);
    { auto rr = __builtin_amdgcn_permlane32_swap(__float_as_uint(pmax), __float_as_uint(pmax), false, false);
      pmax = fmaxf(__uint_as_float(rr[0]), __uint_as_float(rr[1])); }
    constexpr float C2 = 1.f;
    if (__builtin_expect(__all((pmax - m_reg) * SCALE <= THR), 1)) { mn = m_reg; alpha = 1.f; }
    else { mn = fmaxf(m_reg, pmax); alpha = __builtin_amdgcn_exp2f((m_reg - mn) * C2); m_reg = mn; }
    const float mnL = -mn * C2;
    for (int r = 0; r < 16; ++r) p0[r] = fmaf(p0[r], C2, mnL); for (int r = 0; r < 16; ++r) p1[r] = fmaf(p1[r], C2, mnL);
    for (int r = 0; r < 16; ++r) p0[r] = __builtin_amdgcn_exp2f(p0[r]);
}
__device__ __forceinline__ void finishSM(f32x16& p0, f32x16& p1, float alpha, float& l_reg, bf16x8& pa0, bf16x8& pa1, bf16x8& pa2, bf16x8& pa3) {
    for (int r = 0; r < 16; ++r) p1[r] = __builtin_amdgcn_exp2f(p1[r]);
    float ps = 0; for (int r = 0; r < 16; ++r) ps += p0[r]; for (int r = 0; r < 16; ++r) ps += p1[r];
    { auto rr = __builtin_amdgcn_permlane32_swap(__float_as_uint(ps), __float_as_uint(ps), false, false);
      ps = __uint_as_float(rr[0]) + __uint_as_float(rr[1]); }
    l_reg = l_reg * alpha + ps;
#define PK4(P, B_, OUT) do { unsigned a0 = cvtpk(P[B_+0], P[B_+1]), a1 = cvtpk(P[B_+2], P[B_+3]);                          \
        unsigned b0 = cvtpk(P[B_+4], P[B_+5]), b1 = cvtpk(P[B_+6], P[B_+7]);                                             \
        auto r0 = __builtin_amdgcn_permlane32_swap(a0, b0, false, false); auto r1 = __builtin_amdgcn_permlane32_swap(a1, b1, false, false); \
        u32x4 w = {r0[0], r1[0], r0[1], r1[1]}; OUT = *reinterpret_cast<bf16x8*>(&w); } while (0)
    PK4(p0, 0, pa0); PK4(p0, 8, pa1); PK4(p1, 0, pa2); PK4(p1, 8, pa3);
#undef PK4
}
template <int KB, bool SK>
__device__ __forceinline__ void qkt(f32x16& p0, f32x16& p1, const char* K_lds, const float* kbl, int r32, int hi, const __attribute__((address_space(3))) char* q_lds, bool act) {
    if (SK && !act) { const float NEG = -__builtin_inff();
#pragma unroll
        for (int r = 0; r < 16; ++r) { p0[r] = NEG; p1[r] = NEG; } return; }
    { const float* kb_ = kbl + KB * 64 + 4 * hi;
#pragma unroll
      for (int j = 0; j < 4; ++j) { const f32x4 a = *(const f32x4*)(kb_ + 8 * j), b = *(const f32x4*)(kb_ + 32 + 8 * j);
          p0[4 * j] = a[0]; p0[4 * j + 1] = a[1]; p0[4 * j + 2] = a[2]; p0[4 * j + 3] = a[3];
          p1[4 * j] = b[0]; p1[4 * j + 1] = b[1]; p1[4 * j + 2] = b[2]; p1[4 * j + 3] = b[3]; } }
    const char* kb[4];
#pragma unroll
    for (int dd = 0; dd < 4; ++dd) kb[dd] = K_lds + KB * SHM_K + KSWZ(r32, (dd * 16 + hi * 8) * 2);
#pragma unroll
    for (int d0 = 0; d0 < 8; ++d0) { const char* a = kb[d0 & 3] + (d0 >> 2) * 128;
        bf16x8 b0 = *reinterpret_cast<const bf16x8*>(a);
        bf16x8 b1 = *reinterpret_cast<const bf16x8*>(a + 32 * 256);
        const bf16x8 q_ = *(const __attribute__((address_space(3))) bf16x8*)(q_lds + d0 * 1024);
        p0 = __builtin_amdgcn_mfma_f32_32x32x16_bf16(b0, q_, p0, 0, 0, 0);
        p1 = __builtin_amdgcn_mfma_f32_32x32x16_bf16(b1, q_, p1, 0, 0, 0); }
}
template <int VB, bool SK>
__device__ __forceinline__ void pv_tile(f32x16* o, int vb0, bf16x8 pa0, bf16x8 pa1, bf16x8 pa2, bf16x8 pa3, bool act) {
    if (SK && !act) return;
#define TRRD(dst, off) asm volatile("ds_read_b64_tr_b16 %0, %1 offset:%2" : "=&v"(dst) : "v"(vb0), "i"(off) : "memory")
#define PV_D0(d0) do { s16x4 l0, l1, l2, l3, h0, h1, h2, h3; constexpr int b_ = VB * SHM_V + v_rd_off(d0, 0, 0);     \
        TRRD(l0, b_); TRRD(h0, b_ + 2048); TRRD(l1, b_ + 4096); TRRD(h1, b_ + 6144); TRRD(l2, b_ + 8192); TRRD(h2, b_ + 10240); TRRD(l3, b_ + 12288); TRRD(h3, b_ + 14336); \
        asm volatile("s_waitcnt lgkmcnt(0)" ::: "memory"); SBAR();                 \
        o[d0] = __builtin_amdgcn_mfma_f32_32x32x16_bf16(pa0, (bf16x8){l0[0], l0[1], l0[2], l0[3], h0[0], h0[1], h0[2], h0[3]}, o[d0], 0, 0, 0);   \
        o[d0] = __builtin_amdgcn_mfma_f32_32x32x16_bf16(pa1, (bf16x8){l1[0], l1[1], l1[2], l1[3], h1[0], h1[1], h1[2], h1[3]}, o[d0], 0, 0, 0);   \
        o[d0] = __builtin_amdgcn_mfma_f32_32x32x16_bf16(pa2, (bf16x8){l2[0], l2[1], l2[2], l2[3], h2[0], h2[1], h2[2], h2[3]}, o[d0], 0, 0, 0);   \
        o[d0] = __builtin_amdgcn_mfma_f32_32x32x16_bf16(pa3, (bf16x8){l3[0], l3[1], l3[2], l3[3], h3[0], h3[1], h3[2], h3[3]}, o[d0], 0, 0, 0); } while (0)
    PV_D0(0); PV_D0(1); PV_D0(2); PV_D0(3);
#undef PV_D0
#undef TRRD
}

constexpr float LOG2E = 1.4426950408889634f;
struct Blk {
    const bf16* Q; const bf16* K; const bf16* V; bf16* O; float* LSE; const float* CUM;
    long rs, os; int ls;
    int P0, L, W, nvalid; float sd2, cref;
};
struct Seam { bf16x8 st_v0, st_v1, st_k0, st_k1; float st_b0, st_b1; };
__device__ __forceinline__ float kbias_raw(const Blk& B, int key) { return B.CUM ? B.CUM[key] : B.sd2 * (float)(key - B.P0); }
__device__ __forceinline__ float kbias_fin(const Blk& B, float raw) { return B.CUM ? -raw * LOG2E : raw; }
__device__ __forceinline__ int swa_jlo(int P0, int W) { const int lowk = P0 - W + 1; return lowk > 0 ? lowk / KVBLK : 0; }
__device__ __forceinline__ int swa_jhi(int P0, int L) { int j = (P0 + QB - 1) / KVBLK + 1; const int jm = L / KVBLK; return j > jm ? jm : j; }
__device__ __forceinline__ bf16x8 ld8(const bf16* p) { return *reinterpret_cast<const bf16x8*>(p); }
#define ROWP(p, rs_, k0, rr) ((p) + (size_t)(k0) * (rs_) + (unsigned)(((rr) * (int)(rs_)) + sc))
#define VMW() asm volatile("s_waitcnt vmcnt(0)" ::: "memory")
#define SLOAD(B_, k0) do { const bf16* vb_ = (B_).V + (size_t)(k0) * (B_).rs; const bf16* kb_ = (B_).K + (size_t)(k0) * (B_).rs;     \
                           unsigned o0_ = (unsigned)(sr * (int)(B_).rs + sc), o1_ = o0_ + 32u * (unsigned)(B_).rs; asm volatile("" : "+v"(o0_), "+v"(o1_));       \
                           S.st_v0 = ld8(vb_ + o0_); S.st_v1 = ld8(vb_ + o1_); S.st_k0 = ld8(kb_ + o0_); S.st_k1 = ld8(kb_ + o1_);                                  \
                           if ((tid & 15) == 0) { S.st_b0 = kbias_raw((B_), (k0) + sr); S.st_b1 = kbias_raw((B_), (k0) + 32 + sr); } } while (0)
#define SWRITE_K(bf, B_) do { *(bf16x8*)(K_lds + (bf) * SHM_K + kws) = S.st_k0; *(bf16x8*)(K_lds + (bf) * SHM_K + kws + 32 * 256) = S.st_k1;       \
                          if ((tid & 15) == 0) { kbl[(bf) * 64 + sr] = kbias_fin((B_), S.st_b0); kbl[(bf) * 64 + 32 + sr] = kbias_fin((B_), S.st_b1); } } while (0)
#define SWRITE_V(bf) do { *(bf16x8*)(V_lds + (bf) * SHM_V + vst0) = S.st_v0; *(bf16x8*)(V_lds + (bf) * SHM_V + vst1) = S.st_v1; } while (0)
#define QLOAD(B_) do { const int ri_ = (wid * QBLK + r32 < (B_).nvalid) ? wid * QBLK + r32 : (B_).nvalid - 1;                                    \
        const bf16* qp_ = (B_).Q + (unsigned)(ri_ * (int)(B_).rs + hi * 8);                                                                       \
        _Pragma("unroll") for (int hf_ = 0; hf_ < 2; ++hf_) { bf16x8 t_[4];                                                                      \
            _Pragma("unroll") for (int d0 = 0; d0 < 4; ++d0) t_[d0] = ld8(qp_ + (hf_ * 4 + d0) * 16);                                           \
            _Pragma("unroll") for (int d0 = 0; d0 < 4; ++d0) *(__attribute__((address_space(3))) bf16x8*)(q_lds + (hf_ * 4 + d0) * 1024) = t_[d0]; } } while (0)

__device__ __forceinline__ void prime(const Blk& cur, char* lds, Seam& S) {
    int tid_o = threadIdx.x; asm volatile("" : "+v"(tid_o));
    const int tid = tid_o, wid = __builtin_amdgcn_readfirstlane(tid >> 6), lane = tid & 63, r32 = lane & 31, hi = lane >> 5;
    const int sr = tid >> 4, sc = (tid & 15) * 8, kws = KSWZ(sr, sc * 2); char* K_lds = lds + 2 * SHM_V; float* kbl = (float*)(lds + LDS_KB); __attribute__((address_space(3))) char* q_lds = (__attribute__((address_space(3))) char*)(lds + LDS_Q + wid * 8192 + lane * 16);
    const int kb0 = (swa_jhi(cur.P0, cur.L) - 1) * KVBLK;
    S.st_b0 = 0.f; S.st_b1 = 0.f;
    QLOAD(cur);
    SLOAD(cur, kb0); VMW(); SWRITE_K(0, cur);
    __syncthreads();
}
#ifndef ATT_SK
#define ATT_SK true
#endif
struct AttnArgs { const bf16* QKV; unsigned char* ws; long offOA, offOP0, offOP2x; float* LSE; const float* CUM; };
__device__ __forceinline__ Blk decode(int i, const AttnArgs& A);
template <bool SK>
__device__ __forceinline__ bool block(const Blk& cur, Blk& nxt, int pend, int nitems, volatile int* slot, const AttnArgs& A, char* lds, Seam& S) {
    int tid_o = threadIdx.x; asm volatile("" : "+v"(tid_o));
    const int tid = tid_o, wid = __builtin_amdgcn_readfirstlane(tid >> 6), lane = tid & 63, r32 = lane & 31, hi = lane >> 5;
    const int W = cur.W;
    const int j_lo = swa_jlo(cur.P0, W);
    const int j_hi = swa_jhi(cur.P0, cur.L);
    const int NT = j_hi - j_lo;
    const int qlo = cur.P0 + wid * QBLK, qm = qlo + r32 - 4 * hi;
    char* V_lds = lds; char* K_lds = lds + 2 * SHM_V;
    float* ws = (float*)(lds + LDS_WS) + wid * 64; float* li_l = ws, * al_l = ws + 32; float* kbl = (float*)(lds + LDS_KB); __attribute__((address_space(3))) char* q_lds = (__attribute__((address_space(3))) char*)(lds + LDS_Q + wid * 8192 + lane * 16);
    float m_reg = -1e30f, l_reg = 0; f32x16 o[4] = {};
    const int sr = tid >> 4, sc = (tid & 15) * 8, vst0 = v_st(sr, sc), vst1 = v_st(32 + sr, sc), kws = KSWZ(sr, sc * 2);
    const int vb0 = (int)(uintptr_t)V_lds + v_rd_base(lane);
#define RESC(a) do { if (__any((a) < 1.f)) { if (hi == 0) al_l[r32] = (a); asm volatile("s_waitcnt lgkmcnt(0)" ::: "memory");              \
                     for (int d_ = 0; d_ < 4; ++d_) for (int r = 0; r < 16; ++r) o[d_][r] *= al_l[crow(r, hi)]; } } while (0)
#define KBASE(t) ((j_hi - 1 - (t)) * KVBLK)
#define ACT(t) (KBASE(t) <= qlo + QBLK - 1 && KBASE(t) + KVBLK - 1 >= qlo - W + 1)
#define MASKT(P0_, P1_, t) do { const int kb_ = KBASE(t); if ((!SK || ACT(t)) && (kb_ + KVBLK - 1 > qlo || kb_ <= qlo + QBLK - 1 - W)) mask_tile(P0_, P1_, qm - kb_, (unsigned)W); } while (0)
    f32x16 pA0, pA1, pB0, pB1; float mnA, mnB, alA, alB; bf16x8 pa0, pa1, pa2, pa3;
    SWRITE_V(0); SBAR();
    if (NT > 1) SLOAD(cur, KBASE(1));
    SBAR(); qkt<0, SK>(pA0, pA1, K_lds, kbl, r32, hi, q_lds, ACT(0));
    MASKT(pA0, pA1, 0); partialSM(pA0, pA1, m_reg, mnA, alA);
    if (NT > 1) { VMW(); SWRITE_V(1); SWRITE_K(1, cur); }
    __syncthreads();
#define HALF_STEP(PX0, PX1, mnX, alX, PY0, PY1, alY, t, KB, VB, SB) do {                                                      \
        SBAR(); qkt<KB, SK>(PX0, PX1, K_lds, kbl, r32, hi, q_lds, ACT(t));                                                     \
        finishSM(PY0, PY1, alY, l_reg, pa0, pa1, pa2, pa3); SBAR();                                                           \
        if ((t) + 1 < NT) { SLOAD(cur, KBASE((t) + 1)); SBAR(); }                                                             \
        pv_tile<VB, SK>(o, vb0, pa0, pa1, pa2, pa3, ACT((t) - 1)); MASKT(PX0, PX1, (t)); partialSM(PX0, PX1, m_reg, mnX, alX); \
        __syncthreads();                                                                                                      \
        if ((t) + 1 < NT) { VMW(); SWRITE_V(SB); SWRITE_K(SB, cur); }                                                              \
        RESC(alX); __syncthreads(); } while (0)
    for (int t = 1; t + 1 < NT; t += 2) {
        HALF_STEP(pB0, pB1, mnB, alB, pA0, pA1, alA, t, 1, 0, 0);
        HALF_STEP(pA0, pA1, mnA, alA, pB0, pB1, alB, t + 1, 0, 1, 1);
    }
    const bool even = (NT & 1) == 0;
    if (even) { SBAR(); qkt<1, SK>(pB0, pB1, K_lds, kbl, r32, hi, q_lds, ACT(NT - 1)); SBAR(); }
    if (tid == 0) slot[0] = pend;
    __syncthreads();
    const int ni = __builtin_amdgcn_readfirstlane(slot[0]); const bool last = ni >= nitems;
    nxt = decode(last ? 0 : ni, A);
    if (!last) { const int kbn = (swa_jhi(nxt.P0, nxt.L) - 1) * KVBLK;
        SLOAD(nxt, kbn); SBAR();
        QLOAD(nxt); }
    SBAR();
    finishSM(pA0, pA1, alA, l_reg, pa0, pa1, pa2, pa3); SBAR();
    pv_tile<0, SK>(o, vb0, pa0, pa1, pa2, pa3, ACT(even ? NT - 2 : NT - 1));
    if (even) { MASKT(pB0, pB1, NT - 1); partialSM(pB0, pB1, m_reg, mnB, alB); __syncthreads(); RESC(alB);
        finishSM(pB0, pB1, alB, l_reg, pa0, pa1, pa2, pa3); SBAR(); pv_tile<1, SK>(o, vb0, pa0, pa1, pa2, pa3, ACT(NT - 1)); }
    SBAR(); if (!last) SWRITE_K(0, nxt); SBAR();
    int lne_ = (int)(threadIdx.x & 63u); asm volatile("" : "+v"(lne_)); const int r32e = lne_ & 31, hie = lne_ >> 5;
    if (hie == 0) li_l[r32e] = l_reg; asm volatile("s_waitcnt lgkmcnt(0)" ::: "memory");
    float rli[16];
#pragma unroll
    for (int r = 0; r < 16; ++r) rli[r] = __builtin_amdgcn_rcpf(li_l[crow(r, hie)]);
    bf16* Ow = cur.O + (size_t)(wid * QBLK) * cur.os;
#pragma unroll
    for (int r = 0; r < 16; ++r) { const int orow = crow(r, hie); const bool ok = (wid * QBLK + orow < cur.nvalid) && ((r32e & 1) == 0);
#pragma unroll
        for (int d0 = 0; d0 < 4; ++d0) { const float v = o[d0][r] * rli[r]; const float vn = __shfl_xor(v, 1);
            if (ok) *(unsigned*)(Ow + (unsigned)(orow * (int)cur.os + d0 * 32 + r32e)) = cvtpk(v, vn); } }
    if (cur.LSE && hie == 0 && wid * QBLK + r32e < cur.nvalid)
        cur.LSE[(unsigned)((wid * QBLK + r32e) * cur.ls)] = m_reg + __builtin_amdgcn_logf(l_reg) - cur.sd2 * (float)(wid * QBLK + r32e);
    __syncthreads();
    return last;
#undef RESC
#undef KBASE
#undef ACT
#undef MASKT
#undef HALF_STEP
}
#undef ROWP
#undef VMW
#undef SLOAD
#undef SWRITE_K
#undef SWRITE_V
#undef QLOAD

constexpr int NITEMS = 256 + 256 + 256 + 512;
__device__ __forceinline__ Blk decode(int i_in, const AttnArgs& A) {
    const int i = __builtin_amdgcn_readfirstlane(i_in);
    Blk b; int bh, qb, res, dil, pat; const bool fox = i < 256;
    if (i < 256) { qb = 7 - (i >> 5); bh = i & 31; res = 0; dil = 1; pat = 0; }
    else if (i < 512) { const int j = i - 256; qb = 7 - (j >> 5); bh = j & 31; res = 0; dil = 1; pat = 0; }
    else if (i < 768) { const int j = i - 512; bh = j & 31; const int rest = j >> 5; res = rest >> 1; qb = rest & 1; dil = 4; pat = 1; }
    else { const int j = i - 768; bh = j & 31; res = j >> 5; qb = 0; dil = 16; pat = 2; }
    const int bb = bh >> 3, h = bh & 7, L = 2048 / dil, P0 = qb * 256;
    const size_t tok0 = (size_t)bb * 2048 + res;
    const int seg = fox ? 0 : 3;
    const bf16* base = A.QKV + tok0 * 6144 + h * 128;
    const int opitch = fox ? 2048 : 1024;
    b.rs = (long)dil * 6144; b.os = (long)dil * opitch; b.ls = dil * 8;
    b.Q = base + seg * 1024 + (size_t)P0 * b.rs; b.K = base + (seg + 1) * 1024; b.V = base + (seg + 2) * 1024;
    long ooff = A.offOP0 + (long)pat * (16l << 20) + (pat == 2 ? A.offOP2x : 0l); ooff = fox ? A.offOA : ooff;
    bf16* ob = (bf16*)(A.ws + ooff);
    b.O = ob + (tok0 + (size_t)P0 * dil) * opitch + h * 128;
    float* lb = A.LSE + (size_t)pat * (8192 * 8);
    b.LSE = fox ? nullptr : lb + (tok0 + (size_t)P0 * dil) * 8 + h;
    b.CUM = fox ? A.CUM + (size_t)bh * 2048 : nullptr;
    b.cref = 0.f;
    b.P0 = P0; b.L = L; b.W = fox ? (1 << 30) : 129; b.nvalid = (L - P0) < QB ? (L - P0) : QB;
    b.sd2 = fox ? 0.f : __builtin_amdgcn_exp2f(-(float)(h + 1)) * (float)dil * LOG2E;
    return b;
}
__device__ __forceinline__ void attn_phase(char* lds, const AttnArgs& A, unsigned* ctr, int first = 0) {
    volatile int* slot = (volatile int*)(lds + LDS_SLOT);
    const int G = (int)gridDim.x, ci = first + (int)blockIdx.x;
    if (ci >= NITEMS) return;
    Blk cur = decode(ci, A); Seam S;
    prime(cur, lds, S);
    for (;;) {
        int pend = NITEMS; if (threadIdx.x == 0) pend = first + G + (int)atomicAdd(ctr, 1u);
        Blk nxt; bool last;
        if (cur.CUM) last = block<false>(cur, nxt, pend, NITEMS, slot, A, lds, S);
        else last = block<true>(cur, nxt, pend, NITEMS, slot, A, lds, S);
        if (last) break;
        cur = nxt;
    }
}
#undef SBAR
}

#define GAS __attribute__((address_space(1)))
#define LAS __attribute__((address_space(3)))
typedef unsigned short bf16;
typedef unsigned v4u __attribute__((ext_vector_type(4)));
typedef float f32x4 __attribute__((ext_vector_type(4)));
constexpr int NWAVES = 8;
constexpr int NB = 4, SEQ = 2048, DM = 2048, M = NB * SEQ, NH = 8, HD = 128, DFF = 5632, NUP = 2 * DFF, INC = 10248, NPROJ = 10240;
constexpr float EPS = 1e-6f;
constexpr float LOG2E_F = 1.4426950408889634f;
constexpr size_t MiB = 1u << 20;
constexpr size_t WS_CTL = 0, WS_BAR = 64 * 1024;
constexpr size_t WS_GAIN = 2 * MiB, WS_RSTD = 3 * MiB;
constexpr size_t WS_SSQ = 256 * 1024, WS_CUM = 512 * 1024, WS_LOGF = 768 * 1024, WS_LSE = 1 * MiB;
constexpr size_t WS_WIN = 4 * MiB, WS_WBRF = 44 * MiB, WS_WBRD = 48 * MiB, WS_WOUT = 52 * MiB, WS_WUP = 60 * MiB, WS_WDN = 104 * MiB;
constexpr size_t WS_XN = 126 * MiB;
constexpr size_t WS_QKV = 158 * MiB;
constexpr size_t WS_GATES = 254 * MiB;
constexpr size_t WS_OA = 4 * MiB, WS_OB = 20 * MiB;
constexpr size_t WS_OP0 = 126 * MiB, WS_OP1 = 142 * MiB, WS_OP2 = 318 * MiB;
constexpr size_t WS_T = 158 * MiB, WS_MG = 222 * MiB;
constexpr size_t WS_XB = 126 * MiB;
#ifndef CONV_ALIGN
#define CONV_ALIGN false
#endif
#ifndef FUSED_CONV
#define FUSED_CONV 0
#endif
constexpr size_t WS_U = 158 * MiB;
constexpr size_t WS_ACT = FUSED_CONV ? 158 * MiB : 4 * MiB, WS_US = 254 * MiB;
constexpr size_t WS_END = 334 * MiB;
constexpr int RING_BYTES = 131072, XL_OFF = RING_BYTES, BARST_OFF = 143360, LDS_BYTES = 147456;
static_assert(att::LDS_END <= LDS_BYTES, "attention LDS");

__device__ __forceinline__ unsigned f2bf(float f) { unsigned u = __builtin_bit_cast(unsigned, f); return (u + 0x7fffu + ((u >> 16) & 1u)) >> 16; }
__device__ __forceinline__ unsigned pk2(float lo, float hi) { return f2bf(lo) | (f2bf(hi) << 16); }
__device__ __forceinline__ float wave_sum(float v) {
#pragma unroll
    for (int o = 1; o < 64; o <<= 1) v += __shfl_xor(v, o);
    return v;
}
template <int MODE, bool NTST>
__device__ __forceinline__ void transpose_matrix(const float* W, int K, int Nsrc, int Ndst, bf16* WT, int Kdst, int koff, const float* kscale, int rot, int gw, int NGW, LAS float* scr, int lane, int lo = 0, int ilim = 0x7fffffff) {
    const int nblk = Ndst / 32, nall = (K / 64) * nblk, nitems = nall < ilim ? nall : ilim, rr = lane >> 3, c4 = (lane & 7) * 4, c = lane & 7;
    int it = gw - rot; if (it < 0) it += NGW; it += lo;
    f32x4 v[8]; int k0 = 0, n0 = 0;
#define TM_LOAD(dst, IT, K0, N0) do { const int kb_ = (IT) / nblk; N0 = 32 * ((IT) - kb_ * nblk); K0 = 64 * kb_;                                   \
        const int sc_ = MODE == 0 ? N0 : (MODE == 1 ? (N0 < 3072 ? N0 : N0 + 8) : (((N0 >> 7) & 1) * 5632 + 128 * (N0 >> 8) + (N0 & 127)));       \
        _Pragma("unroll") for (int i = 0; i < 8; ++i) dst[i] = __builtin_nontemporal_load((const f32x4*)(W + (size_t)(K0 + 8 * i + rr) * Nsrc + sc_ + c4)); } while (0)
    if (it < nitems) TM_LOAD(v, it, k0, n0);
    while (it < nitems) {
        const int itn = it + NGW; f32x4 vn[8]; int k0n = 0, n0n = 0;
        if (itn < nitems) TM_LOAD(vn, itn, k0n, n0n);
        if (kscale) {
#pragma unroll
            for (int i = 0; i < 8; ++i) v[i] = v[i] * kscale[k0 + 8 * i + rr]; }
#pragma unroll
        for (int i = 0; i < 8; ++i) { LAS float* d = scr + (8 * i + rr) * 33 + c4; d[0] = v[i][0]; d[1] = v[i][1]; d[2] = v[i][2]; d[3] = v[i][3]; }
        asm volatile("s_waitcnt lgkmcnt(0)" ::: "memory");
#pragma unroll
        for (int j = 0; j < 4; ++j) { const int n = (lane >> 3) + 8 * j; const LAS float* sp = scr + (8 * c) * 33 + n;
            v4u o; o.x = pk2(sp[0 * 33], sp[1 * 33]); o.y = pk2(sp[2 * 33], sp[3 * 33]); o.z = pk2(sp[4 * 33], sp[5 * 33]); o.w = pk2(sp[6 * 33], sp[7 * 33]);
            if constexpr (NTST) __builtin_nontemporal_store(o, (v4u*)(WT + (size_t)(n0 + n) * Kdst + koff + k0 + 8 * c)); else *(v4u*)(WT + (size_t)(n0 + n) * Kdst + koff + k0 + 8 * c) = o; }
        asm volatile("s_waitcnt lgkmcnt(0)" ::: "memory");
        it = itn; k0 = k0n; n0 = n0n;
#pragma unroll
        for (int i = 0; i < 8; ++i) v[i] = vn[i];
    }
#undef TM_LOAD
}

typedef GAS unsigned gu32;
#define RLX_AGENT __ATOMIC_RELAXED, __HIP_MEMORY_SCOPE_AGENT
#define XB_TMO      128
#define XB_XCNT(j)  (256  + 64 * (j))
#define XB_XSUB(j)  (1280 + 64 * (j))
#define XB_XGEN(j)  (2304 + 64 * (j))
#define XB_TOP      3328
#define XB_TOPGEN   3392
#define XCD_BAR_WORDS 3456
#define XB_SPIN_CAP (1u << 18)

__device__ __forceinline__ unsigned xb_ld(unsigned* p)              { return __hip_atomic_load(p, __ATOMIC_RELAXED, __HIP_MEMORY_SCOPE_AGENT); }
__device__ __forceinline__ unsigned xb_add(unsigned* p, unsigned v) { return __hip_atomic_fetch_add(p, v, __ATOMIC_RELAXED, __HIP_MEMORY_SCOPE_AGENT); }
__device__ __forceinline__ unsigned xb_xcc_id() { return (unsigned)__builtin_amdgcn_s_getreg((3 << 11) | 20) & 0xFu; }
#define XB_SPIN(cond, bar) do { unsigned _sp = 0; while (cond) { __builtin_amdgcn_s_sleep(1); \
    if ((++_sp & 255u) == 0u) { if (xb_ld(&(bar)[XB_TMO])) break; if (_sp > XB_SPIN_CAP) { atomicAdd(&(bar)[XB_TMO], 1u); break; } } } } while (0)

struct XcdBarrier {
    unsigned* bar; unsigned x;
    volatile LAS unsigned* st;
};

__device__ __forceinline__ XcdBarrier xcd_barrier_post(unsigned* bar, volatile LAS unsigned* st) {
    XcdBarrier b; b.bar = bar; b.x = xb_xcc_id(); b.st = st;
    if (threadIdx.x == 0) (void)xb_add(&bar[XB_XCNT(b.x)], 1u);
    return b;
}
__device__ __forceinline__ void xcd_barrier_complete(unsigned* bar, unsigned x, unsigned& nloc, unsigned& nx) {
    const unsigned G = gridDim.x * gridDim.y * gridDim.z;
    unsigned sum, cnt, mine, sp = 0u;
    for (;;) {
        sum = 0u; cnt = 0u; mine = 0u;
#pragma unroll
        for (unsigned j = 0; j < 16; ++j) { const unsigned c = xb_ld(&bar[XB_XCNT(j)]); sum += c; cnt += (c > 0u) ? 1u : 0u; mine = (j == x) ? c : mine; }
        if (sum == G) break;
        __builtin_amdgcn_s_sleep(1);
        if ((++sp & 255u) == 0u) { if (xb_ld(&bar[XB_TMO])) break; if (sp > XB_SPIN_CAP) { atomicAdd(&bar[XB_TMO], 1u); break; } }
    }
    nloc = mine > 0u ? mine : 1u; nx = cnt > 0u ? cnt : 1u;
}

__device__ __forceinline__ void xcd_barrier(const XcdBarrier& b) {
    asm volatile("s_waitcnt vmcnt(0)" ::: "memory");
    __syncthreads();
    if (threadIdx.x == 0) {
        unsigned* bar = b.bar;
        __builtin_amdgcn_s_waitcnt(0);
        unsigned nloc = b.st[0], nx = b.st[1];
        if (nloc == 0u) { xcd_barrier_complete(bar, b.x, nloc, nx); b.st[0] = nloc; b.st[1] = nx; }
        const unsigned old = xb_add(&bar[XB_XSUB(b.x)], 1u);
        const unsigned gen = old / nloc;
        if (old + 1u == (gen + 1u) * nloc) {
            __builtin_amdgcn_fence(__ATOMIC_RELEASE, "agent");
            asm volatile("s_waitcnt vmcnt(0)" ::: "memory");
            const unsigned og = xb_add(&bar[XB_TOP], 1u);
            const unsigned tg = og / nx;
            if (og + 1u == (tg + 1u) * nx) xb_add(&bar[XB_TOPGEN], 1u);
            else XB_SPIN(xb_ld(&bar[XB_TOPGEN]) == tg, bar);
            __builtin_amdgcn_fence(__ATOMIC_ACQUIRE, "agent");
            xb_add(&bar[XB_XGEN(b.x)], 1u);
            asm volatile("s_waitcnt vmcnt(0)" ::: "memory");
        } else {
            XB_SPIN(xb_ld(&bar[XB_XGEN(b.x)]) == gen, bar);
            __builtin_amdgcn_fence(__ATOMIC_ACQUIRE, "agent");
            asm volatile("s_waitcnt vmcnt(0)" ::: "memory");
        }
    }
    __syncthreads();
}
#ifndef PROBE_REPEAT
#define PROBE_REPEAT -1
#endif
#ifndef PROBE_FIRST
#define PROBE_FIRST 0
#endif
#define REPS(k) ((PROBE_REPEAT == (k)) ? 2 : 1)
struct Args { const float* in[16]; float* out; unsigned char* ws; unsigned long long flags; };
#define IDS() int tid_o = threadIdx.x; asm volatile("" : "+v"(tid_o)); const int tid = tid_o, lane = tid & 63, wave = __builtin_amdgcn_readfirstlane(tid >> 6); (void)lane; (void)wave
#define OPQ() int z_ = 0; asm volatile("" : "+s"(z_))
#define INP(k) (args.in[z_ + (k)])

__global__ void __launch_bounds__(NWAVES * 64, 2) fwd_mega(Args args) {
    extern __shared__ __attribute__((aligned(16))) unsigned char lds[];
    cg::grid_group grid = cg::this_grid();
    LAS unsigned char* lds3 = (LAS unsigned char*)lds;
    const int G = gridDim.x, bx = blockIdx.x;
    if (threadIdx.x < 2) ((volatile LAS unsigned*)(lds3 + BARST_OFF))[threadIdx.x] = 0u;
    __syncthreads();
    unsigned char* ws = args.ws;
    const XcdBarrier xbar = xcd_barrier_post((unsigned*)(ws + WS_BAR), (volatile LAS unsigned*)(lds3 + BARST_OFF));
    float* out = args.out;
    bf16* Win_t = (bf16*)(ws + WS_WIN); bf16* Wbrf_t = (bf16*)(ws + WS_WBRF); bf16* Wbrd_t = (bf16*)(ws + WS_WBRD); bf16* Wout_t = (bf16*)(ws + WS_WOUT);
    bf16* Wup_t = (bf16*)(ws + WS_WUP); bf16* Wdn_t = (bf16*)(ws + WS_WDN);
    bf16* XN = (bf16*)(ws + WS_XN); bf16* QKV = (bf16*)(ws + WS_QKV); bf16* GATES = (bf16*)(ws + WS_GATES);
    bf16* OA = (bf16*)(ws + WS_OA); bf16* OB = (bf16*)(ws + WS_OB); bf16* OP0 = (bf16*)(ws + WS_OP0); bf16* OP1 = (bf16*)(ws + WS_OP1); bf16* OP2 = (bf16*)(ws + WS_OP2);
    float* T = (float*)(ws + WS_T); bf16* MG = (bf16*)(ws + WS_MG); bf16* XB = (bf16*)(ws + WS_XB); bf16* ACT = (bf16*)(ws + WS_ACT); bf16* U = (bf16*)(ws + WS_U); float* US = (float*)(ws + WS_US); (void)U; (void)US;
    float* SSQ = (float*)(ws + WS_SSQ); float* CUM = (float*)(ws + WS_CUM); float* LOGF = (float*)(ws + WS_LOGF); float* LSE = (float*)(ws + WS_LSE);
    unsigned* ctl = (unsigned*)(ws + WS_CTL); float* GAIN = (float*)(ws + WS_GAIN); float* RSTD = (float*)(ws + WS_RSTD);

#if !defined(ONLY) || ONLY == 0
    _Pragma("unroll 1") for (int rep_ = 0; rep_ < REPS(0); ++rep_) {
        IDS();
        OPQ(); const float* x = INP(0); const float* g_attn = INP(1); const float* w_in = INP(2); const float* b_forget = INP(3); const float* gq_fox = INP(4); const float* gk_fox = INP(5); const float* gq_dil = INP(6); const float* gk_dil = INP(7);
        const float* w_br_fox = INP(8); const float* w_br_dil = INP(9); const float* w_out = INP(10); const float* g_ffn = INP(11); const float* w_up = INP(12); const float* w_down = INP(15);
        if (bx == 1) for (int i = tid; i < 1024; i += NWAVES * 64) { GAIN[i] = gq_fox[i]; GAIN[1024 + i] = gk_fox[i]; GAIN[2048 + i] = gq_dil[i]; GAIN[3072 + i] = gk_dil[i]; }
        LAS float* scr = (LAS float*)(lds3 + wave * 16384);
        const int gw = bx * NWAVES + wave, NGW = G * NWAVES;
        constexpr int I_IN = (DM / 64) * (NPROJ / 32), I_BR = (1024 / 64) * (DM / 32), I_OUT = (DM / 64) * (DM / 32), I_UP = (DM / 64) * (NUP / 32);
        transpose_matrix<1, false>(w_in, DM, INC, NPROJ, Win_t, DM, 0, nullptr, 0, gw, NGW, scr, lane);
        if (G != 256) transpose_matrix<0, true>(w_down, DFF, DM, DM, Wdn_t, DFF, 0, nullptr, (I_IN + 2 * I_BR + I_OUT + I_UP) % NGW, gw, NGW, scr, lane);
        __syncthreads();
        LAS float* wf = (LAS float*)lds3;
        {
            const float* wsrc = w_in + 3072 + (tid & 7);
#pragma unroll 1
            for (int b0 = 0; b0 < 32; b0 += 8) { float tv[8];
#pragma unroll
                for (int q = 0; q < 8; ++q) tv[q] = wsrc[(size_t)((tid + (b0 + q) * NWAVES * 64) >> 3) * INC];
#pragma unroll
                for (int q = 0; q < 8; ++q) wf[tid + (b0 + q) * NWAVES * 64] = tv[q]; }
        }
        __syncthreads();
        for (int m = gw; m < M; m += NGW) {
            const f32x4* xr = (const f32x4*)(x + (size_t)m * DM) + lane; const f32x4* gr = (const f32x4*)g_attn + lane;
            f32x4 v[8]; float s = 0.f;
#pragma unroll
            for (int j = 0; j < 8; ++j) { v[j] = __builtin_nontemporal_load(xr + 64 * j); s += (v[j][0] * v[j][0] + v[j][1] * v[j][1]) + (v[j][2] * v[j][2] + v[j][3] * v[j][3]); }
            const float rstd = 1.f / sqrtf(wave_sum(s) * (1.f / DM) + EPS);
            float fa[8] = {0.f, 0.f, 0.f, 0.f, 0.f, 0.f, 0.f, 0.f};
            unsigned long long* o8 = (unsigned long long*)(XN + (size_t)m * DM) + lane;
#pragma unroll
            for (int j = 0; j < 8; ++j) { const f32x4 h = v[j] * rstd * gr[64 * j];
                o8[64 * j] = (unsigned long long)pk2(h[0], h[1]) | ((unsigned long long)pk2(h[2], h[3]) << 32);
#pragma unroll
                for (int c = 0; c < 4; ++c) { const LAS f32x4* wp = (const LAS f32x4*)(wf + (size_t)(256 * j + 4 * lane + c) * 8); const f32x4 wa = wp[0], wb = wp[1];
                    fa[0] = fmaf(h[c], wa[0], fa[0]); fa[1] = fmaf(h[c], wa[1], fa[1]); fa[2] = fmaf(h[c], wa[2], fa[2]); fa[3] = fmaf(h[c], wa[3], fa[3]);
                    fa[4] = fmaf(h[c], wb[0], fa[4]); fa[5] = fmaf(h[c], wb[1], fa[5]); fa[6] = fmaf(h[c], wb[2], fa[6]); fa[7] = fmaf(h[c], wb[3], fa[7]); }
                asm volatile("" ::: "memory"); }
#pragma unroll
            for (int hh = 0; hh < 8; ++hh) fa[hh] = wave_sum(fa[hh]);
            if (lane < 8) { float z = fa[0];
#pragma unroll
                for (int hh = 1; hh < 8; ++hh) z = (lane == hh) ? fa[hh] : z;
                z += b_forget[lane];
                LOGF[(size_t)m * 8 + lane] = fminf(z, 0.f) - log1pf(expf(-fabsf(z))); }
        }
        __syncthreads();
    }
#endif
    if (args.flags & 1ull) grid.sync();
    xcd_barrier(xbar);

#if !defined(ONLY) || ONLY == 1
    _Pragma("unroll 1") for (int rep_ = 0; rep_ < REPS(1); ++rep_) {
        if (rep_ > 0) xcd_barrier(xbar);
        IDS();
        if (bx < NB * NH) { const int bb = bx >> 3, h = bx & 7; LAS float* wt = (LAS float*)lds3;
            float v[4]; float s = 0.f;
#pragma unroll
            for (int j = 0; j < 4; ++j) { v[j] = LOGF[((size_t)bb * SEQ + 4 * tid + j) * 8 + h]; s += v[j]; v[j] = s; }
            float inc = s;
#pragma unroll
            for (int o = 1; o < 64; o <<= 1) { const float t = __shfl_up(inc, o); if (lane >= o) inc += t; }
            if (lane == 63) wt[wave] = inc;
            __syncthreads();
            float off = inc - s;
            for (int w = 0; w < wave; ++w) off += wt[w];
#pragma unroll
            for (int j = 0; j < 4; ++j) CUM[(size_t)bx * SEQ + 4 * tid + j] = off + v[j];
            __syncthreads();
        }
        pg8::Gemm g{XN, Win_t, M, NPROJ, DM}; pg8::StaticOrder S; S.init(M, NPROJ, G, bx);
        pg8::EpiProj E{QKV, GATES, GAIN, (LAS float*)(lds3 + XL_OFF)};
        pg8::gemm_phase<pg8::EpiProj, pg8::StaticOrder, true, true>(lds3, g, S, E);
    }
#endif
    xcd_barrier(xbar);

#if !defined(ONLY) || ONLY == 2
    _Pragma("unroll 1") for (int rep_ = 0; rep_ < REPS(2); ++rep_) {
        if (rep_ > 0) xcd_barrier(xbar);
        IDS();
        const att::AttnArgs A{QKV, ws, (long)WS_OA, (long)WS_OP0, (long)WS_OP2 - (long)WS_OP0 - 32 * (long)MiB, LSE, CUM};
        att::attn_phase((char*)lds, A, ctl + 16 * rep_, rep_ ? PROBE_FIRST : 0);
        __syncthreads();
        { OPQ(); const float* w_br_fox = INP(8); const float* w_br_dil = INP(9); const float* w_out = INP(10); const float* g_ffn = INP(11); const float* w_up = INP(12);
          LAS float* scr = (LAS float*)(lds3 + wave * 16384);
          constexpr int I_BR = (1024 / 64) * (DM / 32), I_OUT = (DM / 64) * (DM / 32), I_UP = (DM / 64) * (NUP / 32), CH = 32, NCH = (2 * I_BR + I_OUT + I_UP) / CH;
          static_assert(I_BR % CH == 0 && I_OUT % CH == 0 && I_UP % CH == 0, "chunks do not straddle matrices");
          volatile LAS int* cslot = (volatile LAS int*)(lds3 + BARST_OFF + 32);
          for (;;) {
              if (tid == 0) *cslot = (int)atomicAdd(ctl + 48 + 16 * rep_, 1u);
              __syncthreads(); const int ch = __builtin_amdgcn_readfirstlane(*cslot); __syncthreads();
              if (ch >= NCH) break;
              const int g0 = ch * CH;
              if (g0 < I_BR) transpose_matrix<0, true>(w_br_fox, 1024, DM, DM, Wbrf_t, 2048, 0, nullptr, 0, wave, NWAVES, scr, lane, g0, g0 + CH);
              else if (g0 < 2 * I_BR) transpose_matrix<0, true>(w_br_dil, 1024, DM, DM, Wbrf_t, 2048, 1024, nullptr, 0, wave, NWAVES, scr, lane, g0 - I_BR, g0 - I_BR + CH);
              else if (g0 < 2 * I_BR + I_OUT) transpose_matrix<0, true>(w_out, DM, DM, DM, Wout_t, DM, 0, nullptr, 0, wave, NWAVES, scr, lane, g0 - 2 * I_BR, g0 - 2 * I_BR + CH);
              else transpose_matrix<2, true>(w_up, DM, NUP, NUP, Wup_t, DM, 0, g_ffn, 0, wave, NWAVES, scr, lane, g0 - 2 * I_BR - I_OUT, g0 - 2 * I_BR - I_OUT + CH);
          } }
    }
#endif
    xcd_barrier(xbar);

#if !defined(ONLY) || ONLY == 3
    _Pragma("unroll 1") for (int rep_ = 0; rep_ < REPS(3); ++rep_) {
        if (rep_ > 0) xcd_barrier(xbar);
        IDS();
        const int gt = bx * (NWAVES * 64) + tid, NT = G * NWAVES * 64;
        for (int i = gt; i < M * 128; i += NT) { const int m = i >> 7, c8 = (i & 127) * 8, h = c8 >> 7;
            const float l0 = LSE[(size_t)m * 8 + h], l1 = LSE[(size_t)(M + m) * 8 + h], l2 = LSE[(size_t)(2 * M + m) * 8 + h];
            const float mx = fmaxf(l0, fmaxf(l1, l2));
            float w0 = __builtin_amdgcn_exp2f(l0 - mx), w1 = __builtin_amdgcn_exp2f(l1 - mx), w2 = __builtin_amdgcn_exp2f(l2 - mx);
            const float inv = 1.f / (w0 + w1 + w2); w0 *= inv; w1 *= inv; w2 *= inv;
            const v4u a = __builtin_nontemporal_load((const v4u*)(OP0 + (size_t)m * 1024 + c8)), b = __builtin_nontemporal_load((const v4u*)(OP1 + (size_t)m * 1024 + c8)), c = __builtin_nontemporal_load((const v4u*)(OP2 + (size_t)m * 1024 + c8));
            v4u o;
#pragma unroll
            for (int k = 0; k < 4; ++k) { const float lo = w0 * pg8::bflo(a[k]) + w1 * pg8::bflo(b[k]) + w2 * pg8::bflo(c[k]), hi = w0 * pg8::bfhi(a[k]) + w1 * pg8::bfhi(b[k]) + w2 * pg8::bfhi(c[k]); o[k] = pk2(lo, hi); }
            *(v4u*)(OA + (size_t)m * 2048 + 1024 + c8) = o; }
    }
#endif
    xcd_barrier(xbar);

#if !defined(ONLY) || ONLY == 4
    _Pragma("unroll 1") for (int rep_ = 0; rep_ < REPS(4); ++rep_) {
        if (rep_ > 0) xcd_barrier(xbar);
        IDS();
        pg8::StaticOrder S; S.init(M, DM, G, bx);
        pg8::Gemm g{OA, Wbrf_t, M, DM, 2048}; pg8::EpiBr E{GATES, MG};
        pg8::gemm_phase<pg8::EpiBr, pg8::StaticOrder, true, true>(lds3, g, S, E);
    }
#endif
    xcd_barrier(xbar);

#if !defined(ONLY) || ONLY == 5
    _Pragma("unroll 1") for (int rep_ = 0; rep_ < REPS(5); ++rep_) {
        if (rep_ > 0) xcd_barrier(xbar);
        IDS();
        pg8::Gemm g{MG, Wout_t, M, DM, DM}; pg8::StaticOrder S; S.init(M, DM, G, bx);
        OPQ(); pg8::EpiOut E{INP(0), XB, SSQ};
        pg8::gemm_phase<pg8::EpiOut, pg8::StaticOrder, false, true>(lds3, g, S, E);
    }
#endif
    xcd_barrier(xbar);

#if !defined(ONLY) || ONLY == 6
    _Pragma("unroll 1") for (int rep_ = 0; rep_ < REPS(6); ++rep_) {
        if (rep_ > 0) xcd_barrier(xbar);
        IDS();
#pragma unroll 1
        for (int r0 = tid; r0 < M; r0 += 8 * NWAVES * 64) { f32x4 sa[8], sb[8];
#pragma unroll
            for (int q = 0; q < 8; ++q) { const size_t r = (size_t)(r0 + q * NWAVES * 64); sa[q] = *(const f32x4*)(SSQ + r * 8); sb[q] = *(const f32x4*)(SSQ + r * 8 + 4); }
#pragma unroll
            for (int q = 0; q < 8; ++q) RSTD[r0 + q * NWAVES * 64] = 1.f / sqrtf((((sa[q][0] + sa[q][1]) + (sa[q][2] + sa[q][3])) + ((sb[q][0] + sb[q][1]) + (sb[q][2] + sb[q][3]))) * (1.f / DM) + EPS); }
        asm volatile("s_waitcnt vmcnt(0)" ::: "memory"); __syncthreads();
        pg8::Gemm g{XB, Wup_t, M, NUP, DM}; pg8::StaticOrder S; S.init(M, NUP, G, bx);
#if FUSED_CONV
        OPQ(); pg8::EpiUpConv E{RSTD, INP(13), INP(14), ACT, US, (LAS float*)(lds3 + XL_OFF)};
        pg8::gemm_phase<pg8::EpiUpConv, pg8::StaticOrder, CONV_ALIGN, true>(lds3, g, S, E);
#else
        pg8::EpiUp E{RSTD, U};
        pg8::gemm_phase<pg8::EpiUp, pg8::StaticOrder, true, true>(lds3, g, S, E);
        if (G == 256 && bx >= 128) { OPQ(); const float* w_down = INP(15);
            transpose_matrix<0, true>(w_down, DFF, DM, DM, Wdn_t, DFF, 0, nullptr, 0, (bx - 128) * NWAVES + wave, 128 * NWAVES, (LAS float*)(lds3 + wave * 16384), lane); }
#endif
    }
#endif
    xcd_barrier(xbar);

#if (!defined(ONLY) || ONLY == 8) && !FUSED_CONV
    _Pragma("unroll 1") for (int rep_ = 0; rep_ < REPS(8); ++rep_) {
        if (rep_ > 0) xcd_barrier(xbar);
        IDS();
        OPQ(); const float* w_conv = INP(13); const float* b_conv = INP(14);
        const int gt = bx * (NWAVES * 64) + tid, NTH = G * NWAVES * 64;
        for (int it = gt; it < 704 * 512; it += NTH) { const int r = it / 704, k = it - r * 704, t0 = r * 16, pn = k >> 4, j8 = (k & 15) * 8;
            const unsigned ug = 256 * pn + j8, c = 8 * k;
            float wg[3][8], wv[3][8], bg[8], bv[8];
#pragma unroll
            for (int tp = 0; tp < 3; ++tp)
#pragma unroll
                for (int q = 0; q < 2; ++q) { const f32x4 a = *(const f32x4*)(w_conv + tp * NUP + c + 4 * q), b = *(const f32x4*)(w_conv + tp * NUP + DFF + c + 4 * q);
#pragma unroll
                    for (int j = 0; j < 4; ++j) { wg[tp][4 * q + j] = a[j]; wv[tp][4 * q + j] = b[j]; } }
#pragma unroll
            for (int q = 0; q < 2; ++q) { const f32x4 a = *(const f32x4*)(b_conv + c + 4 * q), b = *(const f32x4*)(b_conv + DFF + c + 4 * q);
#pragma unroll
                for (int j = 0; j < 4; ++j) { bg[4 * q + j] = a[j]; bv[4 * q + j] = b[j]; } }
            float g2[8], g1[8], v2[8], v1[8];
            if ((t0 & (SEQ - 1)) == 0) {
#pragma unroll
                for (int j = 0; j < 8; ++j) { g2[j] = 0.f; g1[j] = 0.f; v2[j] = 0.f; v1[j] = 0.f; }
            } else {
                const v4u a2 = *(const v4u*)(U + (size_t)(t0 - 2) * NUP + ug), b2 = *(const v4u*)(U + (size_t)(t0 - 2) * NUP + ug + 128);
                const v4u a1 = *(const v4u*)(U + (size_t)(t0 - 1) * NUP + ug), b1 = *(const v4u*)(U + (size_t)(t0 - 1) * NUP + ug + 128);
#pragma unroll
                for (int q = 0; q < 4; ++q) { g2[2 * q] = pg8::bflo(a2[q]); g2[2 * q + 1] = pg8::bfhi(a2[q]); v2[2 * q] = pg8::bflo(b2[q]); v2[2 * q + 1] = pg8::bfhi(b2[q]);
                    g1[2 * q] = pg8::bflo(a1[q]); g1[2 * q + 1] = pg8::bfhi(a1[q]); v1[2 * q] = pg8::bflo(b1[q]); v1[2 * q + 1] = pg8::bfhi(b1[q]); }
            }
            for (int i4 = 0; i4 < 16; i4 += 4) {
                v4u a0[4], b0[4];
#pragma unroll
                for (int i = 0; i < 4; ++i) { const size_t t = (size_t)(t0 + i4 + i);
                    a0[i] = __builtin_nontemporal_load((const v4u*)(U + t * NUP + ug)); b0[i] = __builtin_nontemporal_load((const v4u*)(U + t * NUP + ug + 128)); }
#pragma unroll
                for (int i = 0; i < 4; ++i) { const size_t t = (size_t)(t0 + i4 + i);
                    float g0[8], v0[8], o[8];
#pragma unroll
                    for (int q = 0; q < 4; ++q) { g0[2 * q] = pg8::bflo(a0[i][q]); g0[2 * q + 1] = pg8::bfhi(a0[i][q]); v0[2 * q] = pg8::bflo(b0[i][q]); v0[2 * q + 1] = pg8::bfhi(b0[i][q]); }
#pragma unroll
                    for (int j = 0; j < 8; ++j) { const float gt_ = fmaf(wg[0][j], g2[j], fmaf(wg[1][j], g1[j], fmaf(wg[2][j], g0[j], bg[j])));
                        const float vl = fmaf(wv[0][j], v2[j], fmaf(wv[1][j], v1[j], fmaf(wv[2][j], v0[j], bv[j])));
                        o[j] = gt_ * pg8::sigm(gt_) * vl; g2[j] = g1[j]; g1[j] = g0[j]; v2[j] = v1[j]; v1[j] = v0[j]; }
                    v4u w; w.x = pk2(o[0], o[1]); w.y = pk2(o[2], o[3]); w.z = pk2(o[4], o[5]); w.w = pk2(o[6], o[7]);
                    *(v4u*)(ACT + t * DFF + c) = w; } }
        }
    }
#endif
    #if !FUSED_CONV
    xcd_barrier(xbar);
#endif

#if !defined(ONLY) || ONLY == 7
    _Pragma("unroll 1") for (int rep_ = 0; rep_ < REPS(7); ++rep_) {
        if (rep_ > 0) xcd_barrier(xbar);
        IDS();
        pg8::StaticOrder S; S.init(M, DM, G, bx);
#if FUSED_CONV
        {
            OPQ(); const float* w_conv = INP(13); const float* b_conv = INP(14); pg8::Unit u0;
            if (S.next(0, u0)) {
                for (int i = tid; i < 4 * DFF; i += NWAVES * 64) { const int gq = i / DFF, c = i - gq * DFF, Gi = 4 * u0.pm + gq; const bool first = (Gi & 31) == 0;
                    const float* up = US + (size_t)Gi * 4 * NUP;
                    float cv[2][2];
#pragma unroll
                    for (int bj = 0; bj < 2; ++bj) { const int uc = bj * DFF + c; const float u0v = first ? 0.f : up[uc], u1v = first ? 0.f : up[NUP + uc], u2v = up[2 * NUP + uc], u3v = up[3 * NUP + uc];
                        const float w0 = w_conv[uc], w1 = w_conv[NUP + uc], w2 = w_conv[2 * NUP + uc], bb = b_conv[uc];
                        cv[bj][0] = fmaf(w0, u0v, fmaf(w1, u1v, fmaf(w2, u2v, bb))); cv[bj][1] = fmaf(w0, u1v, fmaf(w1, u2v, fmaf(w2, u3v, bb))); }
#pragma unroll
                    for (int t = 0; t < 2; ++t) { const float gte = cv[0][t]; ACT[(size_t)(64 * Gi + t) * DFF + c] = (bf16)f2bf(gte * pg8::sigm(gte) * cv[1][t]); } }
            }
            asm volatile("s_waitcnt vmcnt(0)" ::: "memory"); __threadfence(); __syncthreads();
        }
#endif
        pg8::Gemm g{ACT, Wdn_t, M, DM, DFF};
        pg8::EpiFinal E{XB, out};
        pg8::gemm_phase<pg8::EpiFinal, pg8::StaticOrder, true, true>(lds3, g, S, E);
    }
#endif
}

extern "C" void kernel_launch(void* const* d_in, const int* in_sizes, int n_in, void* d_out, int out_size, void* d_ws, size_t ws_size, hipStream_t stream) {
    static int grid = 0;
    if (grid == 0) {
        if (n_in != 16 || in_sizes[0] != M * DM || out_size != M * DM || ws_size < WS_END) { fprintf(stderr, "kernel_launch: unexpected shapes (n_in %d, in0 %d, out %d, ws %zu)\n", n_in, n_in > 0 ? in_sizes[0] : -1, out_size, ws_size); grid = -1; return; }
        int dev = 0, cus = 0, per_cu = 0;
        (void)hipGetDevice(&dev); (void)hipDeviceGetAttribute(&cus, hipDeviceAttributeMultiprocessorCount, dev);
        if (hipFuncSetAttribute((const void*)fwd_mega, hipFuncAttributeMaxDynamicSharedMemorySize, LDS_BYTES) != hipSuccess) { fprintf(stderr, "kernel_launch: hipFuncSetAttribute failed\n"); grid = -1; return; }
        if (hipOccupancyMaxActiveBlocksPerMultiprocessor(&per_cu, (const void*)fwd_mega, NWAVES * 64, LDS_BYTES) != hipSuccess || per_cu < 1) { fprintf(stderr, "kernel_launch: occupancy query says %d\n", per_cu); per_cu = 1; }
        (void)hipGetLastError();
        grid = cus * 1;
        if (grid != 256) fprintf(stderr, "kernel_launch: %d CUs; the single-unit GEMM phases assume 256\n", grid);
    }
    if (grid < 0) return;
    if (hipMemsetAsync(d_ws, 0, 128 * 1024, stream) != hipSuccess) { fprintf(stderr, "kernel_launch: hipMemsetAsync failed\n"); return; }
    Args a{};
    for (int i = 0; i < 16; ++i) a.in[i] = (const float*)d_in[i];
    a.out = (float*)d_out; a.ws = (unsigned char*)d_ws;
    void* kargs[] = {&a};
    hipError_t e = hipLaunchCooperativeKernel((const void*)fwd_mega, dim3(grid), dim3(NWAVES * 64), kargs, LDS_BYTES, stream);
    if (e != hipSuccess) fprintf(stderr, "cooperative launch failed: %s (grid %d)\n", hipGetErrorString(e), grid);
}
```

```cpp
#include <hip/hip_runtime.h>
#include <hip/hip_cooperative_groups.h>
#include <cstdio>
#include <cstdint>
namespace cg = cooperative_groups;
namespace pg8 {
#define PG8_LAS __attribute__((address_space(3)))
typedef unsigned short bf16_t;
typedef short bf16x8 __attribute__((ext_vector_type(8)));
typedef float f32x4 __attribute__((ext_vector_type(4)));
typedef unsigned u32x4 __attribute__((ext_vector_type(4)));
constexpr int BM = 256, BK = 64, HALF = 128, HTB = HALF * BK * 2  , STAGE_BYTES = 8 * HTB, NXCD = 8, WGM = 4;

__host__ __device__ __forceinline__ int lds_byte(int r, int c) { const int st = (r >> 4) * 2 + (c >> 5), rr = r & 15, cc = c & 31, ob = rr * 64 + cc * 2; return st * 1024 + (ob ^ (((ob >> 9) & 1) << 5)); }
__host__ __device__ __forceinline__ void stage_rc(int b, int& R, int& C) { const int st = b / 1024, sb = b % 1024, swz = sb ^ (((sb >> 9) & 1) << 5); R = (st >> 1) * 16 + swz / 64; C = (st & 1) * 32 + (swz % 64) / 2; }
__host__ __device__ __forceinline__ int perm32(int rho) { const int n = rho >> 4, i = rho & 15; return 8 * (i >> 2) + 4 * n + (i & 3); }

struct Unit { int pm, pn; };
struct Gemm { const bf16_t* A; const bf16_t* Bt; int M, N, K; };

struct StaticOrder {
    int nM, nN, nwg, G, c;
    __host__ __device__ void init(int M, int N, int G_, int c_) { nM = M / BM; nN = N / BM; nwg = nM * nN; G = G_; c = c_; }
    __host__ __device__ bool next(int i, Unit& u) const {
        const long L = (long)i * G + c; if (L >= nwg) return false;
        int wgid = (int)L; { const int q = nwg / NXCD, r = nwg % NXCD, xcd = wgid % NXCD, off = wgid / NXCD; wgid = (xcd < r ? xcd * (q + 1) : r * (q + 1) + (xcd - r) * q) + off; }
        const int nig = WGM * nN, gid = wgid / nig, fm = gid * WGM, gsz = (nM - fm) < WGM ? (nM - fm) : WGM;
        u.pm = fm + ((wgid % nig) % gsz); u.pn = (wgid % nig) / gsz; return true;
    }
    __device__ __forceinline__ void a_ready(const Unit&) const {}
    __device__ __forceinline__ void done(const Unit&) const {}
};

__device__ __forceinline__ unsigned cvt_pk_bf16(float lo, float hi) { unsigned r; asm volatile("v_cvt_pk_bf16_f32 %0, %1, %2" : "=v"(r) : "v"(lo), "v"(hi)); return r; }
typedef unsigned u32x4e __attribute__((ext_vector_type(4)));
constexpr float LOG2E = 1.4426950408889634f;
constexpr float EPSN = 1e-6f;
constexpr float QSCALE = 0.08838834764831845f * 1.4426950408889634f;
__device__ __forceinline__ float sigm(float x) { return __builtin_amdgcn_rcpf(1.f + __builtin_amdgcn_exp2f(-x * LOG2E)); }
__device__ __forceinline__ float bflo(unsigned w) { return __uint_as_float(w << 16); }
__device__ __forceinline__ float bfhi(unsigned w) { return __uint_as_float(w & 0xffff0000u); }
__device__ __forceinline__ u32x4e pack8f(const f32x4 a, const f32x4 b) { u32x4e w; w.x = cvt_pk_bf16(a[0], a[1]); w.y = cvt_pk_bf16(a[2], a[3]); w.z = cvt_pk_bf16(b[0], b[1]); w.w = cvt_pk_bf16(b[2], b[3]); return w; }
#define EPI_LDSBAR() do { asm volatile("s_waitcnt lgkmcnt(0)" ::: "memory"); __builtin_amdgcn_s_barrier(); asm volatile("" ::: "memory"); } while (0)

struct EpiProj {
    static constexpr bool PERM = true, AFTER_DRAIN = false, HAS_MID = false;
    bf16_t* QKV; bf16_t* GATES; const float* gains; PG8_LAS float* xl;
    __device__ __forceinline__ void operator()(f32x4 (&acc)[2][2][4][2], const Unit& u, int wr, int wc, int fr, int fq) const {
        const int colt = u.pn * BM, row0 = u.pm * BM + wr * 64 + fr, seg = colt >> 10;
        const bool norm = (seg == 0) | (seg == 1) | (seg == 3) | (seg == 4);
        if (!norm) {
            bf16_t* base; int ldc, col0;
            if (colt >= 6144) { base = GATES; ldc = 4096; col0 = colt - 6144; } else { base = QKV; ldc = 6144; col0 = colt; }
            col0 += wc * 32 + 8 * fq;
#pragma unroll
            for (int ai = 0; ai < 2; ++ai)
#pragma unroll
                for (int m = 0; m < 4; ++m) { bf16_t* rowp = base + (size_t)(row0 + ai * HALF + m * 16) * ldc + col0;
#pragma unroll
                    for (int bj = 0; bj < 2; ++bj) *(u32x4e*)(rowp + bj * HALF) = pack8f(acc[ai][bj][m][0], acc[ai][bj][m][1]); }
        } else {
#pragma unroll
            for (int ai = 0; ai < 2; ++ai)
#pragma unroll
                for (int m = 0; m < 4; ++m)
#pragma unroll
                    for (int bj = 0; bj < 2; ++bj) { const f32x4 a = acc[ai][bj][m][0], b = acc[ai][bj][m][1];
                        float s = (a[0] * a[0] + a[1] * a[1]) + (a[2] * a[2] + a[3] * a[3]) + (b[0] * b[0] + b[1] * b[1]) + (b[2] * b[2] + b[3] * b[3]);
                        s += __shfl_xor(s, 16); s += __shfl_xor(s, 32);
                        if (fq == 0) xl[((ai * HALF + wr * 64 + m * 16 + fr) * 2 + bj) * 4 + wc] = s; }
            EPI_LDSBAR();
            const float* gp = gains + (seg - (seg >= 3 ? 1 : 0)) * 1024 + (colt & 1023) + wc * 32 + 8 * fq;
            const float qs = (seg == 0 || seg == 3) ? QSCALE : 1.f;
            f32x4 g[2][2];
#pragma unroll
            for (int bj = 0; bj < 2; ++bj)
#pragma unroll
                for (int n = 0; n < 2; ++n) g[bj][n] = *(const f32x4*)(gp + bj * HALF + 4 * n) * qs;
            bf16_t* base = QKV + colt + wc * 32 + 8 * fq;
#pragma unroll
            for (int ai = 0; ai < 2; ++ai)
#pragma unroll
                for (int m = 0; m < 4; ++m) { bf16_t* rowp = base + (size_t)(row0 + ai * HALF + m * 16) * 6144;
#pragma unroll
                    for (int bj = 0; bj < 2; ++bj) { const f32x4 p = *(const PG8_LAS f32x4*)(xl + ((ai * HALF + wr * 64 + m * 16 + fr) * 2 + bj) * 4);
                        const float rs = __builtin_amdgcn_rsqf(((p[0] + p[1]) + (p[2] + p[3])) * (1.f / 128.f) + EPSN);
                        *(u32x4e*)(rowp + bj * HALF) = pack8f(acc[ai][bj][m][0] * rs * g[bj][0], acc[ai][bj][m][1] * rs * g[bj][1]); } }
        }
    }
};

__device__ __forceinline__ void gate8(const bf16_t* p, f32x4& s0, f32x4& s1) {
    const u32x4e w = *(const u32x4e*)p;
    s0[0] = sigm(bflo(w.x)); s0[1] = sigm(bfhi(w.x)); s0[2] = sigm(bflo(w.y)); s0[3] = sigm(bfhi(w.y));
    s1[0] = sigm(bflo(w.z)); s1[1] = sigm(bfhi(w.z)); s1[2] = sigm(bflo(w.w)); s1[3] = sigm(bfhi(w.w));
}
struct EpiBr {
    static constexpr bool PERM = true, AFTER_DRAIN = false, HAS_MID = true;
    const bf16_t* G; bf16_t* MG;
    __device__ __forceinline__ void mid(f32x4 (&acc)[2][2][4][2], const Unit& u, int wr, int wc, int fr_in, int fq_in) const {
        (void)fr_in; (void)fq_in; int ln_ = (int)(threadIdx.x & 63u); asm volatile("" : "+v"(ln_)); const int fr = ln_ & 15, fq = ln_ >> 4;
        const int row0 = u.pm * BM + wr * 64 + fr, col0 = u.pn * BM + wc * 32 + 8 * fq;
#define RAT(x, y) ((1.f + __builtin_amdgcn_exp2f(-(y) * LOG2E)) * __builtin_amdgcn_rcpf(1.f + __builtin_amdgcn_exp2f(-(x) * LOG2E)))
#pragma unroll
        for (int ai = 0; ai < 2; ++ai) {
            u32x4e ga[4][2], gb[4][2];
#pragma unroll
            for (int m = 0; m < 4; ++m)
#pragma unroll
                for (int bj = 0; bj < 2; ++bj) { const bf16_t* gp = G + (size_t)(row0 + ai * HALF + m * 16) * 4096 + col0 + bj * HALF; ga[m][bj] = *(const u32x4e*)gp; gb[m][bj] = *(const u32x4e*)(gp + 2048); }
#pragma unroll
            for (int m = 0; m < 4; ++m)
#pragma unroll
                for (int bj = 0; bj < 2; ++bj) { const u32x4e a = ga[m][bj], b = gb[m][bj]; f32x4 r0, r1;
                    r0[0] = RAT(bflo(a.x), bflo(b.x)); r0[1] = RAT(bfhi(a.x), bfhi(b.x)); r0[2] = RAT(bflo(a.y), bflo(b.y)); r0[3] = RAT(bfhi(a.y), bfhi(b.y));
                    r1[0] = RAT(bflo(a.z), bflo(b.z)); r1[1] = RAT(bfhi(a.z), bfhi(b.z)); r1[2] = RAT(bflo(a.w), bflo(b.w)); r1[3] = RAT(bfhi(a.w), bfhi(b.w));
                    acc[ai][bj][m][0] = acc[ai][bj][m][0] * r0; acc[ai][bj][m][1] = acc[ai][bj][m][1] * r1; }
            asm volatile("" ::: "memory"); __builtin_amdgcn_sched_barrier(0); }
#undef RAT
    }
    __device__ __forceinline__ void operator()(f32x4 (&acc)[2][2][4][2], const Unit& u, int wr, int wc, int fr, int fq) const {
        const int row0 = u.pm * BM + wr * 64 + fr, col0 = u.pn * BM + wc * 32 + 8 * fq;
#pragma unroll
        for (int ai = 0; ai < 2; ++ai)
#pragma unroll
            for (int m = 0; m < 4; ++m) { const size_t row = (size_t)(row0 + ai * HALF + m * 16);
#pragma unroll
                for (int bj = 0; bj < 2; ++bj) { const int col = col0 + bj * HALF; f32x4 s0, s1; gate8(G + row * 4096 + 2048 + col, s0, s1);
                    *(u32x4e*)(MG + row * 2048 + col) = pack8f(acc[ai][bj][m][0] * s0, acc[ai][bj][m][1] * s1); } }
    }
};
struct EpiOut {
    static constexpr bool PERM = true, AFTER_DRAIN = true, HAS_MID = false;
    const float* X; bf16_t* XB; float* SSQ;
    __device__ __forceinline__ void fused(f32x4 (&acc)[2][2][4][2], const Unit& u, int wr, int wc, int fr, int fq, PG8_LAS unsigned char* lds, int wid, int lane) const {
        PG8_LAS float* P = (PG8_LAS float*)lds;
        const int row0 = u.pm * BM + wr * 64 + fr, col0 = u.pn * BM + wc * 32 + 8 * fq;
#pragma unroll
        for (int ai = 0; ai < 2; ++ai)
#pragma unroll
            for (int m = 0; m < 4; ++m) { const size_t row = (size_t)(row0 + ai * HALF + m * 16); float ss = 0.f;
#pragma unroll
                for (int bj = 0; bj < 2; ++bj) { const size_t off = row * 2048 + col0 + bj * HALF;
                    const f32x4 v0 = acc[ai][bj][m][0] + __builtin_nontemporal_load((const f32x4*)(X + off)), v1 = acc[ai][bj][m][1] + __builtin_nontemporal_load((const f32x4*)(X + off + 4));
                    *(u32x4e*)(XB + off) = pack8f(v0, v1);
                    ss += (v0[0] * v0[0] + v0[1] * v0[1]) + (v0[2] * v0[2] + v0[3] * v0[3]) + (v1[0] * v1[0] + v1[1] * v1[1]) + (v1[2] * v1[2] + v1[3] * v1[3]); }
                ss += __shfl_xor(ss, 16); ss += __shfl_xor(ss, 32);
                if (fq == 0) P[(ai * HALF + wr * 64 + m * 16 + fr) * 4 + wc] = ss; }
        EPI_LDSBAR();
        const int tid = wid * 64 + lane;
        if (tid < 256) { const f32x4 p = *(const PG8_LAS f32x4*)(P + tid * 4); SSQ[(size_t)(u.pm * BM + tid) * 8 + u.pn] = (p[0] + p[1]) + (p[2] + p[3]); }
    }
};
#ifndef CONV_LDSW
#define CONV_LDSW 0
#endif
__device__ __forceinline__ float ror1f(float v) { return __builtin_bit_cast(float, __builtin_amdgcn_update_dpp(0, __builtin_bit_cast(int, v), 0x121, 0xf, 0xf, false)); }
__device__ __forceinline__ float ror2f(float v) { return __builtin_bit_cast(float, __builtin_amdgcn_update_dpp(0, __builtin_bit_cast(int, v), 0x122, 0xf, 0xf, false)); }
struct EpiUpConv {
    static constexpr bool PERM = true, AFTER_DRAIN = false, HAS_MID = false;
    const float* RSTD; const float* wconv; const float* bconv; bf16_t* ACT; float* US; PG8_LAS float* xl;
    __device__ __forceinline__ void operator()(f32x4 (&acc)[2][2][4][2], const Unit& u, int wr, int wc, int fr_in, int fq_in) const {
        typedef unsigned u32x2e __attribute__((ext_vector_type(2)));
        PG8_LAS float* wl = xl + (unsigned)(wr * 4 + wc) * 256u;
        { const unsigned L_ = threadIdx.x & 63u, ucol_ = (L_ >> 5) * 5632u + (unsigned)u.pn * 128u + (unsigned)wc * 32u + (L_ & 31u);
          const float t0_ = wconv[ucol_], t1_ = wconv[11264u + ucol_], t2_ = wconv[22528u + ucol_], t3_ = bconv[ucol_];
          wl[L_] = t0_; wl[64u + L_] = t1_; wl[128u + L_] = t2_; wl[192u + L_] = t3_;
          asm volatile("s_waitcnt lgkmcnt(0)" ::: "memory"); }
        (void)fr_in; (void)fq_in; int ln_ = (int)(threadIdx.x & 63u); asm volatile("" : "+v"(ln_)); const int fr = ln_ & 15, fq = ln_ >> 4;
        const unsigned cw = (unsigned)(u.pn * 128 + wc * 32 + 8 * fq), row0 = (unsigned)(u.pm * BM + wr * 64 + fr);
        const bool lo = fr < 2, hi14 = fr >= 14, f1 = fr >= 1, f2 = fr >= 2;
#pragma unroll
        for (int ai = 0; ai < 2; ++ai) { const unsigned G = (unsigned)(4 * u.pm + 2 * ai + wr);
            float rs[4];
#pragma unroll
            for (int m = 0; m < 4; ++m) rs[m] = RSTD[row0 + ai * HALF + m * 16];
            const unsigned aoff = (row0 + ai * HALF) * 5632u + cw;
            const unsigned us_lo = (G * 4 + 2 + (fr & 1)) * 11264u; const bool sthi = hi14 && (G + 1 < 128);
#pragma unroll
            for (int n = 0; n < 2; ++n) {
#pragma unroll
                for (int j = 0; j < 4; ++j) { unsigned col = cw + 4 * n + j; asm volatile("" : "+v"(col));
#pragma unroll
                    for (int bj = 0; bj < 2; ++bj) { const unsigned ucol = bj * 5632 + col;
                        const unsigned lc = (unsigned)bj * 32u + (col - (unsigned)u.pn * 128u - (unsigned)wc * 32u);
                        const float w0 = wl[lc], w1 = wl[64u + lc], w2 = wl[128u + lc], bb = wl[192u + lc];
                        float pa1 = 0.f, pa2 = 0.f;
#pragma unroll
                        for (int m = 0; m < 4; ++m) { const float uu = acc[ai][bj][m][n][j] * rs[m];
                            if (m == 0) { if (lo) US[us_lo + ucol] = uu; }
                            if (m == 3) { if (sthi) US[us_lo + 22528u + ucol] = uu; }
                            const float a1 = ror1f(uu), a2 = ror2f(uu);
                            const float p1 = f1 ? a1 : pa1, p2 = f2 ? a2 : pa2;
                            acc[ai][bj][m][n][j] = fmaf(w0, p2, fmaf(w1, p1, fmaf(w2, uu, bb)));
                            pa1 = a1; pa2 = a2; }
                        }
#pragma unroll
                    for (int m = 0; m < 4; ++m) { const float g0 = acc[ai][0][m][n][j]; acc[ai][0][m][n][j] = g0 * sigm(g0) * acc[ai][1][m][n][j]; }
                    asm volatile("" ::: "memory"); }
#pragma unroll
                for (int m = 0; m < 4; ++m) { u32x2e w; w.x = cvt_pk_bf16(acc[ai][0][m][n][0], acc[ai][0][m][n][1]); w.y = cvt_pk_bf16(acc[ai][0][m][n][2], acc[ai][0][m][n][3]);
                    if (!(m == 0 && lo)) *(u32x2e*)(ACT + (aoff + (unsigned)(m * 16 * 5632 + 4 * n))) = w; }
                asm volatile("" ::: "memory"); __builtin_amdgcn_sched_barrier(0); } }
    }
};
struct EpiUp {
    static constexpr bool PERM = true, AFTER_DRAIN = false, HAS_MID = false;
    const float* RSTD; bf16_t* U;
    __device__ __forceinline__ void operator()(f32x4 (&acc)[2][2][4][2], const Unit& u, int wr, int wc, int fr, int fq) const {
        const int row0 = u.pm * BM + wr * 64 + fr, col0 = u.pn * BM + wc * 32 + 8 * fq;
#pragma unroll
        for (int ai = 0; ai < 2; ++ai)
#pragma unroll
            for (int m = 0; m < 4; ++m) { const int row = row0 + ai * HALF + m * 16; const float rs = RSTD[row]; bf16_t* rowp = U + (size_t)row * 11264 + col0;
#pragma unroll
                for (int bj = 0; bj < 2; ++bj) *(u32x4e*)(rowp + bj * HALF) = pack8f(acc[ai][bj][m][0] * rs, acc[ai][bj][m][1] * rs); }
    }
};
struct EpiFinal {
    static constexpr bool PERM = true, AFTER_DRAIN = false, HAS_MID = false;
    const bf16_t* XB; float* OUT;
    __device__ __forceinline__ void operator()(f32x4 (&acc)[2][2][4][2], const Unit& u, int wr, int wc, int fr, int fq) const {
        const int row0 = u.pm * BM + wr * 64 + fr, col0 = u.pn * BM + wc * 32 + 8 * fq;
#pragma unroll
        for (int ai = 0; ai < 2; ++ai)
#pragma unroll
            for (int m = 0; m < 4; ++m)
#pragma unroll
                for (int bj = 0; bj < 2; ++bj) { const size_t off = (size_t)(row0 + ai * HALF + m * 16) * 2048 + col0 + bj * HALF;
                    const u32x4e w = __builtin_nontemporal_load((const u32x4e*)(XB + off));
                    const f32x4 a = {bflo(w.x), bfhi(w.x), bflo(w.y), bfhi(w.y)}, b = {bflo(w.z), bfhi(w.z), bflo(w.w), bfhi(w.w)};
                    __builtin_nontemporal_store(a + acc[ai][bj][m][0], (f32x4*)(OUT + off)); __builtin_nontemporal_store(b + acc[ai][bj][m][1], (f32x4*)(OUT + off + 4)); }
    }
};

template <class Epi, class Sched, bool ALIGN_EPI = false, bool SP2 = false>
__device__ __forceinline__ void gemm_phase(PG8_LAS unsigned char* lds, const Gemm g, const Sched& S, const Epi& E) {
    int tid_o = threadIdx.x; asm volatile("" : "+v"(tid_o));
    const int tid = tid_o, wid = __builtin_amdgcn_readfirstlane(tid >> 6), lane = tid & 63, wr = wid >> 2, wc = wid & 3, fr = lane & 15, fq = lane >> 4;
    const int K = g.K, nt = K / BK;
    unsigned voffA[1], voffB[1];
#pragma unroll
    for (int i = 0; i < 1; ++i) { int R, C; stage_rc(tid * 16 + i * 8192, R, C); const int Rb = Epi::PERM ? ((R & ~31) + perm32(R & 31)) : R;
        voffA[i] = (unsigned)(R * K + C) * 2u; voffB[i] = (unsigned)(Rb * K + C) * 2u; }
    const size_t vstep = (size_t)K * 128;
    const size_t kstep = (size_t)(BK * 2);
    const size_t hstep = (size_t)HALF * K * 2;
    const size_t tstep = 2 * hstep;
    const unsigned ldsw = (unsigned)wid * 1024u;
    const int aoff = lds_byte(wr * 64 + fr, fq * 8), boff = lds_byte(wc * 32 + fr, fq * 8);
#define PG8_SA(b, h) (((b) * 2 + (h)) * HTB)
#define PG8_SB(b, h) ((4 + (b) * 2 + (h)) * HTB)
#define PG8_STAGE(bufoff, gbase, voff) do { _Pragma("unroll") for (int _i = 0; _i < 2; ++_i) \
        __builtin_amdgcn_global_load_lds((const unsigned*)((const char*)(gbase) + (size_t)_i * vstep + (voff)[0]), (PG8_LAS unsigned*)(lds + (bufoff) + ldsw + _i * 8192), 16, 0, 0); } while (0)
#define PG8_LDA(dst, b, h) do { _Pragma("unroll") for (int m = 0; m < 4; ++m) _Pragma("unroll") for (int k = 0; k < 2; ++k) dst[m][k] = *(const PG8_LAS bf16x8*)(lds + PG8_SA(b, h) + aoff + m * 2048 + k * 1024); } while (0)
#define PG8_LDB(dst, b, h) do { _Pragma("unroll") for (int n = 0; n < 2; ++n) _Pragma("unroll") for (int k = 0; k < 2; ++k) dst[n][k] = *(const PG8_LAS bf16x8*)(lds + PG8_SB(b, h) + boff + n * 2048 + k * 1024); } while (0)
#define PG8_MMA(ai, bj, At, Bt) do { __builtin_amdgcn_s_setprio(1); _Pragma("unroll") for (int m = 0; m < 4; ++m) _Pragma("unroll") for (int n = 0; n < 2; ++n) _Pragma("unroll") for (int k = 0; k < 2; ++k) \
        acc[ai][bj][m][n] = __builtin_amdgcn_mfma_f32_16x16x32_bf16(Bt[n][k], At[m][k], acc[ai][bj][m][n], 0, 0, 0); __builtin_amdgcn_s_setprio(0); } while (0)
#define PG8_WAIT_V(n) asm volatile("s_waitcnt vmcnt(" #n ")" ::: "memory")
#define PG8_WAIT_L(n) asm volatile("s_waitcnt lgkmcnt(" #n ")" ::: "memory")
#define PG8_BAR __builtin_amdgcn_s_barrier()
#define PG8_SCHED __builtin_amdgcn_sched_barrier(0)
    Unit cur, nxt; int ui = 0;
    if (!S.next(0, cur)) return;
    f32x4 acc[2][2][4][2];
#pragma unroll
    for (int a = 0; a < 2; ++a)
#pragma unroll
        for (int b = 0; b < 2; ++b)
#pragma unroll
            for (int m = 0; m < 4; ++m)
#pragma unroll
                for (int n = 0; n < 2; ++n) acc[a][b][m][n] = (f32x4){0.f, 0.f, 0.f, 0.f};
    bf16x8 At[4][2], B0[2][2], B1[2][2];
    const char* cA = (const char*)g.A + (size_t)cur.pm * tstep; const char* cB = (const char*)g.Bt + (size_t)cur.pn * tstep;
    S.a_ready(cur);
    if constexpr (SP2) {
        PG8_STAGE(PG8_SB(0, 0), cB, voffB); PG8_STAGE(PG8_SB(0, 1), cB + hstep, voffB); PG8_STAGE(PG8_SA(0, 0), cA, voffA); PG8_STAGE(PG8_SA(0, 1), cA + hstep, voffA);
        if (wr == 1) PG8_BAR;
        PG8_WAIT_V(2); PG8_BAR;
        PG8_STAGE(PG8_SB(1, 0), cB + kstep, voffB); PG8_STAGE(PG8_SA(1, 0), cA + kstep, voffA); PG8_STAGE(PG8_SB(1, 1), cB + hstep + kstep, voffB);
        PG8_WAIT_V(6); PG8_BAR;
    } else {
        PG8_STAGE(PG8_SB(0, 0), cB, voffB); PG8_STAGE(PG8_SA(0, 0), cA, voffA); PG8_STAGE(PG8_SB(0, 1), cB + hstep, voffB); PG8_STAGE(PG8_SA(0, 1), cA + hstep, voffA);
        if (wr == 1) PG8_BAR;
        PG8_WAIT_V(4); PG8_BAR;
        PG8_STAGE(PG8_SB(1, 0), cB + kstep, voffB); PG8_STAGE(PG8_SA(1, 0), cA + kstep, voffA); PG8_STAGE(PG8_SB(1, 1), cB + hstep + kstep, voffB);
        PG8_WAIT_V(6); PG8_BAR;
    }
    for (;;) {
        const bool has_next = S.next(ui + 1, nxt);
        const char* nA = has_next ? (const char*)g.A + (size_t)nxt.pm * tstep : cA; const char* nB = has_next ? (const char*)g.Bt + (size_t)nxt.pn * tstep : cB;
        for (int t = 0; t < nt; t += 2) {
            if constexpr (Epi::HAS_MID) { if (t == (nt >> 1)) E.mid(acc, cur, wr, wc, fr, fq); }
            const bool last = (t == nt - 2);
            const char* a1 = cA + (size_t)(t + 1) * kstep;
            const char* a2 = last ? nA : cA + (size_t)(t + 2) * kstep; const char* b2 = last ? nB : cB + (size_t)(t + 2) * kstep;
            const char* a3 = a2 + kstep; const char* b3 = b2 + kstep;
            if (last && has_next) S.a_ready(nxt);
            if constexpr (SP2) {
            PG8_LDB(B0, 0, 0); PG8_LDB(B1, 0, 1); PG8_SCHED; PG8_LDA(At, 0, 0); PG8_STAGE(PG8_SA(1, 1), a1 + hstep, voffA);
            PG8_WAIT_V(8); PG8_WAIT_L(0); PG8_BAR; PG8_MMA(0, 0, At, B0); PG8_MMA(0, 1, At, B1); PG8_BAR; PG8_SCHED;
            PG8_LDA(At, 0, 1); PG8_STAGE(PG8_SB(0, 0), b2, voffB); PG8_STAGE(PG8_SB(0, 1), b2 + hstep, voffB); PG8_STAGE(PG8_SA(0, 0), a2, voffA);
            PG8_WAIT_V(8); PG8_WAIT_L(0); PG8_BAR; PG8_MMA(1, 0, At, B0); PG8_MMA(1, 1, At, B1); PG8_BAR; PG8_SCHED;
            PG8_LDB(B0, 1, 0); PG8_LDB(B1, 1, 1); PG8_SCHED; PG8_LDA(At, 1, 0); PG8_STAGE(PG8_SA(0, 1), a2 + hstep, voffA);
            PG8_WAIT_V(8); PG8_WAIT_L(0); PG8_BAR; PG8_MMA(0, 0, At, B0); PG8_MMA(0, 1, At, B1); PG8_BAR; PG8_SCHED;
            PG8_LDA(At, 1, 1); PG8_STAGE(PG8_SB(1, 0), b3, voffB); PG8_STAGE(PG8_SB(1, 1), b3 + hstep, voffB); PG8_STAGE(PG8_SA(1, 0), a3, voffA);
            PG8_WAIT_V(8); PG8_WAIT_L(0); PG8_BAR; PG8_MMA(1, 0, At, B0); PG8_MMA(1, 1, At, B1); PG8_BAR; PG8_SCHED;
            } else {
            PG8_LDB(B0, 0, 0); PG8_SCHED; PG8_LDA(At, 0, 0); PG8_STAGE(PG8_SA(1, 1), a1 + hstep, voffA);
            PG8_WAIT_L(8); PG8_BAR; PG8_WAIT_L(0); PG8_MMA(0, 0, At, B0); PG8_BAR; PG8_SCHED;
            PG8_LDB(B1, 0, 1); PG8_STAGE(PG8_SB(0, 0), b2, voffB);
            PG8_BAR; PG8_WAIT_L(0); PG8_MMA(0, 1, At, B1); PG8_BAR;
            PG8_LDA(At, 0, 1); PG8_STAGE(PG8_SA(0, 0), a2, voffA);
            PG8_BAR; PG8_WAIT_L(0); PG8_MMA(1, 0, At, B0); PG8_BAR; PG8_SCHED;
            PG8_STAGE(PG8_SB(0, 1), b2 + hstep, voffB);
            PG8_WAIT_V(6); PG8_BAR; PG8_MMA(1, 1, At, B1); PG8_BAR;
            PG8_LDB(B0, 1, 0); PG8_SCHED; PG8_LDA(At, 1, 0); PG8_STAGE(PG8_SA(0, 1), a2 + hstep, voffA);
            PG8_WAIT_L(8); PG8_BAR; PG8_WAIT_L(0); PG8_MMA(0, 0, At, B0); PG8_BAR; PG8_SCHED;
            PG8_LDB(B1, 1, 1); PG8_STAGE(PG8_SB(1, 0), b3, voffB);
            PG8_BAR; PG8_WAIT_L(0); PG8_MMA(0, 1, At, B1); PG8_BAR;
            PG8_LDA(At, 1, 1); PG8_STAGE(PG8_SA(1, 0), a3, voffA);
            PG8_BAR; PG8_WAIT_L(0); PG8_MMA(1, 0, At, B0); PG8_BAR; PG8_SCHED;
            PG8_STAGE(PG8_SB(1, 1), b3 + hstep, voffB);
            PG8_WAIT_V(6); PG8_BAR; PG8_MMA(1, 1, At, B1); PG8_BAR;
            }
        }
        if constexpr (ALIGN_EPI) { if (wr == 0) PG8_BAR; }
        if constexpr (!Epi::AFTER_DRAIN) { E(acc, cur, wr, wc, fr, fq); S.done(cur); }
        if (!has_next) break;
#pragma unroll
        for (int a = 0; a < 2; ++a)
#pragma unroll
            for (int b = 0; b < 2; ++b)
#pragma unroll
                for (int m = 0; m < 4; ++m)
#pragma unroll
                    for (int n = 0; n < 2; ++n) acc[a][b][m][n] = (f32x4){0.f, 0.f, 0.f, 0.f};
        cur = nxt; cA = nA; cB = nB; ++ui;
        if constexpr (ALIGN_EPI) { if (wr == 1) PG8_BAR; }
    }
    PG8_WAIT_V(0);
    if constexpr (!ALIGN_EPI) { if (wr == 0) PG8_BAR; }
    PG8_BAR;
    if constexpr (Epi::AFTER_DRAIN) { E.fused(acc, cur, wr, wc, fr, fq, lds, wid, lane); S.done(cur); }
#undef PG8_SA
#undef PG8_SB
#undef PG8_STAGE
#undef PG8_LDA
#undef PG8_LDB
#undef PG8_MMA
#undef PG8_WAIT_V
#undef PG8_WAIT_L
#undef PG8_BAR
#undef PG8_SCHED
}
}

namespace att {
typedef unsigned short bf16;
constexpr int D = 128, NW = 8, QBLK = 32, KVBLK = 64, QB = NW * QBLK;
constexpr int SHM_V = KVBLK * D * 2, SHM_K = KVBLK * D * 2;
constexpr int LDS_WS = 2 * SHM_V + 2 * SHM_K, LDS_KB = LDS_WS + NW * 64 * 4, LDS_SLOT = LDS_KB + 2 * 64 * 4, LDS_Q = LDS_SLOT + 256, LDS_END = LDS_Q + NW * 8192;
constexpr float SCALE = 1.f, THR = 8.f;
typedef short bf16x8 __attribute__((ext_vector_type(8)));
typedef short s16x4 __attribute__((ext_vector_type(4)));
typedef float f32x16 __attribute__((ext_vector_type(16)));
typedef float f32x4 __attribute__((ext_vector_type(4)));
typedef unsigned u32x4 __attribute__((ext_vector_type(4)));
template <class A, class Bt> struct same_t { static constexpr bool v = false; };
template <class A> struct same_t<A, A> { static constexpr bool v = true; };

#define KSWZ(row, colB) ((row) * 256 + ((colB) ^ (((row) & 7) << 4)))
#define SBAR() __builtin_amdgcn_sched_barrier(0)
__device__ __forceinline__ int v_st(int k, int c) { const int kk = (k & ~0xC) | ((k & 4) << 1) | ((k & 8) >> 1); return ((kk >> 3) * 4 + (c >> 5)) * 512 + ((kk & 7) * 32 + (c & 31)) * 2; }
__device__ __forceinline__ int v_rd_base(int lane) { return ((lane & 3) << 3) | (((lane >> 2) & 3) << 6) | (((lane >> 4) & 1) << 5) | (((lane >> 5) & 1) << 8); }
constexpr int v_rd_off(int d0, int ks, int half) { return d0 * 512 + ks * 4096 + half * 2048; }
__device__ __forceinline__ int crow(int r, int hi) { return (r & 3) + 8 * (r >> 2) + 4 * hi; }
__device__ __forceinline__ unsigned cvtpk(float lo, float hi) {
    unsigned r; asm volatile("v_cvt_pk_bf16_f32 %0, %1, %2" : "=v"(r) : "v"(lo), "v"(hi)); return r;
}
__device__ __forceinline__ bf16x8 pack8(f32x4 a, f32x4 b) {
    u32x4 w = {cvtpk(a[0], a[1]), cvtpk(a[2], a[3]), cvtpk(b[0], b[1]), cvtpk(b[2], b[3])};
    return *reinterpret_cast<bf16x8*>(&w);
}
template <class T> __device__ __forceinline__ bf16x8 load8(const T* p) {
    if constexpr (same_t<T, float>::v) { return pack8(*(const f32x4*)p, *(const f32x4*)(p + 4)); }
    else { return *reinterpret_cast<const bf16x8*>(p); }
}
__device__ __forceinline__ void mask_tile(f32x16& p0, f32x16& p1, int dq, unsigned W) {
    const float NEG = -__builtin_inff();
#pragma unroll
    for (int r = 0; r < 16; ++r) {
        const int c = (r & 3) + 8 * (r >> 2);
        if ((unsigned)(dq - c) >= W) p0[r] = NEG;
        if ((unsigned)(dq - c - 32) >= W) p1[r] = NEG;
    }
}
__device__ __forceinline__ void partialSM(f32x16& p0, f32x16& p1, float& m_reg, float& mn, float& alpha) {
    float pmax = p0[0]; for (int r = 1; r < 16; ++r) pmax = fmaxf(pmax, p0[r]); for (int r = 0; r < 16; ++r) pmax = fmaxf(pmax, p1[r]);
    { auto rr = __builtin_amdgcn_permlane32_swap(__float_as_uint(pmax), __float_as_uint(pmax), false, false);
      pmax = fmaxf(__uint_as_float(rr[0]), __uint_as_float(rr[1])); }
    constexpr float C2 = 1.f;
    if (__builtin_expect(__all((pmax - m_reg) * SCALE <= THR), 1)) { mn = m_reg; alpha = 1.f; }
    else { mn = fmaxf(m_reg, pmax); alpha = __builtin_amdgcn_exp2f((m_reg - mn) * C2); m_reg = mn; }
    const float mnL = -mn * C2;
    for (int r = 0; r < 16; ++r) p0[r] = fmaf(p0[r], C2, mnL); for (int r = 0; r < 16; ++r) p1[r] = fmaf(p1[r], C2, mnL);
    for (int r = 0; r < 16; ++r) p0[r] = __builtin_amdgcn_exp2f(p0[r]);
}
__device__ __forceinline__ void finishSM(f32x16& p0, f32x16& p1, float alpha, float& l_reg, bf16x8& pa0, bf16x8& pa1, bf16x8& pa2, bf16x8& pa3) {
    for (int r = 0; r < 16; ++r) p1[r] = __builtin_amdgcn_exp2f(p1[r]);
    float ps = 0; for (int r = 0; r < 16; ++r) ps += p0[r]; for (int r = 0; r < 16; ++r) ps += p1[r];
    { auto rr = __builtin_amdgcn_permlane32_swap(__float_as_uint(ps), __float_as_uint(ps), false, false);
      ps = __uint_as_float(rr[0]) + __uint_as_float(rr[1]); }
    l_reg = l_reg * alpha + ps;
#define PK4(P, B_, OUT) do { unsigned a0 = cvtpk(P[B_+0], P[B_+1]), a1 = cvtpk(P[B_+2], P[B_+3]);                          \
        unsigned b0 = cvtpk(P[B_+4], P[B_+5]), b1 = cvtpk(P[B_+6], P[B_+7]);                                             \
        auto r0 = __builtin_amdgcn_permlane32_swap(a0, b0, false, false); auto r1 = __builtin_amdgcn_permlane32_swap(a1, b1, false, false); \
        u32x4 w = {r0[0], r1[0], r0[1], r1[1]}; OUT = *reinterpret_cast<bf16x8*>(&w); } while (0)
    PK4(p0, 0, pa0); PK4(p0, 8, pa1); PK4(p1, 0, pa2); PK4(p1, 8, pa3);
#undef PK4
}
template <int KB, bool SK>
__device__ __forceinline__ void qkt(f32x16& p0, f32x16& p1, const char* K_lds, const float* kbl, int r32, int hi, const __attribute__((address_space(3))) char* q_lds, bool act) {
    if (SK && !act) { const float NEG = -__builtin_inff();
#pragma unroll
        for (int r = 0; r < 16; ++r) { p0[r] = NEG; p1[r] = NEG; } return; }
    { const float* kb_ = kbl + KB * 64 + 4 * hi;
#pragma unroll
      for (int j = 0; j < 4; ++j) { const f32x4 a = *(const f32x4*)(kb_ + 8 * j), b = *(const f32x4*)(kb_ + 32 + 8 * j);
          p0[4 * j] = a[0]; p0[4 * j + 1] = a[1]; p0[4 * j + 2] = a[2]; p0[4 * j + 3] = a[3];
          p1[4 * j] = b[0]; p1[4 * j + 1] = b[1]; p1[4 * j + 2] = b[2]; p1[4 * j + 3] = b[3]; } }
    const char* kb[4];
#pragma unroll
    for (int dd = 0; dd < 4; ++dd) kb[dd] = K_lds + KB * SHM_K + KSWZ(r32, (dd * 16 + hi * 8) * 2);
#pragma unroll
    for (int d0 = 0; d0 < 8; ++d0) { const char* a = kb[d0 & 3] + (d0 >> 2) * 128;
        bf16x8 b0 = *reinterpret_cast<const bf16x8*>(a);
        bf16x8 b1 = *reinterpret_cast<const bf16x8*>(a + 32 * 256);
        const bf16x8 q_ = *(const __attribute__((address_space(3))) bf16x8*)(q_lds + d0 * 1024);
        p0 = __builtin_amdgcn_mfma_f32_32x32x16_bf16(b0, q_, p0, 0, 0, 0);
        p1 = __builtin_amdgcn_mfma_f32_32x32x16_bf16(b1, q_, p1, 0, 0, 0); }
}
template <int VB, bool SK>
__device__ __forceinline__ void pv_tile(f32x16* o, int vb0, bf16x8 pa0, bf16x8 pa1, bf16x8 pa2, bf16x8 pa3, bool act) {
    if (SK && !act) return;
#define TRRD(dst, off) asm volatile("ds_read_b64_tr_b16 %0, %1 offset:%2" : "=&v"(dst) : "v"(vb0), "i"(off) : "memory")
#define PV_D0(d0) do { s16x4 l0, l1, l2, l3, h0, h1, h2, h3; constexpr int b_ = VB * SHM_V + v_rd_off(d0, 0, 0);     \
        TRRD(l0, b_); TRRD(h0, b_ + 2048); TRRD(l1, b_ + 4096); TRRD(h1, b_ + 6144); TRRD(l2, b_ + 8192); TRRD(h2, b_ + 10240); TRRD(l3, b_ + 12288); TRRD(h3, b_ + 14336); \
        asm volatile("s_waitcnt lgkmcnt(0)" ::: "memory"); SBAR();                 \
        o[d0] = __builtin_amdgcn_mfma_f32_32x32x16_bf16(pa0, (bf16x8){l0[0], l0[1], l0[2], l0[3], h0[0], h0[1], h0[2], h0[3]}, o[d0], 0, 0, 0);   \
        o[d0] = __builtin_amdgcn_mfma_f32_32x32x16_bf16(pa1, (bf16x8){l1[0], l1[1], l1[2], l1[3], h1[0], h1[1], h1[2], h1[3]}, o[d0], 0, 0, 0);   \
        o[d0] = __builtin_amdgcn_mfma_f32_32x32x16_bf16(pa2, (bf16x8){l2[0], l2[1], l2[2], l2[3], h2[0], h2[1], h2[2], h2[3]}, o[d0], 0, 0, 0);   \
        o[d0] = __builtin_amdgcn_mfma_f32_32x32x16_bf16(pa3, (bf16x8){l3[0], l3[1], l3[2], l3[3], h3[0], h3[1], h3[2], h3[3]}, o[d0], 0, 0, 0); } while (0)
    PV_D0(0); PV_D0(1); PV_D0(2); PV_D0(3);
#undef PV_D0
#undef TRRD
}

constexpr float LOG2E = 1.4426950408889634f;
struct Blk {
    const bf16* Q; const bf16* K; const bf16* V; bf16* O; float* LSE; const float* CUM;
    long rs, os; int ls;
    int P0, L, W, nvalid; float sd2, cref;
};
struct Seam { bf16x8 st_v0, st_v1, st_k0, st_k1; float st_b0, st_b1; };
__device__ __forceinline__ float kbias_raw(const Blk& B, int key) { return B.CUM ? B.CUM[key] : B.sd2 * (float)(key - B.P0); }
__device__ __forceinline__ float kbias_fin(const Blk& B, float raw) { return B.CUM ? -raw * LOG2E : raw; }
__device__ __forceinline__ int swa_jlo(int P0, int W) { const int lowk = P0 - W + 1; return lowk > 0 ? lowk / KVBLK : 0; }
__device__ __forceinline__ int swa_jhi(int P0, int L) { int j = (P0 + QB - 1) / KVBLK + 1; const int jm = L / KVBLK; return j > jm ? jm : j; }
__device__ __forceinline__ bf16x8 ld8(const bf16* p) { return *reinterpret_cast<const bf16x8*>(p); }
#define ROWP(p, rs_, k0, rr) ((p) + (size_t)(k0) * (rs_) + (unsigned)(((rr) * (int)(rs_)) + sc))
#define VMW() asm volatile("s_waitcnt vmcnt(0)" ::: "memory")
#define SLOAD(B_, k0) do { const bf16* vb_ = (B_).V + (size_t)(k0) * (B_).rs; const bf16* kb_ = (B_).K + (size_t)(k0) * (B_).rs;     \
                           unsigned o0_ = (unsigned)(sr * (int)(B_).rs + sc), o1_ = o0_ + 32u * (unsigned)(B_).rs; asm volatile("" : "+v"(o0_), "+v"(o1_));       \
                           S.st_v0 = ld8(vb_ + o0_); S.st_v1 = ld8(vb_ + o1_); S.st_k0 = ld8(kb_ + o0_); S.st_k1 = ld8(kb_ + o1_);                                  \
                           if ((tid & 15) == 0) { S.st_b0 = kbias_raw((B_), (k0) + sr); S.st_b1 = kbias_raw((B_), (k0) + 32 + sr); } } while (0)
#define SWRITE_K(bf, B_) do { *(bf16x8*)(K_lds + (bf) * SHM_K + kws) = S.st_k0; *(bf16x8*)(K_lds + (bf) * SHM_K + kws + 32 * 256) = S.st_k1;       \
                          if ((tid & 15) == 0) { kbl[(bf) * 64 + sr] = kbias_fin((B_), S.st_b0); kbl[(bf) * 64 + 32 + sr] = kbias_fin((B_), S.st_b1); } } while (0)
#define SWRITE_V(bf) do { *(bf16x8*)(V_lds + (bf) * SHM_V + vst0) = S.st_v0; *(bf16x8*)(V_lds + (bf) * SHM_V + vst1) = S.st_v1; } while (0)
#define QLOAD(B_) do { const int ri_ = (wid * QBLK + r32 < (B_).nvalid) ? wid * QBLK + r32 : (B_).nvalid - 1;                                    \
        const bf16* qp_ = (B_).Q + (unsigned)(ri_ * (int)(B_).rs + hi * 8);                                                                       \
        _Pragma("unroll") for (int hf_ = 0; hf_ < 2; ++hf_) { bf16x8 t_[4];                                                                      \
            _Pragma("unroll") for (int d0 = 0; d0 < 4; ++d0) t_[d0] = ld8(qp_ + (hf_ * 4 + d0) * 16);                                           \
            _Pragma("unroll") for (int d0 = 0; d0 < 4; ++d0) *(__attribute__((address_space(3))) bf16x8*)(q_lds + (hf_ * 4 + d0) * 1024) = t_[d0]; } } while (0)

__device__ __forceinline__ void prime(const Blk& cur, char* lds, Seam& S) {
    int tid_o = threadIdx.x; asm volatile("" : "+v"(tid_o));
    const int tid = tid_o, wid = __builtin_amdgcn_readfirstlane(tid >> 6), lane = tid & 63, r32 = lane & 31, hi = lane >> 5;
    const int sr = tid >> 4, sc = (tid & 15) * 8, kws = KSWZ(sr, sc * 2); char* K_lds = lds + 2 * SHM_V; float* kbl = (float*)(lds + LDS_KB); __attribute__((address_space(3))) char* q_lds = (__attribute__((address_space(3))) char*)(lds + LDS_Q + wid * 8192 + lane * 16);
    const int kb0 = (swa_jhi(cur.P0, cur.L) - 1) * KVBLK;
    S.st_b0 = 0.f; S.st_b1 = 0.f;
    QLOAD(cur);
    SLOAD(cur, kb0); VMW(); SWRITE_K(0, cur);
    __syncthreads();
}
#ifndef ATT_SK
#define ATT_SK true
#endif
struct AttnArgs { const bf16* QKV; unsigned char* ws; long offOA, offOP0, offOP2x; float* LSE; const float* CUM; };
__device__ __forceinline__ Blk decode(int i, const AttnArgs& A);
template <bool SK>
__device__ __forceinline__ bool block(const Blk& cur, Blk& nxt, int pend, int nitems, volatile int* slot, const AttnArgs& A, char* lds, Seam& S) {
    int tid_o = threadIdx.x; asm volatile("" : "+v"(tid_o));
    const int tid = tid_o, wid = __builtin_amdgcn_readfirstlane(tid >> 6), lane = tid & 63, r32 = lane & 31, hi = lane >> 5;
    const int W = cur.W;
    const int j_lo = swa_jlo(cur.P0, W);
    const int j_hi = swa_jhi(cur.P0, cur.L);
    const int NT = j_hi - j_lo;
    const int qlo = cur.P0 + wid * QBLK, qm = qlo + r32 - 4 * hi;
    char* V_lds = lds; char* K_lds = lds + 2 * SHM_V;
    float* ws = (float*)(lds + LDS_WS) + wid * 64; float* li_l = ws, * al_l = ws + 32; float* kbl = (float*)(lds + LDS_KB); __attribute__((address_space(3))) char* q_lds = (__attribute__((address_space(3))) char*)(lds + LDS_Q + wid * 8192 + lane * 16);
    float m_reg = -1e30f, l_reg = 0; f32x16 o[4] = {};
    const int sr = tid >> 4, sc = (tid & 15) * 8, vst0 = v_st(sr, sc), vst1 = v_st(32 + sr, sc), kws = KSWZ(sr, sc * 2);
    const int vb0 = (int)(uintptr_t)V_lds + v_rd_base(lane);
#define RESC(a) do { if (__any((a) < 1.f)) { if (hi == 0) al_l[r32] = (a); asm volatile("s_waitcnt lgkmcnt(0)" ::: "memory");              \
                     for (int d_ = 0; d_ < 4; ++d_) for (int r = 0; r < 16; ++r) o[d_][r] *= al_l[crow(r, hi)]; } } while (0)
#define KBASE(t) ((j_hi - 1 - (t)) * KVBLK)
#define ACT(t) (KBASE(t) <= qlo + QBLK - 1 && KBASE(t) + KVBLK - 1 >= qlo - W + 1)
#define MASKT(P0_, P1_, t) do { const int kb_ = KBASE(t); if ((!SK || ACT(t)) && (kb_ + KVBLK - 1 > qlo || kb_ <= qlo + QBLK - 1 - W)) mask_tile(P0_, P1_, qm - kb_, (unsigned)W); } while (0)
    f32x16 pA0, pA1, pB0, pB1; float mnA, mnB, alA, alB; bf16x8 pa0, pa1, pa2, pa3;
    SWRITE_V(0); SBAR();
    if (NT > 1) SLOAD(cur, KBASE(1));
    SBAR(); qkt<0, SK>(pA0, pA1, K_lds, kbl, r32, hi, q_lds, ACT(0));
    MASKT(pA0, pA1, 0); partialSM(pA0, pA1, m_reg, mnA, alA);
    if (NT > 1) { VMW(); SWRITE_V(1); SWRITE_K(1, cur); }
    __syncthreads();
#define HALF_STEP(PX0, PX1, mnX, alX, PY0, PY1, alY, t, KB, VB, SB) do {                                                      \
        SBAR(); qkt<KB, SK>(PX0, PX1, K_lds, kbl, r32, hi, q_lds, ACT(t));                                                     \
        finishSM(PY0, PY1, alY, l_reg, pa0, pa1, pa2, pa3); SBAR();                                                           \
        if ((t) + 1 < NT) { SLOAD(cur, KBASE((t) + 1)); SBAR(); }                                                             \
        pv_tile<VB, SK>(o, vb0, pa0, pa1, pa2, pa3, ACT((t) - 1)); MASKT(PX0, PX1, (t)); partialSM(PX0, PX1, m_reg, mnX, alX); \
        __syncthreads();                                                                                                      \
        if ((t) + 1 < NT) { VMW(); SWRITE_V(SB); SWRITE_K(SB, cur); }                                                              \
        RESC(alX); __syncthreads(); } while (0)
    for (int t = 1; t + 1 < NT; t += 2) {
        HALF_STEP(pB0, pB1, mnB, alB, pA0, pA1, alA, t, 1, 0, 0);
        HALF_STEP(pA0, pA1, mnA, alA, pB0, pB1, alB, t + 1, 0, 1, 1);
    }
    const bool even = (NT & 1) == 0;
    if (even) { SBAR(); qkt<1, SK>(pB0, pB1, K_lds, kbl, r32, hi, q_lds, ACT(NT - 1)); SBAR(); }
    if (tid == 0) slot[0] = pend;
    __syncthreads();
    const int ni = __builtin_amdgcn_readfirstlane(slot[0]); const bool last = ni >= nitems;
    nxt = decode(last ? 0 : ni, A);
    if (!last) { const int kbn = (swa_jhi(nxt.P0, nxt.L) - 1) * KVBLK;
        SLOAD(nxt, kbn); SBAR();
        QLOAD(nxt); }
    SBAR();
    finishSM(pA0, pA1, alA, l_reg, pa0, pa1, pa2, pa3); SBAR();
    pv_tile<0, SK>(o, vb0, pa0, pa1, pa2, pa3, ACT(even ? NT - 2 : NT - 1));
    if (even) { MASKT(pB0, pB1, NT - 1); partialSM(pB0, pB1, m_reg, mnB, alB); __syncthreads(); RESC(alB);
        finishSM(pB0, pB1, alB, l_reg, pa0, pa1, pa2, pa3); SBAR(); pv_tile<1, SK>(o, vb0, pa0, pa1, pa2, pa3, ACT(NT - 1)); }
    SBAR(); if (!last) SWRITE_K(0, nxt); SBAR();
    int lne_ = (int)(threadIdx.x & 63u); asm volatile("" : "+v"(lne_)); const int r32e = lne_ & 31, hie = lne_ >> 5;
    if (hie == 0) li_l[r32e] = l_reg; asm volatile("s_waitcnt lgkmcnt(0)" ::: "memory");
    float rli[16];
#pragma unroll
    for (int r = 0; r < 16; ++r) rli[r] = __builtin_amdgcn_rcpf(li_l[crow(r, hie)]);
    bf16* Ow = cur.O + (size_t)(wid * QBLK) * cur.os;
#pragma unroll
    for (int r = 0; r < 16; ++r) { const int orow = crow(r, hie); const bool ok = (wid * QBLK + orow < cur.nvalid) && ((r32e & 1) == 0);
#pragma unroll
        for (int d0 = 0; d0 < 4; ++d0) { const float v = o[d0][r] * rli[r]; const float vn = __shfl_xor(v, 1);
            if (ok) *(unsigned*)(Ow + (unsigned)(orow * (int)cur.os + d0 * 32 + r32e)) = cvtpk(v, vn); } }
    if (cur.LSE && hie == 0 && wid * QBLK + r32e < cur.nvalid)
        cur.LSE[(unsigned)((wid * QBLK + r32e) * cur.ls)] = m_reg + __builtin_amdgcn_logf(l_reg) - cur.sd2 * (float)(wid * QBLK + r32e);
    __syncthreads();
    return last;
#undef RESC
#undef KBASE
#undef ACT
#undef MASKT
#undef HALF_STEP
}
#undef ROWP
#undef VMW
#undef SLOAD
#undef SWRITE_K
#undef SWRITE_V
#undef QLOAD

constexpr int NITEMS = 256 + 256 + 256 + 512;
__device__ __forceinline__ Blk decode(int i_in, const AttnArgs& A) {
    const int i = __builtin_amdgcn_readfirstlane(i_in);
    Blk b; int bh, qb, res, dil, pat; const bool fox = i < 256;
    if (i < 256) { qb = 7 - (i >> 5); bh = i & 31; res = 0; dil = 1; pat = 0; }
    else if (i < 512) { const int j = i - 256; qb = 7 - (j >> 5); bh = j & 31; res = 0; dil = 1; pat = 0; }
    else if (i < 768) { const int j = i - 512; bh = j & 31; const int rest = j >> 5; res = rest >> 1; qb = rest & 1; dil = 4; pat = 1; }
    else { const int j = i - 768; bh = j & 31; res = j >> 5; qb = 0; dil = 16; pat = 2; }
    const int bb = bh >> 3, h = bh & 7, L = 2048 / dil, P0 = qb * 256;
    const size_t tok0 = (size_t)bb * 2048 + res;
    const int seg = fox ? 0 : 3;
    const bf16* base = A.QKV + tok0 * 6144 + h * 128;
    const int opitch = fox ? 2048 : 1024;
    b.rs = (long)dil * 6144; b.os = (long)dil * opitch; b.ls = dil * 8;
    b.Q = base + seg * 1024 + (size_t)P0 * b.rs; b.K = base + (seg + 1) * 1024; b.V = base + (seg + 2) * 1024;
    long ooff = A.offOP0 + (long)pat * (16l << 20) + (pat == 2 ? A.offOP2x : 0l); ooff = fox ? A.offOA : ooff;
    bf16* ob = (bf16*)(A.ws + ooff);
    b.O = ob + (tok0 + (size_t)P0 * dil) * opitch + h * 128;
    float* lb = A.LSE + (size_t)pat * (8192 * 8);
    b.LSE = fox ? nullptr : lb + (tok0 + (size_t)P0 * dil) * 8 + h;
    b.CUM = fox ? A.CUM + (size_t)bh * 2048 : nullptr;
    b.cref = 0.f;
    b.P0 = P0; b.L = L; b.W = fox ? (1 << 30) : 129; b.nvalid = (L - P0) < QB ? (L - P0) : QB;
    b.sd2 = fox ? 0.f : __builtin_amdgcn_exp2f(-(float)(h + 1)) * (float)dil * LOG2E;
    return b;
}
__device__ __forceinline__ void attn_phase(char* lds, const AttnArgs& A, unsigned* ctr, int first = 0) {
    volatile int* slot = (volatile int*)(lds + LDS_SLOT);
    const int G = (int)gridDim.x, ci = first + (int)blockIdx.x;
    if (ci >= NITEMS) return;
    Blk cur = decode(ci, A); Seam S;
    prime(cur, lds, S);
    for (;;) {
        int pend = NITEMS; if (threadIdx.x == 0) pend = first + G + (int)atomicAdd(ctr, 1u);
        Blk nxt; bool last;
        if (cur.CUM) last = block<false>(cur, nxt, pend, NITEMS, slot, A, lds, S);
        else last = block<true>(cur, nxt, pend, NITEMS, slot, A, lds, S);
        if (last) break;
        cur = nxt;
    }
}
#undef SBAR
}

#define GAS __attribute__((address_space(1)))
#define LAS __attribute__((address_space(3)))
typedef unsigned short bf16;
typedef unsigned v4u __attribute__((ext_vector_type(4)));
typedef float f32x4 __attribute__((ext_vector_type(4)));
constexpr int NWAVES = 8;
constexpr int NB = 4, SEQ = 2048, DM = 2048, M = NB * SEQ, NH = 8, HD = 128, DFF = 5632, NUP = 2 * DFF, INC = 10248, NPROJ = 10240;
constexpr float EPS = 1e-6f;
constexpr float LOG2E_F = 1.4426950408889634f;
constexpr size_t MiB = 1u << 20;
constexpr size_t WS_CTL = 0, WS_BAR = 64 * 1024;
constexpr size_t WS_GAIN = 2 * MiB, WS_RSTD = 3 * MiB;
constexpr size_t WS_SSQ = 256 * 1024, WS_CUM = 512 * 1024, WS_LOGF = 768 * 1024, WS_LSE = 1 * MiB;
constexpr size_t WS_WIN = 4 * MiB, WS_WBRF = 44 * MiB, WS_WBRD = 48 * MiB, WS_WOUT = 52 * MiB, WS_WUP = 60 * MiB, WS_WDN = 104 * MiB;
constexpr size_t WS_XN = 126 * MiB;
constexpr size_t WS_QKV = 158 * MiB;
constexpr size_t WS_GATES = 254 * MiB;
constexpr size_t WS_OA = 4 * MiB, WS_OB = 20 * MiB;
constexpr size_t WS_OP0 = 126 * MiB, WS_OP1 = 142 * MiB, WS_OP2 = 318 * MiB;
constexpr size_t WS_T = 158 * MiB, WS_MG = 222 * MiB;
constexpr size_t WS_XB = 126 * MiB;
#ifndef CONV_ALIGN
#define CONV_ALIGN false
#endif
#ifndef FUSED_CONV
#define FUSED_CONV 0
#endif
constexpr size_t WS_U = 158 * MiB;
constexpr size_t WS_ACT = FUSED_CONV ? 158 * MiB : 4 * MiB, WS_US = 254 * MiB;
constexpr size_t WS_END = 334 * MiB;
constexpr int RING_BYTES = 131072, XL_OFF = RING_BYTES, BARST_OFF = 143360, LDS_BYTES = 147456;
static_assert(att::LDS_END <= LDS_BYTES, "attention LDS");

__device__ __forceinline__ unsigned f2bf(float f) { unsigned u = __builtin_bit_cast(unsigned, f); return (u + 0x7fffu + ((u >> 16) & 1u)) >> 16; }
__device__ __forceinline__ unsigned pk2(float lo, float hi) { return f2bf(lo) | (f2bf(hi) << 16); }
__device__ __forceinline__ float wave_sum(float v) {
#pragma unroll
    for (int o = 1; o < 64; o <<= 1) v += __shfl_xor(v, o);
    return v;
}
template <int MODE, bool NTST>
__device__ __forceinline__ void transpose_matrix(const float* W, int K, int Nsrc, int Ndst, bf16* WT, int Kdst, int koff, const float* kscale, int rot, int gw, int NGW, LAS float* scr, int lane, int lo = 0, int ilim = 0x7fffffff) {
    const int nblk = Ndst / 32, nall = (K / 64) * nblk, nitems = nall < ilim ? nall : ilim, rr = lane >> 3, c4 = (lane & 7) * 4, c = lane & 7;
    int it = gw - rot; if (it < 0) it += NGW; it += lo;
    f32x4 v[8]; int k0 = 0, n0 = 0;
#define TM_LOAD(dst, IT, K0, N0) do { const int kb_ = (IT) / nblk; N0 = 32 * ((IT) - kb_ * nblk); K0 = 64 * kb_;                                   \
        const int sc_ = MODE == 0 ? N0 : (MODE == 1 ? (N0 < 3072 ? N0 : N0 + 8) : (((N0 >> 7) & 1) * 5632 + 128 * (N0 >> 8) + (N0 & 127)));       \
        _Pragma("unroll") for (int i = 0; i < 8; ++i) dst[i] = __builtin_nontemporal_load((const f32x4*)(W + (size_t)(K0 + 8 * i + rr) * Nsrc + sc_ + c4)); } while (0)
    if (it < nitems) TM_LOAD(v, it, k0, n0);
    while (it < nitems) {
        const int itn = it + NGW; f32x4 vn[8]; int k0n = 0, n0n = 0;
        if (itn < nitems) TM_LOAD(vn, itn, k0n, n0n);
        if (kscale) {
#pragma unroll
            for (int i = 0; i < 8; ++i) v[i] = v[i] * kscale[k0 + 8 * i + rr]; }
#pragma unroll
        for (int i = 0; i < 8; ++i) { LAS float* d = scr + (8 * i + rr) * 33 + c4; d[0] = v[i][0]; d[1] = v[i][1]; d[2] = v[i][2]; d[3] = v[i][3]; }
        asm volatile("s_waitcnt lgkmcnt(0)" ::: "memory");
#pragma unroll
        for (int j = 0; j < 4; ++j) { const int n = (lane >> 3) + 8 * j; const LAS float* sp = scr + (8 * c) * 33 + n;
            v4u o; o.x = pk2(sp[0 * 33], sp[1 * 33]); o.y = pk2(sp[2 * 33], sp[3 * 33]); o.z = pk2(sp[4 * 33], sp[5 * 33]); o.w = pk2(sp[6 * 33], sp[7 * 33]);
            if constexpr (NTST) __builtin_nontemporal_store(o, (v4u*)(WT + (size_t)(n0 + n) * Kdst + koff + k0 + 8 * c)); else *(v4u*)(WT + (size_t)(n0 + n) * Kdst + koff + k0 + 8 * c) = o; }
        asm volatile("s_waitcnt lgkmcnt(0)" ::: "memory");
        it = itn; k0 = k0n; n0 = n0n;
#pragma unroll
        for (int i = 0; i < 8; ++i) v[i] = vn[i];
    }
#undef TM_LOAD
}

typedef GAS unsigned gu32;
#define RLX_AGENT __ATOMIC_RELAXED, __HIP_MEMORY_SCOPE_AGENT
#define XB_TMO      128
#define XB_XCNT(j)  (256  + 64 * (j))
#define XB_XSUB(j)  (1280 + 64 * (j))
#define XB_XGEN(j)  (2304 + 64 * (j))
#define XB_TOP      3328
#define XB_TOPGEN   3392
#define XCD_BAR_WORDS 3456
#define XB_SPIN_CAP (1u << 18)

__device__ __forceinline__ unsigned xb_ld(unsigned* p)              { return __hip_atomic_load(p, __ATOMIC_RELAXED, __HIP_MEMORY_SCOPE_AGENT); }
__device__ __forceinline__ unsigned xb_add(unsigned* p, unsigned v) { return __hip_atomic_fetch_add(p, v, __ATOMIC_RELAXED, __HIP_MEMORY_SCOPE_AGENT); }
__device__ __forceinline__ unsigned xb_xcc_id() { return (unsigned)__builtin_amdgcn_s_getreg((3 << 11) | 20) & 0xFu; }
#define XB_SPIN(cond, bar) do { unsigned _sp = 0; while (cond) { __builtin_amdgcn_s_sleep(1); \
    if ((++_sp & 255u) == 0u) { if (xb_ld(&(bar)[XB_TMO])) break; if (_sp > XB_SPIN_CAP) { atomicAdd(&(bar)[XB_TMO], 1u); break; } } } } while (0)

struct XcdBarrier {
    unsigned* bar; unsigned x;
    volatile LAS unsigned* st;
};

__device__ __forceinline__ XcdBarrier xcd_barrier_post(unsigned* bar, volatile LAS unsigned* st) {
    XcdBarrier b; b.bar = bar; b.x = xb_xcc_id(); b.st = st;
    if (threadIdx.x == 0) (void)xb_add(&bar[XB_XCNT(b.x)], 1u);
    return b;
}
__device__ __forceinline__ void xcd_barrier_complete(unsigned* bar, unsigned x, unsigned& nloc, unsigned& nx) {
    const unsigned G = gridDim.x * gridDim.y * gridDim.z;
    unsigned sum, cnt, mine, sp = 0u;
    for (;;) {
        sum = 0u; cnt = 0u; mine = 0u;
#pragma unroll
        for (unsigned j = 0; j < 16; ++j) { const unsigned c = xb_ld(&bar[XB_XCNT(j)]); sum += c; cnt += (c > 0u) ? 1u : 0u; mine = (j == x) ? c : mine; }
        if (sum == G) break;
        __builtin_amdgcn_s_sleep(1);
        if ((++sp & 255u) == 0u) { if (xb_ld(&bar[XB_TMO])) break; if (sp > XB_SPIN_CAP) { atomicAdd(&bar[XB_TMO], 1u); break; } }
    }
    nloc = mine > 0u ? mine : 1u; nx = cnt > 0u ? cnt : 1u;
}

__device__ __forceinline__ void xcd_barrier(const XcdBarrier& b) {
    asm volatile("s_waitcnt vmcnt(0)" ::: "memory");
    __syncthreads();
    if (threadIdx.x == 0) {
        unsigned* bar = b.bar;
        __builtin_amdgcn_s_waitcnt(0);
        unsigned nloc = b.st[0], nx = b.st[1];
        if (nloc == 0u) { xcd_barrier_complete(bar, b.x, nloc, nx); b.st[0] = nloc; b.st[1] = nx; }
        const unsigned old = xb_add(&bar[XB_XSUB(b.x)], 1u);
        const unsigned gen = old / nloc;
        if (old + 1u == (gen + 1u) * nloc) {
            __builtin_amdgcn_fence(__ATOMIC_RELEASE, "agent");
            asm volatile("s_waitcnt vmcnt(0)" ::: "memory");
            const unsigned og = xb_add(&bar[XB_TOP], 1u);
            const unsigned tg = og / nx;
            if (og + 1u == (tg + 1u) * nx) xb_add(&bar[XB_TOPGEN], 1u);
            else XB_SPIN(xb_ld(&bar[XB_TOPGEN]) == tg, bar);
            __builtin_amdgcn_fence(__ATOMIC_ACQUIRE, "agent");
            xb_add(&bar[XB_XGEN(b.x)], 1u);
            asm volatile("s_waitcnt vmcnt(0)" ::: "memory");
        } else {
            XB_SPIN(xb_ld(&bar[XB_XGEN(b.x)]) == gen, bar);
            __builtin_amdgcn_fence(__ATOMIC_ACQUIRE, "agent");
            asm volatile("s_waitcnt vmcnt(0)" ::: "memory");
        }
    }
    __syncthreads();
}
#ifndef PROBE_REPEAT
#define PROBE_REPEAT -1
#endif
#ifndef PROBE_FIRST
#define PROBE_FIRST 0
#endif
#define REPS(k) ((PROBE_REPEAT == (k)) ? 2 : 1)
struct Args { const float* in[16]; float* out; unsigned char* ws; unsigned long long flags; };
#define IDS() int tid_o = threadIdx.x; asm volatile("" : "+v"(tid_o)); const int tid = tid_o, lane = tid & 63, wave = __builtin_amdgcn_readfirstlane(tid >> 6); (void)lane; (void)wave
#define OPQ() int z_ = 0; asm volatile("" : "+s"(z_))
#define INP(k) (args.in[z_ + (k)])

__global__ void __launch_bounds__(NWAVES * 64, 2) fwd_mega(Args args) {
    extern __shared__ __attribute__((aligned(16))) unsigned char lds[];
    cg::grid_group grid = cg::this_grid();
    LAS unsigned char* lds3 = (LAS unsigned char*)lds;
    const int G = gridDim.x, bx = blockIdx.x;
    if (threadIdx.x < 2) ((volatile LAS unsigned*)(lds3 + BARST_OFF))[threadIdx.x] = 0u;
    __syncthreads();
    unsigned char* ws = args.ws;
    const XcdBarrier xbar = xcd_barrier_post((unsigned*)(ws + WS_BAR), (volatile LAS unsigned*)(lds3 + BARST_OFF));
    float* out = args.out;
    bf16* Win_t = (bf16*)(ws + WS_WIN); bf16* Wbrf_t = (bf16*)(ws + WS_WBRF); bf16* Wbrd_t = (bf16*)(ws + WS_WBRD); bf16* Wout_t = (bf16*)(ws + WS_WOUT);
    bf16* Wup_t = (bf16*)(ws + WS_WUP); bf16* Wdn_t = (bf16*)(ws + WS_WDN);
    bf16* XN = (bf16*)(ws + WS_XN); bf16* QKV = (bf16*)(ws + WS_QKV); bf16* GATES = (bf16*)(ws + WS_GATES);
    bf16* OA = (bf16*)(ws + WS_OA); bf16* OB = (bf16*)(ws + WS_OB); bf16* OP0 = (bf16*)(ws + WS_OP0); bf16* OP1 = (bf16*)(ws + WS_OP1); bf16* OP2 = (bf16*)(ws + WS_OP2);
    float* T = (float*)(ws + WS_T); bf16* MG = (bf16*)(ws + WS_MG); bf16* XB = (bf16*)(ws + WS_XB); bf16* ACT = (bf16*)(ws + WS_ACT); bf16* U = (bf16*)(ws + WS_U); float* US = (float*)(ws + WS_US); (void)U; (void)US;
    float* SSQ = (float*)(ws + WS_SSQ); float* CUM = (float*)(ws + WS_CUM); float* LOGF = (float*)(ws + WS_LOGF); float* LSE = (float*)(ws + WS_LSE);
    unsigned* ctl = (unsigned*)(ws + WS_CTL); float* GAIN = (float*)(ws + WS_GAIN); float* RSTD = (float*)(ws + WS_RSTD);

#if !defined(ONLY) || ONLY == 0
    _Pragma("unroll 1") for (int rep_ = 0; rep_ < REPS(0); ++rep_) {
        IDS();
        OPQ(); const float* x = INP(0); const float* g_attn = INP(1); const float* w_in = INP(2); const float* b_forget = INP(3); const float* gq_fox = INP(4); const float* gk_fox = INP(5); const float* gq_dil = INP(6); const float* gk_dil = INP(7);
        const float* w_br_fox = INP(8); const float* w_br_dil = INP(9); const float* w_out = INP(10); const float* g_ffn = INP(11); const float* w_up = INP(12); const float* w_down = INP(15);
        if (bx == 1) for (int i = tid; i < 1024; i += NWAVES * 64) { GAIN[i] = gq_fox[i]; GAIN[1024 + i] = gk_fox[i]; GAIN[2048 + i] = gq_dil[i]; GAIN[3072 + i] = gk_dil[i]; }
        LAS float* scr = (LAS float*)(lds3 + wave * 16384);
        const int gw = bx * NWAVES + wave, NGW = G * NWAVES;
        constexpr int I_IN = (DM / 64) * (NPROJ / 32), I_BR = (1024 / 64) * (DM / 32), I_OUT = (DM / 64) * (DM / 32), I_UP = (DM / 64) * (NUP / 32);
        transpose_matrix<1, false>(w_in, DM, INC, NPROJ, Win_t, DM, 0, nullptr, 0, gw, NGW, scr, lane);
        if (G != 256) transpose_matrix<0, true>(w_down, DFF, DM, DM, Wdn_t, DFF, 0, nullptr, (I_IN + 2 * I_BR + I_OUT + I_UP) % NGW, gw, NGW, scr, lane);
        __syncthreads();
        LAS float* wf = (LAS float*)lds3;
        {
            const float* wsrc = w_in + 3072 + (tid & 7);
#pragma unroll 1
            for (int b0 = 0; b0 < 32; b0 += 8) { float tv[8];
#pragma unroll
                for (int q = 0; q < 8; ++q) tv[q] = wsrc[(size_t)((tid + (b0 + q) * NWAVES * 64) >> 3) * INC];
#pragma unroll
                for (int q = 0; q < 8; ++q) wf[tid + (b0 + q) * NWAVES * 64] = tv[q]; }
        }
        __syncthreads();
        for (int m = gw; m < M; m += NGW) {
            const f32x4* xr = (const f32x4*)(x + (size_t)m * DM) + lane; const f32x4* gr = (const f32x4*)g_attn + lane;
            f32x4 v[8]; float s = 0.f;
#pragma unroll
            for (int j = 0; j < 8; ++j) { v[j] = __builtin_nontemporal_load(xr + 64 * j); s += (v[j][0] * v[j][0] + v[j][1] * v[j][1]) + (v[j][2] * v[j][2] + v[j][3] * v[j][3]); }
            const float rstd = 1.f / sqrtf(wave_sum(s) * (1.f / DM) + EPS);
            float fa[8] = {0.f, 0.f, 0.f, 0.f, 0.f, 0.f, 0.f, 0.f};
            unsigned long long* o8 = (unsigned long long*)(XN + (size_t)m * DM) + lane;
#pragma unroll
            for (int j = 0; j < 8; ++j) { const f32x4 h = v[j] * rstd * gr[64 * j];
                o8[64 * j] = (unsigned long long)pk2(h[0], h[1]) | ((unsigned long long)pk2(h[2], h[3]) << 32);
#pragma unroll
                for (int c = 0; c < 4; ++c) { const LAS f32x4* wp = (const LAS f32x4*)(wf + (size_t)(256 * j + 4 * lane + c) * 8); const f32x4 wa = wp[0], wb = wp[1];
                    fa[0] = fmaf(h[c], wa[0], fa[0]); fa[1] = fmaf(h[c], wa[1], fa[1]); fa[2] = fmaf(h[c], wa[2], fa[2]); fa[3] = fmaf(h[c], wa[3], fa[3]);
                    fa[4] = fmaf(h[c], wb[0], fa[4]); fa[5] = fmaf(h[c], wb[1], fa[5]); fa[6] = fmaf(h[c], wb[2], fa[6]); fa[7] = fmaf(h[c], wb[3], fa[7]); }
                asm volatile("" ::: "memory"); }
#pragma unroll
            for (int hh = 0; hh < 8; ++hh) fa[hh] = wave_sum(fa[hh]);
            if (lane < 8) { float z = fa[0];
#pragma unroll
                for (int hh = 1; hh < 8; ++hh) z = (lane == hh) ? fa[hh] : z;
                z += b_forget[lane];
                LOGF[(size_t)m * 8 + lane] = fminf(z, 0.f) - log1pf(expf(-fabsf(z))); }
        }
        __syncthreads();
    }
#endif
    if (args.flags & 1ull) grid.sync();
    xcd_barrier(xbar);

#if !defined(ONLY) || ONLY == 1
    _Pragma("unroll 1") for (int rep_ = 0; rep_ < REPS(1); ++rep_) {
        if (rep_ > 0) xcd_barrier(xbar);
        IDS();
        if (bx < NB * NH) { const int bb = bx >> 3, h = bx & 7; LAS float* wt = (LAS float*)lds3;
            float v[4]; float s = 0.f;
#pragma unroll
            for (int j = 0; j < 4; ++j) { v[j] = LOGF[((size_t)bb * SEQ + 4 * tid + j) * 8 + h]; s += v[j]; v[j] = s; }
            float inc = s;
#pragma unroll
            for (int o = 1; o < 64; o <<= 1) { const float t = __shfl_up(inc, o); if (lane >= o) inc += t; }
            if (lane == 63) wt[wave] = inc;
            __syncthreads();
            float off = inc - s;
            for (int w = 0; w < wave; ++w) off += wt[w];
#pragma unroll
            for (int j = 0; j < 4; ++j) CUM[(size_t)bx * SEQ + 4 * tid + j] = off + v[j];
            __syncthreads();
        }
        pg8::Gemm g{XN, Win_t, M, NPROJ, DM}; pg8::StaticOrder S; S.init(M, NPROJ, G, bx);
        pg8::EpiProj E{QKV, GATES, GAIN, (LAS float*)(lds3 + XL_OFF)};
        pg8::gemm_phase<pg8::EpiProj, pg8::StaticOrder, true, true>(lds3, g, S, E);
    }
#endif
    xcd_barrier(xbar);

#if !defined(ONLY) || ONLY == 2
    _Pragma("unroll 1") for (int rep_ = 0; rep_ < REPS(2); ++rep_) {
        if (rep_ > 0) xcd_barrier(xbar);
        IDS();
        const att::AttnArgs A{QKV, ws, (long)WS_OA, (long)WS_OP0, (long)WS_OP2 - (long)WS_OP0 - 32 * (long)MiB, LSE, CUM};
        { OPQ(); const float* w_br_fox = INP(8); const float* w_br_dil = INP(9); const float* w_out = INP(10); const float* g_ffn = INP(11); const float* w_up = INP(12);
          LAS float* scr = (LAS float*)(lds3 + wave * 16384);
          constexpr int I_BR = (1024 / 64) * (DM / 32), I_OUT = (DM / 64) * (DM / 32), I_UP = (DM / 64) * (NUP / 32), CH = 32, NCH = (2 * I_BR + I_OUT + I_UP) / CH;
          static_assert(I_BR % CH == 0 && I_OUT % CH == 0 && I_UP % CH == 0, "chunks do not straddle matrices");
          volatile LAS int* cslot = (volatile LAS int*)(lds3 + BARST_OFF + 32);
#define CONV_CHUNKS(MAXN) do { \
          for (int nch_ = 0; nch_ < (MAXN); ++nch_) { \
              if (tid == 0) *cslot = (int)atomicAdd(ctl + 48 + 16 * rep_, 1u); \
              __syncthreads(); const int ch = __builtin_amdgcn_readfirstlane(*cslot); __syncthreads(); \
              if (ch >= NCH) break; \
              const int g0 = ch * CH; \
              if (g0 < I_BR) transpose_matrix<0, true>(w_br_fox, 1024, DM, DM, Wbrf_t, 2048, 0, nullptr, 0, wave, NWAVES, scr, lane, g0, g0 + CH); \
              else if (g0 < 2 * I_BR) transpose_matrix<0, true>(w_br_dil, 1024, DM, DM, Wbrf_t, 2048, 1024, nullptr, 0, wave, NWAVES, scr, lane, g0 - I_BR, g0 - I_BR + CH); \
              else if (g0 < 2 * I_BR + I_OUT) transpose_matrix<0, true>(w_out, DM, DM, DM, Wout_t, DM, 0, nullptr, 0, wave, NWAVES, scr, lane, g0 - 2 * I_BR, g0 - 2 * I_BR + CH); \
              else transpose_matrix<2, true>(w_up, DM, NUP, NUP, Wup_t, DM, 0, g_ffn, 0, wave, NWAVES, scr, lane, g0 - 2 * I_BR - I_OUT, g0 - 2 * I_BR - I_OUT + CH); \
          } \
          } while (0)
          if (bx >= 128) CONV_CHUNKS(3);
          __syncthreads();
          att::attn_phase((char*)lds, A, ctl + 16 * rep_, rep_ ? PROBE_FIRST : 0);
          __syncthreads();
          CONV_CHUNKS(0x7fffffff);
#undef CONV_CHUNKS
        }
    }
#endif
    xcd_barrier(xbar);

#if !defined(ONLY) || ONLY == 3
    _Pragma("unroll 1") for (int rep_ = 0; rep_ < REPS(3); ++rep_) {
        if (rep_ > 0) xcd_barrier(xbar);
        IDS();
        const int gt = bx * (NWAVES * 64) + tid, NT = G * NWAVES * 64;
        for (int i = gt; i < M * 128; i += NT) { const int m = i >> 7, c8 = (i & 127) * 8, h = c8 >> 7;
            const float l0 = LSE[(size_t)m * 8 + h], l1 = LSE[(size_t)(M + m) * 8 + h], l2 = LSE[(size_t)(2 * M + m) * 8 + h];
            const float mx = fmaxf(l0, fmaxf(l1, l2));
            float w0 = __builtin_amdgcn_exp2f(l0 - mx), w1 = __builtin_amdgcn_exp2f(l1 - mx), w2 = __builtin_amdgcn_exp2f(l2 - mx);
            const float inv = 1.f / (w0 + w1 + w2); w0 *= inv; w1 *= inv; w2 *= inv;
            const v4u a = __builtin_nontemporal_load((const v4u*)(OP0 + (size_t)m * 1024 + c8)), b = __builtin_nontemporal_load((const v4u*)(OP1 + (size_t)m * 1024 + c8)), c = __builtin_nontemporal_load((const v4u*)(OP2 + (size_t)m * 1024 + c8));
            v4u o;
#pragma unroll
            for (int k = 0; k < 4; ++k) { const float lo = w0 * pg8::bflo(a[k]) + w1 * pg8::bflo(b[k]) + w2 * pg8::bflo(c[k]), hi = w0 * pg8::bfhi(a[k]) + w1 * pg8::bfhi(b[k]) + w2 * pg8::bfhi(c[k]); o[k] = pk2(lo, hi); }
            *(v4u*)(OA + (size_t)m * 2048 + 1024 + c8) = o; }
    }
#endif
    xcd_barrier(xbar);

#if !defined(ONLY) || ONLY == 4
    _Pragma("unroll 1") for (int rep_ = 0; rep_ < REPS(4); ++rep_) {
        if (rep_ > 0) xcd_barrier(xbar);
        IDS();
        pg8::StaticOrder S; S.init(M, DM, G, bx);
        pg8::Gemm g{OA, Wbrf_t, M, DM, 2048}; pg8::EpiBr E{GATES, MG};
        pg8::gemm_phase<pg8::EpiBr, pg8::StaticOrder, true, true>(lds3, g, S, E);
    }
#endif
    xcd_barrier(xbar);

#if !defined(ONLY) || ONLY == 5
    _Pragma("unroll 1") for (int rep_ = 0; rep_ < REPS(5); ++rep_) {
        if (rep_ > 0) xcd_barrier(xbar);
        IDS();
        pg8::Gemm g{MG, Wout_t, M, DM, DM}; pg8::StaticOrder S; S.init(M, DM, G, bx);
        OPQ(); pg8::EpiOut E{INP(0), XB, SSQ};
        pg8::gemm_phase<pg8::EpiOut, pg8::StaticOrder, false, true>(lds3, g, S, E);
    }
#endif
    xcd_barrier(xbar);

#if !defined(ONLY) || ONLY == 6
    _Pragma("unroll 1") for (int rep_ = 0; rep_ < REPS(6); ++rep_) {
        if (rep_ > 0) xcd_barrier(xbar);
        IDS();
#pragma unroll 1
        for (int r0 = tid; r0 < M; r0 += 8 * NWAVES * 64) { f32x4 sa[8], sb[8];
#pragma unroll
            for (int q = 0; q < 8; ++q) { const size_t r = (size_t)(r0 + q * NWAVES * 64); sa[q] = *(const f32x4*)(SSQ + r * 8); sb[q] = *(const f32x4*)(SSQ + r * 8 + 4); }
#pragma unroll
            for (int q = 0; q < 8; ++q) RSTD[r0 + q * NWAVES * 64] = 1.f / sqrtf((((sa[q][0] + sa[q][1]) + (sa[q][2] + sa[q][3])) + ((sb[q][0] + sb[q][1]) + (sb[q][2] + sb[q][3]))) * (1.f / DM) + EPS); }
        asm volatile("s_waitcnt vmcnt(0)" ::: "memory"); __syncthreads();
        pg8::Gemm g{XB, Wup_t, M, NUP, DM}; pg8::StaticOrder S; S.init(M, NUP, G, bx);
#if FUSED_CONV
        OPQ(); pg8::EpiUpConv E{RSTD, INP(13), INP(14), ACT, US, (LAS float*)(lds3 + XL_OFF)};
        pg8::gemm_phase<pg8::EpiUpConv, pg8::StaticOrder, CONV_ALIGN, true>(lds3, g, S, E);
#else
        pg8::EpiUp E{RSTD, U};
        pg8::gemm_phase<pg8::EpiUp, pg8::StaticOrder, true, true>(lds3, g, S, E);
        if (G == 256 && bx >= 128) { OPQ(); const float* w_down = INP(15);
            transpose_matrix<0, true>(w_down, DFF, DM, DM, Wdn_t, DFF, 0, nullptr, 0, (bx - 128) * NWAVES + wave, 128 * NWAVES, (LAS float*)(lds3 + wave * 16384), lane); }
#endif
    }
#endif
    xcd_barrier(xbar);

#if (!defined(ONLY) || ONLY == 8) && !FUSED_CONV
    _Pragma("unroll 1") for (int rep_ = 0; rep_ < REPS(8); ++rep_) {
        if (rep_ > 0) xcd_barrier(xbar);
        IDS();
        OPQ(); const float* w_conv = INP(13); const float* b_conv = INP(14);
        const int gt = bx * (NWAVES * 64) + tid, NTH = G * NWAVES * 64;
        for (int it = gt; it < 704 * 512; it += NTH) { const int r = it / 704, k = it - r * 704, t0 = r * 16, pn = k >> 4, j8 = (k & 15) * 8;
            const unsigned ug = 256 * pn + j8, c = 8 * k;
            float wg[3][8], wv[3][8], bg[8], bv[8];
#pragma unroll
            for (int tp = 0; tp < 3; ++tp)
#pragma unroll
                for (int q = 0; q < 2; ++q) { const f32x4 a = *(const f32x4*)(w_conv + tp * NUP + c + 4 * q), b = *(const f32x4*)(w_conv + tp * NUP + DFF + c + 4 * q);
#pragma unroll
                    for (int j = 0; j < 4; ++j) { wg[tp][4 * q + j] = a[j]; wv[tp][4 * q + j] = b[j]; } }
#pragma unroll
            for (int q = 0; q < 2; ++q) { const f32x4 a = *(const f32x4*)(b_conv + c + 4 * q), b = *(const f32x4*)(b_conv + DFF + c + 4 * q);
#pragma unroll
                for (int j = 0; j < 4; ++j) { bg[4 * q + j] = a[j]; bv[4 * q + j] = b[j]; } }
            float g2[8], g1[8], v2[8], v1[8];
            if ((t0 & (SEQ - 1)) == 0) {
#pragma unroll
                for (int j = 0; j < 8; ++j) { g2[j] = 0.f; g1[j] = 0.f; v2[j] = 0.f; v1[j] = 0.f; }
            } else {
                const v4u a2 = *(const v4u*)(U + (size_t)(t0 - 2) * NUP + ug), b2 = *(const v4u*)(U + (size_t)(t0 - 2) * NUP + ug + 128);
                const v4u a1 = *(const v4u*)(U + (size_t)(t0 - 1) * NUP + ug), b1 = *(const v4u*)(U + (size_t)(t0 - 1) * NUP + ug + 128);
#pragma unroll
                for (int q = 0; q < 4; ++q) { g2[2 * q] = pg8::bflo(a2[q]); g2[2 * q + 1] = pg8::bfhi(a2[q]); v2[2 * q] = pg8::bflo(b2[q]); v2[2 * q + 1] = pg8::bfhi(b2[q]);
                    g1[2 * q] = pg8::bflo(a1[q]); g1[2 * q + 1] = pg8::bfhi(a1[q]); v1[2 * q] = pg8::bflo(b1[q]); v1[2 * q + 1] = pg8::bfhi(b1[q]); }
            }
            for (int i4 = 0; i4 < 16; i4 += 4) {
                v4u a0[4], b0[4];
#pragma unroll
                for (int i = 0; i < 4; ++i) { const size_t t = (size_t)(t0 + i4 + i);
                    a0[i] = __builtin_nontemporal_load((const v4u*)(U + t * NUP + ug)); b0[i] = __builtin_nontemporal_load((const v4u*)(U + t * NUP + ug + 128)); }
#pragma unroll
                for (int i = 0; i < 4; ++i) { const size_t t = (size_t)(t0 + i4 + i);
                    float g0[8], v0[8], o[8];
#pragma unroll
                    for (int q = 0; q < 4; ++q) { g0[2 * q] = pg8::bflo(a0[i][q]); g0[2 * q + 1] = pg8::bfhi(a0[i][q]); v0[2 * q] = pg8::bflo(b0[i][q]); v0[2 * q + 1] = pg8::bfhi(b0[i][q]); }
#pragma unroll
                    for (int j = 0; j < 8; ++j) { const float gt_ = fmaf(wg[0][j], g2[j], fmaf(wg[1][j], g1[j], fmaf(wg[2][j], g0[j], bg[j])));
                        const float vl = fmaf(wv[0][j], v2[j], fmaf(wv[1][j], v1[j], fmaf(wv[2][j], v0[j], bv[j])));
                        o[j] = gt_ * pg8::sigm(gt_) * vl; g2[j] = g1[j]; g1[j] = g0[j]; v2[j] = v1[j]; v1[j] = v0[j]; }
                    v4u w; w.x = pk2(o[0], o[1]); w.y = pk2(o[2], o[3]); w.z = pk2(o[4], o[5]); w.w = pk2(o[6], o[7]);
                    *(v4u*)(ACT + t * DFF + c) = w; } }
        }
    }
#endif
    #if !FUSED_CONV
    xcd_barrier(xbar);
#endif

#if !defined(ONLY) || ONLY == 7
    _Pragma("unroll 1") for (int rep_ = 0; rep_ < REPS(7); ++rep_) {
        if (rep_ > 0) xcd_barrier(xbar);
        IDS();
        pg8::StaticOrder S; S.init(M, DM, G, bx);
#if FUSED_CONV
        {
            OPQ(); const float* w_conv = INP(13); const float* b_conv = INP(14); pg8::Unit u0;
            if (S.next(0, u0)) {
                for (int i = tid; i < 4 * DFF; i += NWAVES * 64) { const int gq = i / DFF, c = i - gq * DFF, Gi = 4 * u0.pm + gq; const bool first = (Gi & 31) == 0;
                    const float* up = US + (size_t)Gi * 4 * NUP;
                    float cv[2][2];
#pragma unroll
                    for (int bj = 0; bj < 2; ++bj) { const int uc = bj * DFF + c; const float u0v = first ? 0.f : up[uc], u1v = first ? 0.f : up[NUP + uc], u2v = up[2 * NUP + uc], u3v = up[3 * NUP + uc];
                        const float w0 = w_conv[uc], w1 = w_conv[NUP + uc], w2 = w_conv[2 * NUP + uc], bb = b_conv[uc];
                        cv[bj][0] = fmaf(w0, u0v, fmaf(w1, u1v, fmaf(w2, u2v, bb))); cv[bj][1] = fmaf(w0, u1v, fmaf(w1, u2v, fmaf(w2, u3v, bb))); }
#pragma unroll
                    for (int t = 0; t < 2; ++t) { const float gte = cv[0][t]; ACT[(size_t)(64 * Gi + t) * DFF + c] = (bf16)f2bf(gte * pg8::sigm(gte) * cv[1][t]); } }
            }
            asm volatile("s_waitcnt vmcnt(0)" ::: "memory"); __threadfence(); __syncthreads();
        }
#endif
        pg8::Gemm g{ACT, Wdn_t, M, DM, DFF};
        pg8::EpiFinal E{XB, out};
        pg8::gemm_phase<pg8::EpiFinal, pg8::StaticOrder, true, true>(lds3, g, S, E);
    }
#endif
}

extern "C" void kernel_launch(void* const* d_in, const int* in_sizes, int n_in, void* d_out, int out_size, void* d_ws, size_t ws_size, hipStream_t stream) {
    static int grid = 0;
    if (grid == 0) {
        if (n_in != 16 || in_sizes[0] != M * DM || out_size != M * DM || ws_size < WS_END) { fprintf(stderr, "kernel_launch: unexpected shapes (n_in %d, in0 %d, out %d, ws %zu)\n", n_in, n_in > 0 ? in_sizes[0] : -1, out_size, ws_size); grid = -1; return; }
        int dev = 0, cus = 0, per_cu = 0;
        (void)hipGetDevice(&dev); (void)hipDeviceGetAttribute(&cus, hipDeviceAttributeMultiprocessorCount, dev);
        if (hipFuncSetAttribute((const void*)fwd_mega, hipFuncAttributeMaxDynamicSharedMemorySize, LDS_BYTES) != hipSuccess) { fprintf(stderr, "kernel_launch: hipFuncSetAttribute failed\n"); grid = -1; return; }
        if (hipOccupancyMaxActiveBlocksPerMultiprocessor(&per_cu, (const void*)fwd_mega, NWAVES * 64, LDS_BYTES) != hipSuccess || per_cu < 1) { fprintf(stderr, "kernel_launch: occupancy query says %d\n", per_cu); per_cu = 1; }
        (void)hipGetLastError();
        grid = cus * 1;
        if (grid != 256) fprintf(stderr, "kernel_launch: %d CUs; the single-unit GEMM phases assume 256\n", grid);
    }
    if (grid < 0) return;
    if (hipMemsetAsync(d_ws, 0, 128 * 1024, stream) != hipSuccess) { fprintf(stderr, "kernel_launch: hipMemsetAsync failed\n"); return; }
    Args a{};
    for (int i = 0; i < 16; ++i) a.in[i] = (const float*)d_in[i];
    a.out = (float*)d_out; a.ws = (unsigned char*)d_ws;
    void* kargs[] = {&a};
    hipError_t e = hipLaunchCooperativeKernel((const void*)fwd_mega, dim3(grid), dim3(NWAVES * 64), kargs, LDS_BYTES, stream);
    if (e != hipSuccess) fprintf(stderr, "cooperative launch failed: %s (grid %d)\n", hipGetErrorString(e), grid);
}
```
